# Optimizing an MI355X kernel written in HIP

```python
import jax, jax.numpy as jnp
from jax import lax
import numpy as np

D_MODEL = 1024
BATCH = 8
SEQ = 4096
DEPTH = 4

GRID_W = 64
CTX_LEN = 256
N_MIXERS = 2
N_HEADS = 16
HEAD_DIM = D_MODEL // N_HEADS
N_DIRS = 2
DECAY_LORA = 64
AAA_LORA = 64
MV_LORA = 32
GATE_LORA = 128
FOURIER_GROUPS = 4
MLP_HIDDEN = 4 * D_MODEL
N_MOD = 6
RMS_EPS = 1e-6
LNX_EPS = 64e-5
L2_EPS = 1e-24

kernel_name = 'hybrid_rwkv7_fnet_adaln_block'


def _rmsnorm(x, g):
    x32 = x.astype(jnp.float32)
    y = x32 * lax.rsqrt(jnp.mean(x32 * x32, axis=-1, keepdims=True) + RMS_EPS)
    return (y * g.astype(jnp.float32)).astype(x.dtype)


def _modulate(h, shift, scale):
    return h * (1 + scale) + shift


def _mlp(h, w1, w2):
    return jnp.square(jax.nn.relu(h @ w1)) @ w2


def _heads(t):
    return t.reshape(t.shape[0], t.shape[1], N_HEADS, HEAD_DIM)


def _qshift(h):
    b, t, d = h.shape
    rows = t // GRID_W
    g = h.reshape(b, rows, GRID_W, 4, d // 4)
    left = jnp.pad(g[:, :, :-1, 0], ((0, 0), (0, 0), (1, 0), (0, 0)))
    right = jnp.pad(g[:, :, 1:, 1], ((0, 0), (0, 0), (0, 1), (0, 0)))
    up = jnp.pad(g[:, :-1, :, 2], ((0, 0), (1, 0), (0, 0), (0, 0)))
    down = jnp.pad(g[:, 1:, :, 3], ((0, 0), (0, 1), (0, 0), (0, 0)))
    return jnp.stack([left, right, up, down], axis=3).reshape(b, t, d)


def _shift_ctx(h):
    d = h.shape[-1]
    prev = jnp.pad(h[:, :-1, : d // 2], ((0, 0), (1, 0), (0, 0)))
    nxt = jnp.pad(h[:, 1:, d // 2:], ((0, 0), (0, 1), (0, 0)))
    return jnp.concatenate([prev, nxt], axis=-1)


def _wkv_scan(r, v, w, k, a, b, s0, reverse):
    dt = v.dtype
    with_out = r is not None
    ins = (w, k, v, a, b) + ((r,) if with_out else ())
    xs = tuple(jnp.swapaxes(t.astype(jnp.float32), 0, 1) for t in ins)

    def step(s, inp):
        w_t, k_t, v_t, a_t, b_t = inp[:5]
        sa = jnp.einsum('bhvk,bhk->bhv', s, a_t)
        s = s * w_t[:, :, None, :] + sa[..., None] * b_t[:, :, None, :] + v_t[..., None] * k_t[:, :, None, :]
        y = jnp.einsum('bhvk,bhk->bhv', s, inp[5]) if with_out else None
        return s, y

    s_fin, ys = lax.scan(step, s0, xs, reverse=reverse)
    if with_out:
        ys = jnp.swapaxes(ys, 0, 1).astype(dt)
    return ys, s_fin


def _rwkv_streams(h, shifted, lp, vres, v_first, readout):
    xx = shifted - h
    mu = lp['mu']
    xr, xw, xk, xv, xa, xg = (h + xx * mu[j] for j in range(6))
    k = xk @ lp['wk']
    v = xv @ lp['wv']
    if vres is not None:
        v0, v1, v2 = vres
        v = v + (v_first - v) * jax.nn.sigmoid(v0 + (xv @ v1) @ v2)
    kk = _heads(k * lp['kk']).astype(jnp.float32)
    kk = kk * lax.rsqrt(jnp.maximum(jnp.sum(kk * kk, axis=-1, keepdims=True), L2_EPS))
    dirs = []
    for d in range(N_DIRS):
        w_log = -jax.nn.softplus(-(lp['w0'][d] + jnp.tanh(xw @ lp['w1'][d]) @ lp['w2'][d])) - 0.5
        decay = jnp.exp(-jnp.exp(w_log.astype(jnp.float32)))
        iclr = jax.nn.sigmoid(lp['a0'][d] + (xa @ lp['a1'][d]) @ lp['a2'][d])
        k_d = k * (1 + (iclr - 1) * lp['ka'])
        dirs.append((_heads(decay), _heads(k_d), -kk, kk * _heads(iclr).astype(jnp.float32)))
    st = {'v': v, 'dirs': dirs}
    if readout:
        st['r'] = _heads(xr @ lp['wr'])
        st['g'] = jax.nn.sigmoid(xg @ lp['g1']) @ lp['g2']
    return st


def _rwkv_readout(y, st, lp):
    b, l = y.shape[:2]
    y32 = y.astype(jnp.float32)
    mean = jnp.mean(y32, axis=-1, keepdims=True)
    var = jnp.mean(jnp.square(y32 - mean), axis=-1, keepdims=True)
    yn = ((y32 - mean) * lax.rsqrt(var + LNX_EPS)).reshape(b, l, D_MODEL) * lp['lnx_w'] + lp['lnx_b']
    r = st['r']
    vh = _heads(st['v'])
    bonus = sum(jnp.sum(r * kd * lp['rk'], axis=-1, keepdims=True) for (_, kd, _, _) in st['dirs']) * vh
    out = (yn.astype(st['v'].dtype) + bonus.reshape(b, l, D_MODEL)) * st['g']
    return out @ lp['wo']


def _rwkv_mixer(h_ctx, h_lat, lp, vres, vf_ctx, vf_lat, ctx_readout):
    st_c = _rwkv_streams(h_ctx, _shift_ctx(h_ctx), lp, vres, vf_ctx, ctx_readout)
    st_l = _rwkv_streams(h_lat, _qshift(h_lat), lp, vres, vf_lat, True)
    vh_c = _heads(st_c['v'])
    vh_l = _heads(st_l['v'])
    s0 = jnp.zeros((h_lat.shape[0], N_HEADS, HEAD_DIM, HEAD_DIM), jnp.float32)
    y_ctx = []
    y_lat = []
    for d in range(N_DIRS):
        rev = d == 1
        yc, s_ctx = _wkv_scan(st_c.get('r'), vh_c, *st_c['dirs'][d], s0, rev)
        yl, _ = _wkv_scan(st_l['r'], vh_l, *st_l['dirs'][d], s_ctx, rev)
        y_lat.append(yl)
        y_ctx.append(yc)
    o_lat = _rwkv_readout(y_lat[0] + y_lat[1], st_l, lp)
    o_ctx = _rwkv_readout(y_ctx[0] + y_ctx[1], st_c, lp) if ctx_readout else None
    return o_ctx, o_lat, st_c['v'], st_l['v']


def _fourier_mixer(h, wo):
    b, l, d = h.shape
    g = h.astype(jnp.float32).reshape(b, l, FOURIER_GROUPS, d // FOURIER_GROUPS)
    f = jnp.fft.fftn(g, axes=(1, 3), norm='ortho').real
    return f.reshape(b, l, d).astype(h.dtype) @ wo


def setup_inputs(seed: int = 0) -> dict:
    key = jax.random.key(seed)
    ks = iter(jax.random.split(key, 40))
    D = D_MODEL
    F = MLP_HIDDEN
    n_a = (DEPTH + 1) // 2
    n_b = DEPTH // 2
    n_v = n_a - 1

    def nrm(shape, s):
        return jax.random.normal(next(ks), shape, jnp.float32) * s

    def unif(shape, lo, hi):
        return jax.random.uniform(next(ks), shape, jnp.float32, minval=lo, maxval=hi)

    return {
        'x': nrm((BATCH, SEQ, D), 1.0),
        'c': nrm((BATCH, D), 1.0),
        'ctx': nrm((BATCH, CTX_LEN, D), 1.0),
        'c_ctx': nrm((D,), 1.0),
        'norm1_g': 1.0 + nrm((DEPTH, D), 0.02),
        'norm2_g': 1.0 + nrm((DEPTH, D), 0.02),
        'mod_w': nrm((DEPTH, D, N_MOD * D), 0.5 * D ** -0.5),
        'mod_b': nrm((DEPTH, N_MOD * D), 0.02),
        'mlp_w1': nrm((DEPTH, D, F), D ** -0.5),
        'mlp_w2': nrm((DEPTH, F, D), F ** -0.5),
        'rk_mu': unif((n_a, 6, D), 0.0, 1.0),
        'rk_wr': nrm((n_a, D, D), D ** -0.5),
        'rk_wk': nrm((n_a, D, D), D ** -0.5),
        'rk_wv': nrm((n_a, D, D), D ** -0.5),
        'rk_wo': nrm((n_a, D, D), D ** -0.5),
        'rk_w0': unif((n_a, N_DIRS, D), -3.0, 0.5),
        'rk_w1': nrm((n_a, N_DIRS, D, DECAY_LORA), D ** -0.5),
        'rk_w2': nrm((n_a, N_DIRS, DECAY_LORA, D), 0.5 * DECAY_LORA ** -0.5),
        'rk_a0': nrm((n_a, N_DIRS, D), 0.1),
        'rk_a1': nrm((n_a, N_DIRS, D, AAA_LORA), D ** -0.5),
        'rk_a2': nrm((n_a, N_DIRS, AAA_LORA, D), 0.5 * AAA_LORA ** -0.5),
        'rk_v0': 0.5 + nrm((n_v, D), 0.1),
        'rk_v1': nrm((n_v, D, MV_LORA), D ** -0.5),
        'rk_v2': nrm((n_v, MV_LORA, D), 0.5 * MV_LORA ** -0.5),
        'rk_g1': nrm((n_a, D, GATE_LORA), D ** -0.5),
        'rk_g2': nrm((n_a, GATE_LORA, D), GATE_LORA ** -0.5),
        'rk_kk': 0.85 + nrm((n_a, D), 0.02),
        'rk_ka': 1.0 + nrm((n_a, D), 0.02),
        'rk_rk': nrm((n_a, N_HEADS, HEAD_DIM), 0.1),
        'rk_lnx_w': 1.0 + nrm((n_a, D), 0.02),
        'rk_lnx_b': nrm((n_a, D), 0.02),
        'ft_wo': nrm((n_b, D, D), D ** -0.5),
        'final_g': 1.0 + nrm((D,), 0.02),
    }


def reference(x, c, ctx, c_ctx, norm1_g, norm2_g, mod_w, mod_b, mlp_w1, mlp_w2, rk_mu, rk_wr, rk_wk, rk_wv, rk_wo, rk_w0, rk_w1, rk_w2, rk_a0, rk_a1, rk_a2, rk_v0, rk_v1, rk_v2, rk_g1, rk_g2, rk_kk, rk_ka, rk_rk, rk_lnx_w, rk_lnx_b, ft_wo, final_g):
    last_a = ((DEPTH - 1) // N_MIXERS) * N_MIXERS
    silu_c = jax.nn.silu(c)
    silu_cc = jax.nn.silu(c_ctx)
    vf_ctx = None
    vf_lat = None
    for i in range(DEPTH):
        mixer = i % N_MIXERS
        idx = i // N_MIXERS
        ctx_in = i <= last_a
        ctx_out = i < last_a
        sh1, sc1, ga1, sh2, sc2, ga2 = jnp.split((silu_c @ mod_w[i] + mod_b[i])[:, None, :], N_MOD, axis=-1)
        h_lat = _modulate(_rmsnorm(x, norm1_g[i]), sh1, sc1)
        if ctx_in:
            csh1, csc1, cga1, csh2, csc2, cga2 = jnp.split(silu_cc @ mod_w[i] + mod_b[i], N_MOD, axis=-1)
            h_ctx = _modulate(_rmsnorm(ctx, norm1_g[i]), csh1, csc1)
        if mixer == 0:
            lp = {'mu': rk_mu[idx], 'wr': rk_wr[idx], 'wk': rk_wk[idx], 'wv': rk_wv[idx], 'wo': rk_wo[idx],
                  'w0': rk_w0[idx], 'w1': rk_w1[idx], 'w2': rk_w2[idx],
                  'a0': rk_a0[idx], 'a1': rk_a1[idx], 'a2': rk_a2[idx],
                  'g1': rk_g1[idx], 'g2': rk_g2[idx], 'kk': rk_kk[idx], 'ka': rk_ka[idx], 'rk': rk_rk[idx],
                  'lnx_w': rk_lnx_w[idx], 'lnx_b': rk_lnx_b[idx]}
            vres = (rk_v0[idx - 1], rk_v1[idx - 1], rk_v2[idx - 1]) if idx > 0 else None
            o_ctx, o_lat, v_c, v_l = _rwkv_mixer(h_ctx, h_lat, lp, vres, vf_ctx, vf_lat, ctx_out)
            if idx == 0:
                vf_ctx, vf_lat = v_c, v_l
        else:
            o_lat = _fourier_mixer(h_lat, ft_wo[idx])
            o_ctx = _fourier_mixer(h_ctx, ft_wo[idx]) if ctx_out else None
        x = x + ga1 * o_lat
        x = x + ga2 * _mlp(_modulate(_rmsnorm(x, norm2_g[i]), sh2, sc2), mlp_w1[i], mlp_w2[i])
        if ctx_out:
            ctx = ctx + cga1 * o_ctx
            ctx = ctx + cga2 * _mlp(_modulate(_rmsnorm(ctx, norm2_g[i]), csh2, csc2), mlp_w1[i], mlp_w2[i])
    return _rmsnorm(x, final_g)
```

```cpp
#include <hip/hip_runtime.h>
#include <hip/hip_cooperative_groups.h>
#include <cstdio>
namespace cg = cooperative_groups;

typedef unsigned short u16;
typedef __attribute__((ext_vector_type(8))) short bf16x8;
typedef __attribute__((ext_vector_type(16))) float f32x16;
typedef __attribute__((ext_vector_type(4))) float f32x4;
typedef __attribute__((ext_vector_type(2))) float f32x2;
typedef __attribute__((ext_vector_type(2))) __bf16 bf16x2v;

constexpr int TL = 8 * 4096, TC = 8 * 256, T = TL + TC;
constexpr size_t SLOT = (size_t)T * 1024 * 2;
constexpr size_t OFF_CTXRES = 6 * SLOT;
constexpr size_t OFF_MOD = OFF_CTXRES + (size_t)TC * 1024 * 4;
constexpr size_t OFF_HW = OFF_MOD + 4 * 9 * 6144 * 4;
constexpr size_t OFF_HA = OFF_HW + (size_t)T * 128 * 2;
constexpr size_t OFF_HG = OFF_HA + (size_t)T * 128 * 2;
constexpr size_t OFF_HV = OFF_HG + (size_t)T * 128 * 2;
constexpr size_t OFF_BSUM = OFF_HV + (size_t)T * 64 * 2;
constexpr size_t OFF_WMIX = OFF_BSUM + (size_t)T * 32 * 4;
constexpr size_t M1 = 1048576;
constexpr size_t WMIX_ELEMS = 4 * M1 + 5 * 131072 + 65536;
constexpr size_t OFF_WMLP = OFF_WMIX + WMIX_ELEMS * 2;
constexpr size_t WS_END = OFF_WMLP + 2 * 4 * M1 * 2;
constexpr int LDS_BYTES = 131072;

struct Params {
  const float* in[33];
  float* out;
  char* ws;
};

__device__ __forceinline__ unsigned pack2(float a, float b) {
  f32x2 v = {a, b};
  bf16x2v r = __builtin_convertvector(v, bf16x2v);
  return __builtin_bit_cast(unsigned, r);
}
__device__ __forceinline__ u16 f2bf(float a) { return (u16)(pack2(a, 0.f) & 0xffffu); }
__device__ __forceinline__ float bflo(unsigned u) { return __uint_as_float(u << 16); }
__device__ __forceinline__ float bfhi(unsigned u) { return __uint_as_float(u & 0xffff0000u); }
__device__ __forceinline__ float bf2f(u16 h) { return __uint_as_float(((unsigned)h) << 16); }
__device__ __forceinline__ float wave_sum(float v) {
#pragma unroll
  for (int o = 32; o > 0; o >>= 1) v += __shfl_xor(v, o);
  return v;
}
__device__ __forceinline__ float sigmoidf_(float x) { return 1.f / (1.f + __expf(-x)); }
__device__ __forceinline__ float xrow_sum(float x) {
  unsigned u = __float_as_uint(x);
  auto r = __builtin_amdgcn_permlane32_swap(u, u, false, false);
  float s = __uint_as_float(r[0]) + __uint_as_float(r[1]);
  u = __float_as_uint(s);
  auto r2 = __builtin_amdgcn_permlane16_swap(u, u, false, false);
  return __uint_as_float(r2[0]) + __uint_as_float(r2[1]);
}

__device__ __forceinline__ void phase_mod(const Params& p, char* smem, const int tid) {
  float* sv = (float*)smem;
  float* red = sv + 9 * 1024;
  const float* c = p.in[1];
  const float* cc = p.in[3];
  const float* mod_w = p.in[6];
  const float* mod_b = p.in[7];
  float* mod = (float*)(p.ws + OFF_MOD);
  for (int e = tid; e < 9 * 1024; e += 512) {
    int j = e >> 10, k = e & 1023;
    float v = (j < 8) ? c[j * 1024 + k] : cc[k];
    sv[e] = v / (1.f + expf(-v));
  }
  __syncthreads();
  for (int item = blockIdx.x; item < 384; item += gridDim.x) {
    int layer = item / 96, c0 = (item % 96) * 64;
    int kq = tid >> 6, col = tid & 63;
    const float* w = mod_w + (size_t)layer * 1024 * 6144 + c0 + col;
    float acc[9];
#pragma unroll
    for (int j = 0; j < 9; ++j) acc[j] = 0.f;
#pragma unroll 8
    for (int k = kq * 128; k < kq * 128 + 128; ++k) {
      float wv = w[(size_t)k * 6144];
#pragma unroll
      for (int j = 0; j < 9; ++j) acc[j] += sv[j * 1024 + k] * wv;
    }
#pragma unroll
    for (int j = 0; j < 9; ++j) red[(kq * 9 + j) * 64 + col] = acc[j];
    __syncthreads();
    for (int e = tid; e < 9 * 64; e += 512) {
      int j = e >> 6, cx = e & 63;
      float s = 0.f;
#pragma unroll
      for (int q = 0; q < 8; ++q) s += red[(q * 9 + j) * 64 + cx];
      s += mod_b[layer * 6144 + c0 + cx];
      mod[(layer * 9 + j) * 6144 + c0 + cx] = s;
    }
    __syncthreads();
  }
}

__device__ __forceinline__ void prep_rows(const Params& p, int layer, int which, int nrows, bool from_input, const int tid) {
  const float* gam = (which == 0 ? p.in[4] : p.in[5]) + layer * 1024;
  const float* mod = (const float*)(p.ws + OFF_MOD);
  float* ctxres = (float*)(p.ws + OFF_CTXRES);
  u16* H = (u16*)(p.ws);
  int lane = tid & 63, wv = tid >> 6;
  for (int row = blockIdx.x * 8 + wv; row < nrows; row += gridDim.x * 8) {
    const float* src;
    float* dst;
    if (row < TL) { src = (from_input ? p.in[0] : p.out) + (size_t)row * 1024; dst = p.out + (size_t)row * 1024; }
    else { src = (from_input ? p.in[2] : ctxres) + (size_t)(row - TL) * 1024; dst = ctxres + (size_t)(row - TL) * 1024; }
    float4 x[4];
    float ss = 0.f;
#pragma unroll
    for (int q = 0; q < 4; ++q) {
      x[q] = *(const float4*)(src + q * 256 + lane * 4);
      ss += x[q].x * x[q].x + x[q].y * x[q].y + x[q].z * x[q].z + x[q].w * x[q].w;
    }
    ss = wave_sum(ss);
    float rstd = rsqrtf(ss * (1.f / 1024.f) + 1e-6f);
    int j = (row < TL) ? (row >> 12) : 8;
    const float* mp = mod + (size_t)(layer * 9 + j) * 6144 + which * 3072;
#pragma unroll
    for (int q = 0; q < 4; ++q) {
      int col = q * 256 + lane * 4;
      if (from_input) *(float4*)(dst + col) = x[q];
      float4 g = *(const float4*)(gam + col);
      float4 sh = *(const float4*)(mp + col);
      float4 sc = *(const float4*)(mp + 1024 + col);
      float h0 = x[q].x * rstd * g.x * (1.f + sc.x) + sh.x;
      float h1 = x[q].y * rstd * g.y * (1.f + sc.y) + sh.y;
      float h2 = x[q].z * rstd * g.z * (1.f + sc.z) + sh.z;
      float h3 = x[q].w * rstd * g.w * (1.f + sc.w) + sh.w;
      uint2 o; o.x = pack2(h0, h1); o.y = pack2(h2, h3);
      *(uint2*)(H + (size_t)row * 1024 + col) = o;
    }
  }
}

struct CJ { const float* src; int K, N, ld; u16* dst; int ldd, Kp, Np; };
__device__ __forceinline__ void get_cj(const Params& p, int layer, int j, CJ& c) {
  const int idx = layer >> 1;
  u16* wm = (u16*)(p.ws + OFF_WMIX);
  u16* wl = (u16*)(p.ws + OFF_WMLP);
  c.K = 1024; c.N = 1024; c.ld = 1024; c.ldd = 1024; c.Kp = 1024; c.Np = 1024; c.src = nullptr; c.dst = nullptr;
  if (j == 0) { c.src = p.in[8] + (size_t)layer * 4 * M1; c.N = 4096; c.ld = 4096; c.dst = wl; c.Np = 4096; }
  else if (j == 1) { c.src = p.in[9] + (size_t)layer * 4 * M1; c.K = 4096; c.dst = wl + 4 * M1; c.ldd = 4096; c.Kp = 4096; }
  else if (layer & 1) { c.src = p.in[31] + (size_t)idx * M1; c.dst = wm; }
  else if (j < 6) { c.src = p.in[11 + (j - 2)] + (size_t)idx * M1; c.dst = wm + (size_t)(j - 2) * M1; }
  else if (j < 10) {
    int d = j & 1; bool isa = j >= 8;
    c.src = p.in[isa ? 19 : 16] + (size_t)(idx * 2 + d) * 65536; c.N = 64; c.ld = 64; c.Np = 64;
    c.dst = wm + 4 * M1 + (isa ? 131072 : 0) + d * 65536;
  }
  else if (j == 10) { c.src = p.in[24] + (size_t)idx * 131072; c.N = 128; c.ld = 128; c.Np = 128; c.dst = wm + 4 * M1 + 2 * 131072; }
  else if (j == 11) { c.src = p.in[25] + (size_t)idx * 131072; c.K = 128; c.Kp = 128; c.ldd = 128; c.dst = wm + 4 * M1 + 4 * 131072; }
  else if (j == 12) { c.src = p.in[22]; c.N = 32; c.ld = 32; c.Np = 128; c.dst = wm + 4 * M1 + 3 * 131072; }
  else { c.src = p.in[23]; c.K = 32; c.Kp = 64; c.ldd = 64; c.dst = wm + 4 * M1 + 5 * 131072; }
}

__device__ __forceinline__ void convert_weights(const Params& p, char* smem, int layer, const int tid) {
  float* tile = (float*)smem;
  const int nj = (layer & 1) ? 3 : ((layer >> 1) == 1 ? 14 : 12);
  int rot = 0;
  for (int j = 0; j < nj; ++j) {
    CJ c; get_cj(p, layer, j, c);
    const int nnt = c.Np >> 6, ntiles = (c.Kp >> 6) * nnt;
    int start = (int)blockIdx.x - rot; if (start < 0) start += gridDim.x;
    for (int t = start; t < ntiles; t += gridDim.x) {
      int k0 = (t / nnt) << 6, n0 = (t % nnt) << 6;
      int r = tid >> 4, c4 = (tid & 15) * 4;
#pragma unroll
      for (int hh = 0; hh < 2; ++hh) {
        int rr = r + hh * 32;
        float4 v = make_float4(0.f, 0.f, 0.f, 0.f);
        if (k0 + rr < c.K && n0 + c4 < c.N) v = *(const float4*)(c.src + (size_t)(k0 + rr) * c.ld + n0 + c4);
        tile[(c4 + 0) * 65 + rr] = v.x; tile[(c4 + 1) * 65 + rr] = v.y; tile[(c4 + 2) * 65 + rr] = v.z; tile[(c4 + 3) * 65 + rr] = v.w;
      }
      __syncthreads();
      int n = tid >> 3, kc = (tid & 7) * 8;
      const float* tp = tile + n * 65 + kc;
      uint4 o;
      o.x = pack2(tp[0], tp[1]); o.y = pack2(tp[2], tp[3]); o.z = pack2(tp[4], tp[5]); o.w = pack2(tp[6], tp[7]);
      *(uint4*)(c.dst + (size_t)(n0 + n) * c.ldd + k0 + kc) = o;
      __syncthreads();
    }
    rot = (rot + ntiles) % (int)gridDim.x;
  }
}

__device__ __forceinline__ void fourier_tables(const Params& p, bool with_ctx, const int tid) {
  u16* wm = (u16*)(p.ws + OFF_WMIX);
  u16* dftT = wm + M1;
  u16* dftL = (u16*)(p.ws + 4 * SLOT);
  u16* dftC = dftL + (size_t)4096 * 8192;
  size_t gtid = (size_t)blockIdx.x * 512 + tid, gsz = (size_t)gridDim.x * 512;
  for (size_t e = gtid; e < 512 * 256 / 8; e += gsz) {
    int r = (int)(e >> 5), c0 = (int)(e & 31) * 8;
    int ri = r >> 8, m = r & 255;
    float v[8];
#pragma unroll
    for (int q = 0; q < 8; ++q) {
      int ph = (m * (c0 + q)) & 255;
      float s, c; sincospif((float)ph * (1.f / 128.f), &s, &c);
      v[q] = (ri ? s : c) * (1.f / 16.f);
    }
    uint4 o; o.x = pack2(v[0], v[1]); o.y = pack2(v[2], v[3]); o.z = pack2(v[4], v[5]); o.w = pack2(v[6], v[7]);
    *(uint4*)(dftT + (size_t)r * 256 + c0) = o;
  }
  for (size_t e = gtid; e < (size_t)4096 * 8192 / 8; e += gsz) {
    int k = (int)(e >> 10), kap = (int)(e & 1023) * 8;
    int ri = kap >> 12, l0 = kap & 4095;
    float v[8];
#pragma unroll
    for (int q = 0; q < 8; ++q) {
      int ph = (k * (l0 + q)) & 4095;
      float s, c; sincospif((float)ph * (1.f / 2048.f), &s, &c);
      v[q] = (ri ? -s : c) * (1.f / 64.f);
    }
    uint4 o; o.x = pack2(v[0], v[1]); o.y = pack2(v[2], v[3]); o.z = pack2(v[4], v[5]); o.w = pack2(v[6], v[7]);
    *(uint4*)(dftL + (size_t)k * 8192 + kap) = o;
  }
  if (with_ctx) {
    for (size_t e = gtid; e < 256 * 512 / 8; e += gsz) {
      int k = (int)(e >> 6), kap = (int)(e & 63) * 8;
      int ri = kap >> 8, l0 = kap & 255;
      float v[8];
#pragma unroll
      for (int q = 0; q < 8; ++q) {
        int ph = (k * (l0 + q)) & 255;
        float s, c; sincospif((float)ph * (1.f / 128.f), &s, &c);
        v[q] = (ri ? -s : c) * (1.f / 16.f);
      }
      uint4 o; o.x = pack2(v[0], v[1]); o.y = pack2(v[2], v[3]); o.z = pack2(v[4], v[5]); o.w = pack2(v[6], v[7]);
      *(uint4*)(dftC + (size_t)k * 512 + kap) = o;
    }
  }
}

struct GD {
  const u16* A; long lda; int a_rowmask; int a_mode; const float* mu;
  const u16* B; long b_rs_hi, b_rs_lo; int b_kshift; long b_kstride;
  int K, m0, n0;
  int ep; u16* out; long ldo; u16* out2; const float* e0; const u16* gsrc;
};
__device__ __forceinline__ void gd_plainA(GD& g, const u16* A, long lda) { g.A = A; g.lda = lda; g.a_rowmask = 0x7fffffff; g.a_mode = 0; g.mu = nullptr; }
__device__ __forceinline__ void gd_mixA(GD& g, const u16* H, const float* mu) { g.A = H; g.lda = 1024; g.a_rowmask = 0x7fffffff; g.a_mode = 1; g.mu = mu; }
__device__ __forceinline__ void gd_plainB(GD& g, const u16* B, long ldb) { g.B = B; g.b_rs_hi = 256 * ldb; g.b_rs_lo = ldb; g.b_kshift = 30; g.b_kstride = 0; }

__device__ __forceinline__ unsigned mix2(unsigned h, unsigned s, float m0, float m1) {
  float h0 = bflo(h), h1 = bfhi(h), s0 = bflo(s), s1 = bfhi(s);
  return pack2(h0 + (s0 - h0) * m0, h1 + (s1 - h1) * m1);
}

#define EPI_LOOP(LD, BODY) \
  _Pragma("unroll") for (int i = 0; i < 2; ++i) { _Pragma("unroll") for (int j = 0; j < 2; ++j) { \
    _Pragma("unroll") for (int r = 0; r < 16; ++r) { \
      const int off = (32 * i + (r & 3) + 8 * (r >> 2)) * (LD) + 32 * j; \
      const float v = acc[i][j][r]; BODY } \
    asm volatile("" ::: "memory"); } }

struct Stage { uint4 a0, a1, a2, a3, s0, s1, s2, s3, b0, b1; float4 mu0, mu1; };

__device__ __forceinline__ int mix_nb(int t, int k) {
  int nb = -1;
  if (t < TL) {
    int l = t & 4095, c = l & 63, r = l >> 6, qq = k >> 8;
    if (qq == 0) nb = (c > 0) ? t - 1 : -1;
    else if (qq == 1) nb = (c < 63) ? t + 1 : -1;
    else if (qq == 2) nb = (r > 0) ? t - 64 : -1;
    else nb = (r < 63) ? t + 64 : -1;
  } else {
    int pp = (t - TL) & 255;
    if (k < 512) nb = (pp > 0) ? t - 1 : -1; else nb = (pp < 255) ? t + 1 : -1;
  }
  return nb;
}
__device__ __forceinline__ uint4 ld16(const u16* ptr) { return *(const uint4*)ptr; }
__device__ __forceinline__ uint4 mix4(uint4 h, uint4 s, float4 m0, float4 m1) {
  uint4 o;
  o.x = mix2(h.x, s.x, m0.x, m0.y); o.y = mix2(h.y, s.y, m0.z, m0.w);
  o.z = mix2(h.z, s.z, m1.x, m1.y); o.w = mix2(h.w, s.w, m1.z, m1.w);
  return o;
}

__device__ __forceinline__ void gemm_tile(const Params& p, char* smem, const GD& g, const int tid) {
  u16* As = (u16*)smem;
  u16* Bs = As + 2 * 256 * 72;
  const int lane = tid & 63, w = tid >> 6, wm = w >> 1, wn = w & 1;
  const int lr = tid >> 3, lc = (tid & 7) * 8;
  f32x16 acc[2][2];
#pragma unroll
  for (int i = 0; i < 2; ++i)
#pragma unroll
    for (int j = 0; j < 2; ++j)
#pragma unroll
      for (int r = 0; r < 16; ++r) acc[i][j][r] = 0.f;
  Stage st;
  st.s0 = st.s1 = st.s2 = st.s3 = make_uint4(0, 0, 0, 0);
  st.mu0 = st.mu1 = make_float4(0.f, 0.f, 0.f, 0.f);
  const int nk = g.K >> 6;
  const int kmask = (1 << g.b_kshift) - 1;
  const int n_0 = g.n0 + lr, n_1 = g.n0 + lr + 64;
  const u16* bp0 = g.B + (long)(n_0 >> 8) * g.b_rs_hi + (long)(n_0 & 255) * g.b_rs_lo;
  const u16* bp1 = g.B + (long)(n_1 >> 8) * g.b_rs_hi + (long)(n_1 & 255) * g.b_rs_lo;
  const int t0 = g.m0 + lr;
  const u16* ap0 = g.A + (long)((t0) & g.a_rowmask) * g.lda;
  const u16* ap1 = g.A + (long)((t0 + 64) & g.a_rowmask) * g.lda;
  const u16* ap2 = g.A + (long)((t0 + 128) & g.a_rowmask) * g.lda;
  const u16* ap3 = g.A + (long)((t0 + 192) & g.a_rowmask) * g.lda;
  const int sto = lr * 72 + lc;

  for (int kt = -1; kt < nk; ++kt) {
    const int cur = kt & 1;
    if (kt + 1 < nk) {
      const int k = (kt + 1) * 64 + lc;
      st.a0 = ld16(ap0 + k); st.a1 = ld16(ap1 + k); st.a2 = ld16(ap2 + k); st.a3 = ld16(ap3 + k);
      if (g.a_mode != 0) {
        st.mu0 = *(const float4*)(g.mu + k); st.mu1 = *(const float4*)(g.mu + k + 4);
        int nb;
        nb = mix_nb(t0, k);       st.s0 = make_uint4(0, 0, 0, 0); if (nb >= 0) st.s0 = ld16(g.A + (long)nb * 1024 + k);
        nb = mix_nb(t0 + 64, k);  st.s1 = make_uint4(0, 0, 0, 0); if (nb >= 0) st.s1 = ld16(g.A + (long)nb * 1024 + k);
        nb = mix_nb(t0 + 128, k); st.s2 = make_uint4(0, 0, 0, 0); if (nb >= 0) st.s2 = ld16(g.A + (long)nb * 1024 + k);
        nb = mix_nb(t0 + 192, k); st.s3 = make_uint4(0, 0, 0, 0); if (nb >= 0) st.s3 = ld16(g.A + (long)nb * 1024 + k);
      }
      const long ko = (long)(k >> g.b_kshift) * g.b_kstride + (k & kmask);
      st.b0 = ld16(bp0 + ko); st.b1 = ld16(bp1 + ko);
    }
    if (kt >= 0) {
      const u16* ab = As + cur * 256 * 72 + (64 * wm + (lane & 31)) * 72 + 8 * (lane >> 5);
      const u16* bb = Bs + cur * 128 * 72 + (64 * wn + (lane & 31)) * 72 + 8 * (lane >> 5);
#pragma unroll
      for (int k16 = 0; k16 < 4; ++k16) {
        bf16x8 a0 = *(const bf16x8*)(ab + k16 * 16);
        bf16x8 a1 = *(const bf16x8*)(ab + 32 * 72 + k16 * 16);
        bf16x8 b0 = *(const bf16x8*)(bb + k16 * 16);
        bf16x8 b1 = *(const bf16x8*)(bb + 32 * 72 + k16 * 16);
        acc[0][0] = __builtin_amdgcn_mfma_f32_32x32x16_bf16(a0, b0, acc[0][0], 0, 0, 0);
        acc[0][1] = __builtin_amdgcn_mfma_f32_32x32x16_bf16(a0, b1, acc[0][1], 0, 0, 0);
        acc[1][0] = __builtin_amdgcn_mfma_f32_32x32x16_bf16(a1, b0, acc[1][0], 0, 0, 0);
        acc[1][1] = __builtin_amdgcn_mfma_f32_32x32x16_bf16(a1, b1, acc[1][1], 0, 0, 0);
      }
    }
    if (kt + 1 < nk) {
      if (g.a_mode != 0) {
        st.a0 = mix4(st.a0, st.s0, st.mu0, st.mu1); st.a1 = mix4(st.a1, st.s1, st.mu0, st.mu1);
        st.a2 = mix4(st.a2, st.s2, st.mu0, st.mu1); st.a3 = mix4(st.a3, st.s3, st.mu0, st.mu1);
      }
      u16* ad = As + (cur ^ 1) * 256 * 72 + sto;
      u16* bd = Bs + (cur ^ 1) * 128 * 72 + sto;
      *(uint4*)(ad) = st.a0; *(uint4*)(ad + 64 * 72) = st.a1; *(uint4*)(ad + 128 * 72) = st.a2; *(uint4*)(ad + 192 * 72) = st.a3;
      *(uint4*)(bd) = st.b0; *(uint4*)(bd + 64 * 72) = st.b1;
    }
    __syncthreads();
  }
  int te = tid;
  asm volatile("" : "+v"(te));
  const int le = te & 63, we = te >> 6;
  const int lrow0 = 64 * (we >> 1) + 4 * (le >> 5), lcol0 = 64 * (we & 1) + (le & 31);
  const int ldo = (int)g.ldo;
  switch (g.ep) {
    case 0: { u16* ob = g.out + (size_t)(g.m0 + lrow0) * g.ldo + g.n0 + lcol0; EPI_LOOP(ldo, { ob[off] = f2bf(v); }) } break;
    case 1: { u16* ob = g.out + (size_t)(g.m0 + lrow0) * g.ldo + g.n0 + lcol0; EPI_LOOP(ldo, { ob[off] = f2bf(tanhf(v)); }) } break;
    case 2: { u16* ob = g.out + (size_t)(g.m0 + lrow0) * g.ldo + g.n0 + lcol0; EPI_LOOP(ldo, { ob[off] = f2bf(sigmoidf_(v)); }) } break;
    case 3: { u16* ob = g.out + (size_t)(g.m0 + lrow0) * g.ldo + g.n0 + lcol0; EPI_LOOP(ldo, { float rr = fmaxf(v, 0.f); ob[off] = f2bf(rr * rr); }) } break;
    case 4: { u16* ob = g.out + (size_t)(g.m0 + lrow0) * 64 + g.n0 + lcol0; if (g.n0 + lcol0 < 32) { EPI_LOOP(64, { ob[off] = f2bf(v); }) } } break;
    case 5: {
      const int jb = (g.m0 < TL) ? (g.m0 >> 12) : 8;
      const float* gp = g.e0 + jb * 6144 + g.n0 + lcol0;
      const float g0 = gp[0], g1 = gp[32];
      float* xb = ((g.m0 < TL) ? (p.out + (size_t)g.m0 * 1024) : ((float*)(p.ws + OFF_CTXRES) + (size_t)(g.m0 - TL) * 1024)) + (size_t)lrow0 * 1024 + g.n0 + lcol0;
      EPI_LOOP(1024, { float* xp = xb + off; *xp = *xp + (j ? g1 : g0) * v; })
    } break;
    case 6: { u16* ob = g.out + (size_t)(g.m0 + lrow0) * g.ldo + g.n0 + lcol0; const float* bp = g.e0 + g.n0 + lcol0; const float c0 = bp[0], c1 = bp[32];
      EPI_LOOP(ldo, { ob[off] = f2bf(sigmoidf_((j ? c1 : c0) + v)); }) } break;
    case 7: {
      u16* ob = g.out + (size_t)(g.m0 + lrow0) * 1024 + g.n0 + lcol0; const u16* gs = g.gsrc + (size_t)(g.m0 + lrow0) * 1024 + g.n0 + lcol0;
      EPI_LOOP(1024, { float vf = bf2f(ob[off]); float gt = bf2f(gs[off]); ob[off] = f2bf(v + (vf - v) * gt); })
    } break;
    case 8: {
      u16* ob; int ld;
      if (g.n0 < TL) { ld = TL; ob = g.out + (size_t)(g.m0 + lrow0) * TL + g.n0 + lcol0; } else { ld = TC; ob = g.out2 + (size_t)(g.m0 + lrow0) * TC + (g.n0 - TL) + lcol0; }
      EPI_LOOP(ld, { ob[off] = f2bf(v); })
    } break;
    default: break;
  }
}

enum { G_RB = 0, G_RC, G_RC2, G_WO_R, G_FB, G_FC, G_WO_F, G_MLP1, G_MLP2 };

__device__ __forceinline__ int gemm_total(int kind, int layer) {
  const int idx = layer >> 1;
  const bool ctx_in = layer <= 2, ctx_out = layer < 2;
  const int mt_out = (ctx_out ? T : TL) >> 8;
  switch (kind) {
    case G_RB: return 136 * ((idx == 0) ? 27 : 20);
    case G_RC: return 136 * ((idx == 0) ? 8 : 16);
    case G_RC2: return 136 * 8;
    case G_WO_R: return mt_out * 8;
    case G_FB: return 8 * (ctx_in ? 272 : 256);
    case G_FC: return 1024 + (ctx_in ? 64 : 0);
    case G_WO_F: return mt_out * 8;
    case G_MLP1: return mt_out * 32;
    default: return mt_out * 8;
  }
}

__device__ __forceinline__ void make_gd(const Params& p, int kind, int layer, int tile, GD& g) {
  const int idx = layer >> 1;
  const u16* H = (const u16*)p.ws;
  const u16* wm = (const u16*)(p.ws + OFF_WMIX);
  const float* mu = p.in[10] + (size_t)idx * 6 * 1024;
  const float* mod = (const float*)(p.ws + OFF_MOD) + (size_t)layer * 9 * 6144;
  g.out = nullptr; g.out2 = nullptr; g.e0 = nullptr; g.gsrc = nullptr; g.ldo = 1024; g.ep = 0; g.K = 1024;
  switch (kind) {
    case G_RB: {
      const int CT = (idx == 0) ? 27 : 20;
      int tm = tile / CT, ct = tile % CT;
      g.m0 = tm * 256;
      int nv = (idx == 0) ? 8 : 0;
      if (ct < 8) { gd_mixA(g, H, mu + 0 * 1024); gd_plainB(g, wm + 0 * M1, 1024); g.n0 = ct * 128; g.out = (u16*)(p.ws + 1 * SLOT); }
      else if (ct < 16) { gd_mixA(g, H, mu + 2 * 1024); gd_plainB(g, wm + 1 * M1, 1024); g.n0 = (ct - 8) * 128; g.out = (u16*)(p.ws + 2 * SLOT); }
      else if (ct < 16 + nv) { gd_mixA(g, H, mu + 3 * 1024); gd_plainB(g, wm + 2 * M1, 1024); g.n0 = (ct - 16) * 128; g.out = (u16*)(p.ws + 5 * SLOT); }
      else {
        int q = ct - 16 - nv; g.n0 = 0;
        if (q == 0) { gd_mixA(g, H, mu + 1 * 1024); gd_plainB(g, wm + 4 * M1, 1024); g.ep = 1; g.out = (u16*)(p.ws + OFF_HW); g.ldo = 128; }
        else if (q == 1) { gd_mixA(g, H, mu + 4 * 1024); gd_plainB(g, wm + 4 * M1 + 131072, 1024); g.ep = 0; g.out = (u16*)(p.ws + OFF_HA); g.ldo = 128; }
        else if (q == 2) { gd_mixA(g, H, mu + 5 * 1024); gd_plainB(g, wm + 4 * M1 + 2 * 131072, 1024); g.ep = 2; g.out = (u16*)(p.ws + OFF_HG); g.ldo = 128; }
        else { gd_mixA(g, H, mu + 3 * 1024); gd_plainB(g, wm + 4 * M1 + 3 * 131072, 1024); g.ep = 4; g.out = (u16*)(p.ws + OFF_HV); g.ldo = 64; }
      }
    } break;
    case G_RC: {
      const int CT = (idx == 0) ? 8 : 16;
      int tm = tile / CT, ct = tile % CT;
      g.m0 = tm * 256;
      if (ct < 8) { gd_plainA(g, (const u16*)(p.ws + OFF_HG), 128); gd_plainB(g, wm + 4 * M1 + 4 * 131072, 128); g.K = 128; g.n0 = ct * 128; g.out = (u16*)(p.ws + 4 * SLOT); }
      else { gd_plainA(g, (const u16*)(p.ws + OFF_HV), 64); gd_plainB(g, wm + 4 * M1 + 5 * 131072, 64); g.K = 64; g.n0 = (ct - 8) * 128; g.ep = 6; g.e0 = p.in[21]; g.out = (u16*)(p.ws + 3 * SLOT); }
    } break;
    case G_RC2: {
      int tm = tile >> 3, ct = tile & 7;
      g.m0 = tm * 256; g.n0 = ct * 128;
      gd_mixA(g, H, mu + 3 * 1024); gd_plainB(g, wm + 2 * M1, 1024);
      g.ep = 7; g.out = (u16*)(p.ws + 5 * SLOT); g.gsrc = (const u16*)(p.ws + 3 * SLOT);
    } break;
    case G_WO_R: {
      int tm = tile >> 3, ct = tile & 7;
      g.m0 = tm * 256; g.n0 = ct * 128;
      gd_plainA(g, H, 1024); gd_plainB(g, wm + 3 * M1, 1024);
      g.ep = 5; g.e0 = mod + 2048;
    } break;
    case G_FB: {
      int tn = tile >> 3, tm = tile & 7;
      g.K = 256; g.m0 = tm * 256; g.n0 = tn * 128;
      gd_plainA(g, wm + M1, 256); g.a_rowmask = 511;
      gd_plainB(g, H + 256 * (tm >> 1), 1024);
      g.ep = 8; g.out = (u16*)(p.ws + 1 * SLOT); g.out2 = g.out + (size_t)2048 * TL;
    } break;
    case G_FC: {
      const u16* dftL = (const u16*)(p.ws + 4 * SLOT);
      const u16* dftC = dftL + (size_t)4096 * 8192;
      const u16* YT = (const u16*)(p.ws + 1 * SLOT);
      const u16* YTc = YT + (size_t)2048 * TL;
      u16* fo = (u16*)(p.ws + 3 * SLOT);
      if (tile < 1024) {
        int b = tile >> 7, tm = (tile >> 3) & 15, ct = tile & 7;
        g.K = 8192; g.m0 = tm * 256; g.n0 = ct * 128;
        gd_plainA(g, dftL, 8192);
        g.B = YT + (size_t)b * 4096; g.b_rs_hi = (long)512 * TL; g.b_rs_lo = TL; g.b_kshift = 12; g.b_kstride = (long)256 * TL;
        g.out = fo + (size_t)b * 4096 * 1024;
      } else {
        int t2 = tile - 1024; int b = t2 >> 3, ct = t2 & 7;
        g.K = 512; g.m0 = 0; g.n0 = ct * 128;
        gd_plainA(g, dftC, 512);
        g.B = YTc + (size_t)b * 256; g.b_rs_hi = (long)512 * TC; g.b_rs_lo = TC; g.b_kshift = 8; g.b_kstride = (long)256 * TC;
        g.out = fo + (size_t)(TL + b * 256) * 1024;
      }
    } break;
    case G_WO_F: {
      int tm = tile >> 3, ct = tile & 7;
      g.m0 = tm * 256; g.n0 = ct * 128;
      gd_plainA(g, (const u16*)(p.ws + 3 * SLOT), 1024); gd_plainB(g, wm, 1024);
      g.ep = 5; g.e0 = mod + 2048;
    } break;
    case G_MLP1: {
      int tm = tile >> 5, ct = tile & 31;
      g.m0 = tm * 256; g.n0 = ct * 128;
      gd_plainA(g, H, 1024); gd_plainB(g, (const u16*)(p.ws + OFF_WMLP), 1024);
      g.ep = 3; g.out = (u16*)(p.ws + 1 * SLOT); g.ldo = 4096;
    } break;
    default: {
      int tm = tile >> 3, ct = tile & 7;
      g.K = 4096; g.m0 = tm * 256; g.n0 = ct * 128;
      gd_plainA(g, (const u16*)(p.ws + 1 * SLOT), 4096); gd_plainB(g, (const u16*)(p.ws + OFF_WMLP) + 4 * M1, 4096);
      g.ep = 5; g.e0 = mod + 5 * 1024;
    } break;
  }
}

#define FMAC_DPP(acc, bsrc, x, j) asm("v_fmac_f32_dpp %0, %1, %2 row_newbcast:" #j " row_mask:0xf bank_mask:0xf" : "+v"(acc) : "v"(bsrc), "v"(x))
#define MUL_DPP(dst, bsrc, x, j) asm("v_mul_f32_dpp %0, %1, %2 row_newbcast:" #j " row_mask:0xf bank_mask:0xf" : "=v"(dst) : "v"(bsrc), "v"(x))
#define SA_J(acc, j) FMAC_DPP(acc, A, S[j], j);
#define UP_J(j) MUL_DPP(S[j], W, S[j], j); FMAC_DPP(S[j], Bv, sa, j); FMAC_DPP(S[j], KD, VV, j);
#define Y_J(acc, j) FMAC_DPP(acc, R, S[j], j);

__device__ __forceinline__ int scan_row(int gstep, int b, int d) {
  if (gstep < 256) { int pp = d ? 255 - gstep : gstep; return TL + b * 256 + pp; }
  int l = gstep - 256; if (d) l = 4095 - l;
  return b * 4096 + l;
}

__device__ __forceinline__ void phase_scan(const Params& p, char* smem, int idx, bool ctx_y, const int tid) {
  if (blockIdx.x >= 256) return;
  const int item = blockIdx.x;
  const int d = item & 1, h = (item >> 1) & 15, b = item >> 5;
  float* buf = (float*)smem;
  float* ybuf = buf + 2 * 32 * 384;
  const int lane = tid & 63, w = tid >> 6;
  const u16* rbuf = (const u16*)(p.ws + 1 * SLOT);
  const u16* kbuf = (const u16*)(p.ws + 2 * SLOT);
  const u16* vbuf = (const u16*)(p.ws + 5 * SLOT);
  u16* ybase = (u16*)(p.ws + (d == 0 ? 0 : 3 * SLOT));
  const u16* hw = (const u16*)(p.ws + OFF_HW);
  const u16* ha = (const u16*)(p.ws + OFF_HA);
  float* bsum = (float*)(p.ws + OFF_BSUM);
  const int ch = h * 64;

  uint4* Bl = (uint4*)(ybuf + 2 * 2048);
  float w0v[4], a0v[4];
  float kkw = 0.f, kaw = 0.f, rkw = 0.f;
#pragma unroll
  for (int cb = 0; cb < 4; ++cb) { w0v[cb] = 0.f; a0v[cb] = 0.f; }
  if (w >= 4) {
    const float* w2 = p.in[17] + (size_t)(idx * 2 + d) * 64 * 1024;
    const float* a2 = p.in[20] + (size_t)(idx * 2 + d) * 64 * 1024;
#pragma unroll
    for (int cb = 0; cb < 4; ++cb) {
      int col = ch + 16 * cb + (lane & 15);
      w0v[cb] = p.in[15][(idx * 2 + d) * 1024 + col];
      a0v[cb] = p.in[18][(idx * 2 + d) * 1024 + col];
    }
    {
      const int cb = w - 4;
      const int col = ch + 16 * cb + (lane & 15);
#pragma unroll
      for (int i = 0; i < 2; ++i) {
        const int k0 = 32 * i + 8 * (lane >> 4);
        float fw[8], fa[8];
#pragma unroll
        for (int q = 0; q < 8; ++q) { fw[q] = w2[(size_t)(k0 + q) * 1024 + col]; fa[q] = a2[(size_t)(k0 + q) * 1024 + col]; }
        Bl[((0 * 4 + cb) * 2 + i) * 64 + lane] = make_uint4(pack2(fw[0], fw[1]), pack2(fw[2], fw[3]), pack2(fw[4], fw[5]), pack2(fw[6], fw[7]));
        Bl[((1 * 4 + cb) * 2 + i) * 64 + lane] = make_uint4(pack2(fa[0], fa[1]), pack2(fa[2], fa[3]), pack2(fa[4], fa[5]), pack2(fa[6], fa[7]));
      }
    }
    kkw = p.in[26][idx * 1024 + ch + lane];
    kaw = p.in[27][idx * 1024 + ch + lane];
    rkw = p.in[28][idx * 1024 + ch + lane];
  }
  __syncthreads();
  float S[16];
#pragma unroll
  for (int j = 0; j < 16; ++j) S[j] = 0.f;

  for (int it = 0; it <= 137; ++it) {
    if (w >= 4) {
      const int jw = w - 4;
      if (it >= 2) {
        int cy = it - 2;
        const float* yb = ybuf + (cy & 1) * 2048;
        if (cy >= 8 || ctx_y) {
#pragma unroll
          for (int s8 = 0; s8 < 8; ++s8) {
            int s = jw * 8 + s8;
            int row = scan_row(cy * 32 + s, b, d);
            ybase[(size_t)row * 1024 + ch + lane] = f2bf(yb[s * 64 + lane]);
          }
        }
      }
      if (it < 136) {
        float* bp = buf + (it & 1) * 12288;
        const int s0 = jw * 8;
        int rowm = scan_row(it * 32 + s0 + (lane & 7), b, d);
        bf16x8 Aw0 = *(const bf16x8*)(hw + (size_t)rowm * 128 + d * 64 + 8 * (lane >> 4));
        bf16x8 Aw1 = *(const bf16x8*)(hw + (size_t)rowm * 128 + d * 64 + 32 + 8 * (lane >> 4));
        bf16x8 Aa0 = *(const bf16x8*)(ha + (size_t)rowm * 128 + d * 64 + 8 * (lane >> 4));
        bf16x8 Aa1 = *(const bf16x8*)(ha + (size_t)rowm * 128 + d * 64 + 32 + 8 * (lane >> 4));
        float kx[8], rx[8], vx[8];
#pragma unroll
        for (int s8 = 0; s8 < 8; ++s8) {
          int row = scan_row(it * 32 + s0 + s8, b, d);
          size_t o = (size_t)row * 1024 + ch + lane;
          kx[s8] = bf2f(kbuf[o]); rx[s8] = bf2f(rbuf[o]); vx[s8] = bf2f(vbuf[o]);
        }
#pragma unroll
        for (int cb = 0; cb < 4; ++cb) {
          f32x4 cw = {0.f, 0.f, 0.f, 0.f}, ca = {0.f, 0.f, 0.f, 0.f};
          const bf16x8 bw0 = __builtin_bit_cast(bf16x8, Bl[((0 * 4 + cb) * 2 + 0) * 64 + lane]);
          const bf16x8 bw1 = __builtin_bit_cast(bf16x8, Bl[((0 * 4 + cb) * 2 + 1) * 64 + lane]);
          const bf16x8 ba0 = __builtin_bit_cast(bf16x8, Bl[((1 * 4 + cb) * 2 + 0) * 64 + lane]);
          const bf16x8 ba1 = __builtin_bit_cast(bf16x8, Bl[((1 * 4 + cb) * 2 + 1) * 64 + lane]);
          cw = __builtin_amdgcn_mfma_f32_16x16x32_bf16(Aw0, bw0, cw, 0, 0, 0);
          cw = __builtin_amdgcn_mfma_f32_16x16x32_bf16(Aw1, bw1, cw, 0, 0, 0);
          ca = __builtin_amdgcn_mfma_f32_16x16x32_bf16(Aa0, ba0, ca, 0, 0, 0);
          ca = __builtin_amdgcn_mfma_f32_16x16x32_bf16(Aa1, ba1, ca, 0, 0, 0);
          if (lane < 32) {
#pragma unroll
            for (int r = 0; r < 4; ++r) {
              int m = 4 * (lane >> 4) + r;
              float xw = cw[r] + w0v[cb];
              float dec = __expf(-0.60653066f * sigmoidf_(xw));
              float ic = sigmoidf_(ca[r] + a0v[cb]);
              bp[(s0 + m) * 384 + 0 * 64 + 16 * cb + (lane & 15)] = dec;
              bp[(s0 + m) * 384 + 1 * 64 + 16 * cb + (lane & 15)] = ic;
            }
          }
        }
#pragma unroll
        for (int s8 = 0; s8 < 8; ++s8) {
          int s = s0 + s8;
          int row = scan_row(it * 32 + s, b, d);
          float ic = bp[s * 384 + 64 + lane];
          float kkr = kx[s8] * kkw;
          float ss = wave_sum(kkr * kkr);
          float kk = kkr * rsqrtf(fmaxf(ss, 1e-24f));
          float kd = kx[s8] * (1.f + (ic - 1.f) * kaw);
          float bs = wave_sum(rx[s8] * kd * rkw);
          if (lane == 0) bsum[(size_t)row * 32 + h * 2 + d] = bs;
          bp[s * 384 + 64 + lane] = -kk;
          bp[s * 384 + 128 + lane] = kk * ic;
          bp[s * 384 + 192 + lane] = kd;
          bp[s * 384 + 256 + lane] = rx[s8];
          bp[s * 384 + 320 + lane] = vx[s8];
        }
      }
    } else {
      if (it >= 1 && it <= 136) {
        const float* bp = buf + ((it - 1) & 1) * 12288;
        float* yb = ybuf + ((it - 1) & 1) * 2048;
        const int vo = 320 + 16 * w + (lane & 15);
        float W = bp[lane], A = bp[64 + lane], Bv = bp[128 + lane], KD = bp[192 + lane], R = bp[256 + lane], VV = bp[vo];
#pragma unroll 1
        for (int s = 0; s < 32; ++s) {
          const int sn = (s < 31) ? s + 1 : 31;
          const float* np = bp + sn * 384;
          float Wn = np[lane], An = np[64 + lane], Bn = np[128 + lane], KDn = np[192 + lane], Rn = np[256 + lane], VVn = np[vo];
          float sa0 = 0.f, sa1 = 0.f;
          asm volatile("s_nop 1" : "+v"(A), "+v"(W), "+v"(Bv), "+v"(KD), "+v"(R));
          SA_J(sa0, 0) SA_J(sa1, 1) SA_J(sa0, 2) SA_J(sa1, 3) SA_J(sa0, 4) SA_J(sa1, 5) SA_J(sa0, 6) SA_J(sa1, 7)
          SA_J(sa0, 8) SA_J(sa1, 9) SA_J(sa0, 10) SA_J(sa1, 11) SA_J(sa0, 12) SA_J(sa1, 13) SA_J(sa0, 14) SA_J(sa1, 15)
          float sa = xrow_sum(sa0 + sa1);
          UP_J(0) UP_J(1) UP_J(2) UP_J(3) UP_J(4) UP_J(5) UP_J(6) UP_J(7)
          UP_J(8) UP_J(9) UP_J(10) UP_J(11) UP_J(12) UP_J(13) UP_J(14) UP_J(15)
          float y0 = 0.f, y1 = 0.f;
          Y_J(y0, 0) Y_J(y1, 1) Y_J(y0, 2) Y_J(y1, 3) Y_J(y0, 4) Y_J(y1, 5) Y_J(y0, 6) Y_J(y1, 7)
          Y_J(y0, 8) Y_J(y1, 9) Y_J(y0, 10) Y_J(y1, 11) Y_J(y0, 12) Y_J(y1, 13) Y_J(y0, 14) Y_J(y1, 15)
          float y = xrow_sum(y0 + y1);
          if (lane < 16) yb[s * 64 + 16 * w + lane] = y;
          W = Wn; A = An; Bv = Bn; KD = KDn; R = Rn; VV = VVn;
        }
      }
    }
    __syncthreads();
  }
}

__device__ __forceinline__ void phase_readout(const Params& p, int idx, int nrows, const int tid) {
  u16* y0 = (u16*)(p.ws);
  const u16* y1 = (const u16*)(p.ws + 3 * SLOT);
  const u16* vb = (const u16*)(p.ws + 5 * SLOT);
  const u16* gb = (const u16*)(p.ws + 4 * SLOT);
  const float* bsum = (const float*)(p.ws + OFF_BSUM);
  const float* lw = p.in[29] + idx * 1024;
  const float* lb = p.in[30] + idx * 1024;
  int lane = tid & 63, wv = tid >> 6;
  for (int row = blockIdx.x * 8 + wv; row < nrows; row += gridDim.x * 8) {
    size_t o = (size_t)row * 1024 + lane * 16;
    uint4 a0 = *(const uint4*)(y0 + o), a1 = *(const uint4*)(y0 + o + 8);
    uint4 b0 = *(const uint4*)(y1 + o), b1 = *(const uint4*)(y1 + o + 8);
    uint4 v0 = *(const uint4*)(vb + o), v1 = *(const uint4*)(vb + o + 8);
    uint4 g0 = *(const uint4*)(gb + o), g1 = *(const uint4*)(gb + o + 8);
    unsigned ya[8] = {a0.x, a0.y, a0.z, a0.w, a1.x, a1.y, a1.z, a1.w};
    unsigned yb[8] = {b0.x, b0.y, b0.z, b0.w, b1.x, b1.y, b1.z, b1.w};
    unsigned vv[8] = {v0.x, v0.y, v0.z, v0.w, v1.x, v1.y, v1.z, v1.w};
    unsigned gg[8] = {g0.x, g0.y, g0.z, g0.w, g1.x, g1.y, g1.z, g1.w};
    float y[16];
    float sum = 0.f;
#pragma unroll
    for (int q = 0; q < 8; ++q) {
      y[2 * q] = bflo(ya[q]) + bflo(yb[q]);
      y[2 * q + 1] = bfhi(ya[q]) + bfhi(yb[q]);
      sum += y[2 * q] + y[2 * q + 1];
    }
    sum += __shfl_xor(sum, 1); sum += __shfl_xor(sum, 2);
    float mean = sum * (1.f / 64.f);
    float var = 0.f;
#pragma unroll
    for (int q = 0; q < 16; ++q) { float dd = y[q] - mean; var += dd * dd; }
    var += __shfl_xor(var, 1); var += __shfl_xor(var, 2);
    float rstd = rsqrtf(var * (1.f / 64.f) + 64e-5f);
    int hh = lane >> 2;
    float bon = bsum[(size_t)row * 32 + hh * 2] + bsum[(size_t)row * 32 + hh * 2 + 1];
    unsigned ov[8];
#pragma unroll
    for (int q = 0; q < 8; ++q) {
      int c = lane * 16 + 2 * q;
      float o0 = ((y[2 * q] - mean) * rstd * lw[c] + lb[c] + bon * bflo(vv[q])) * bflo(gg[q]);
      float o1 = ((y[2 * q + 1] - mean) * rstd * lw[c + 1] + lb[c + 1] + bon * bfhi(vv[q])) * bfhi(gg[q]);
      ov[q] = pack2(o0, o1);
    }
    *(uint4*)(y0 + o) = make_uint4(ov[0], ov[1], ov[2], ov[3]);
    *(uint4*)(y0 + o + 8) = make_uint4(ov[4], ov[5], ov[6], ov[7]);
  }
}

__device__ __forceinline__ void phase_final(const Params& p, const int tid) {
  const float* gam = p.in[32];
  int lane = tid & 63, wv = tid >> 6;
  for (int row = blockIdx.x * 8 + wv; row < TL; row += gridDim.x * 8) {
    float* src = p.out + (size_t)row * 1024;
    float4 x[4];
    float ss = 0.f;
#pragma unroll
    for (int q = 0; q < 4; ++q) {
      x[q] = *(const float4*)(src + q * 256 + lane * 4);
      ss += x[q].x * x[q].x + x[q].y * x[q].y + x[q].z * x[q].z + x[q].w * x[q].w;
    }
    ss = wave_sum(ss);
    float rstd = rsqrtf(ss * (1.f / 1024.f) + 1e-6f);
#pragma unroll
    for (int q = 0; q < 4; ++q) {
      int col = q * 256 + lane * 4;
      float4 g = *(const float4*)(gam + col);
      float4 o = make_float4(x[q].x * rstd * g.x, x[q].y * rstd * g.y, x[q].z * rstd * g.z, x[q].w * rstd * g.w);
      *(float4*)(src + col) = o;
    }
  }
}

__global__ void __launch_bounds__(512) fwd_megakernel(Params p) {
  extern __shared__ __attribute__((aligned(16))) char smem[];
  cg::grid_group grid = cg::this_grid();

  int tid0 = threadIdx.x;
  asm volatile("" : "+v"(tid0));
  phase_mod(p, smem, tid0);
  grid.sync();
  for (int ph = 0; ph < 40; ++ph) {
    const int layer = ph / 10, step = ph % 10;
    const int idx = layer >> 1;
    const bool rw = (layer & 1) == 0;
    const bool ctx_in = layer <= 2, ctx_out = layer < 2;
    const int rows_in = ctx_in ? T : TL, rows_out = ctx_out ? T : TL;
    int gk = -1;
    int tid = threadIdx.x;
    asm volatile("" : "+v"(tid));
    if (step == 0 || step == 7) {
      prep_rows(p, layer, step == 0 ? 0 : 1, step == 0 ? rows_in : rows_out, ph == 0, tid);
      if (step == 0) {
        convert_weights(p, smem, layer, tid);
        if (!rw) fourier_tables(p, ctx_in, tid);
      }
    } else if (step == 1) gk = rw ? G_RB : G_FB;
    else if (step == 2) gk = rw ? G_RC : G_FC;
    else if (step == 3) { if (!(rw && idx == 1)) continue; gk = G_RC2; }
    else if (step == 4) { if (!rw) continue; phase_scan(p, smem, idx, ctx_out, tid); }
    else if (step == 5) { if (!rw) continue; phase_readout(p, idx, rows_out, tid); }
    else if (step == 6) gk = rw ? G_WO_R : G_WO_F;
    else if (step == 8) gk = G_MLP1;
    else gk = G_MLP2;
    if (gk >= 0) {
      const int total = gemm_total(gk, layer);
      for (int tile = blockIdx.x; tile < total; tile += gridDim.x) {
        GD g;
        make_gd(p, gk, layer, tile, g);
        gemm_tile(p, smem, g, tid);
      }
    }
    grid.sync();
  }
  int tid1 = threadIdx.x;
  asm volatile("" : "+v"(tid1));
  phase_final(p, tid1);
}

extern "C" void kernel_launch(void* const* d_in, const int* in_sizes, int n_in,
                              void* d_out, int out_size, void* d_ws, size_t ws_size,
                              hipStream_t stream) {
  static int grid_blocks = 0;
  if (!grid_blocks) {
    int dev = 0, cus = 0, per_cu = 0;
    (void)hipGetDevice(&dev);
    (void)hipDeviceGetAttribute(&cus, hipDeviceAttributeMultiprocessorCount, dev);
    if (hipFuncSetAttribute((const void*)fwd_megakernel, hipFuncAttributeMaxDynamicSharedMemorySize, LDS_BYTES) != hipSuccess)
      fprintf(stderr, "hipFuncSetAttribute failed\n");
    (void)hipOccupancyMaxActiveBlocksPerMultiprocessor(&per_cu, (const void*)fwd_megakernel, 512, LDS_BYTES);
    if (per_cu < 1) { fprintf(stderr, "occupancy query returned %d\n", per_cu); per_cu = 1; }
    (void)hipGetLastError();
    grid_blocks = cus;
    if (ws_size < WS_END) fprintf(stderr, "workspace too small: %zu < %zu\n", ws_size, (size_t)WS_END);
  }
  Params p{};
  for (int i = 0; i < 33; ++i) p.in[i] = (const float*)d_in[i];
  p.out = (float*)d_out;
  p.ws = (char*)d_ws;
  void* args[] = {&p};
  hipError_t e = hipLaunchCooperativeKernel((const void*)fwd_megakernel, dim3(grid_blocks), dim3(512), args, LDS_BYTES, stream);
  if (e != hipSuccess) fprintf(stderr, "cooperative launch failed: %s (grid %d)\n", hipGetErrorString(e), grid_blocks);
}
```

```cpp
#include <hip/hip_runtime.h>
#include <hip/hip_cooperative_groups.h>
#include <cstdio>
namespace cg = cooperative_groups;

typedef unsigned short u16;
typedef __attribute__((ext_vector_type(8))) short bf16x8;
typedef __attribute__((ext_vector_type(16))) float f32x16;
typedef __attribute__((ext_vector_type(4))) float f32x4;
typedef __attribute__((ext_vector_type(2))) float f32x2;
typedef __attribute__((ext_vector_type(2))) __bf16 bf16x2v;

constexpr int TL = 8 * 4096, TC = 8 * 256, T = TL + TC;
constexpr size_t SLOT = (size_t)T * 1024 * 2;
constexpr size_t OFF_CTXRES = 6 * SLOT;
constexpr size_t OFF_MOD = OFF_CTXRES + (size_t)TC * 1024 * 4;
constexpr size_t OFF_HW = OFF_MOD + 4 * 9 * 6144 * 4;
constexpr size_t OFF_HA = OFF_HW + (size_t)T * 128 * 2;
constexpr size_t OFF_HG = OFF_HA + (size_t)T * 128 * 2;
constexpr size_t OFF_HV = OFF_HG + (size_t)T * 128 * 2;
constexpr size_t OFF_BSUM = OFF_HV + (size_t)T * 128 * 2;
constexpr size_t OFF_WMIX = OFF_BSUM + (size_t)T * 32 * 4;
constexpr size_t M1 = 1048576;
constexpr size_t WMIX_ELEMS = 4 * M1 + 6 * 131072;
constexpr size_t OFF_WMLP = OFF_WMIX + WMIX_ELEMS * 2;
constexpr size_t WS_END = OFF_WMLP + 2 * 4 * M1 * 2;
constexpr int LDS_BYTES = 131072;
#ifndef PROBE_STEPS
#define PROBE_STEPS 0
#endif
#ifndef PROBE_LAYERS
#define PROBE_LAYERS 15
#endif
constexpr size_t OFF_PROBE = WS_END;

struct Params {
  const float* in[33];
  float* out;
  char* ws;
};
struct Ctx { const float* const* in; float* out; char* ws; };

__device__ __forceinline__ unsigned pack2(float a, float b) {
  f32x2 v = {a, b};
  bf16x2v r = __builtin_convertvector(v, bf16x2v);
  return __builtin_bit_cast(unsigned, r);
}
__device__ __forceinline__ u16 f2bf(float a) { return (u16)(pack2(a, 0.f) & 0xffffu); }
__device__ __forceinline__ float bflo(unsigned u) { return __uint_as_float(u << 16); }
__device__ __forceinline__ float bfhi(unsigned u) { return __uint_as_float(u & 0xffff0000u); }
__device__ __forceinline__ float bf2f(u16 h) { return __uint_as_float(((unsigned)h) << 16); }
__device__ __forceinline__ float wave_sum(float v) {
#pragma unroll
  for (int o = 32; o > 0; o >>= 1) v += __shfl_xor(v, o);
  return v;
}
#define DPP_ROR_ADD(x, n) x += __builtin_bit_cast(float, __builtin_amdgcn_update_dpp(0, __builtin_bit_cast(int, x), 0x120 + (n), 0xf, 0xf, true))
__device__ __forceinline__ float sigmoidf_(float x) { return __builtin_amdgcn_rcpf(1.f + __expf(-x)); }
__device__ __forceinline__ float xrow_sum(float x) {
  unsigned u = __float_as_uint(x);
  auto r = __builtin_amdgcn_permlane32_swap(u, u, false, false);
  float s = __uint_as_float(r[0]) + __uint_as_float(r[1]);
  u = __float_as_uint(s);
  auto r2 = __builtin_amdgcn_permlane16_swap(u, u, false, false);
  return __uint_as_float(r2[0]) + __uint_as_float(r2[1]);
}

__device__ __forceinline__ float wave_sum_fast(float x) {
  DPP_ROR_ADD(x, 8); DPP_ROR_ADD(x, 4); DPP_ROR_ADD(x, 2); DPP_ROR_ADD(x, 1);
  return xrow_sum(x);
}

__device__ __forceinline__ void phase_mod(const Ctx& p, char* smem, const int tid) {
  float* sv = (float*)smem;
  float* red = sv + 9 * 1024;
  const float* c = p.in[1];
  const float* cc = p.in[3];
  const float* mod_w = p.in[6];
  const float* mod_b = p.in[7];
  float* mod = (float*)(p.ws + OFF_MOD);
  for (int e = tid; e < 9 * 1024; e += 512) {
    int j = e >> 10, k = e & 1023;
    float v = (j < 8) ? c[j * 1024 + k] : cc[k];
    sv[e] = v / (1.f + expf(-v));
  }
  __syncthreads();
  for (int item = blockIdx.x; item < 384; item += gridDim.x) {
    int layer = item / 96, c0 = (item % 96) * 64;
    int kq = tid >> 6, col = tid & 63;
    const float* w = mod_w + (size_t)layer * 1024 * 6144 + c0 + col;
    float acc[9];
#pragma unroll
    for (int j = 0; j < 9; ++j) acc[j] = 0.f;
#pragma unroll 8
    for (int k = kq * 128; k < kq * 128 + 128; ++k) {
      float wv = w[(size_t)k * 6144];
#pragma unroll
      for (int j = 0; j < 9; ++j) acc[j] += sv[j * 1024 + k] * wv;
    }
#pragma unroll
    for (int j = 0; j < 9; ++j) red[(kq * 9 + j) * 64 + col] = acc[j];
    __syncthreads();
    for (int e = tid; e < 9 * 64; e += 512) {
      int j = e >> 6, cx = e & 63;
      float s = 0.f;
#pragma unroll
      for (int q = 0; q < 8; ++q) s += red[(q * 9 + j) * 64 + cx];
      s += mod_b[layer * 6144 + c0 + cx];
      mod[(layer * 9 + j) * 6144 + c0 + cx] = s;
    }
    __syncthreads();
  }
}

__device__ __forceinline__ void prep_rows(const Ctx& p, int layer, int which, int nrows, bool from_input, const u16* delta, int drows, const int tid) {
  const float* gam = (which == 0 ? p.in[4] : p.in[5]) + layer * 1024;
  const float* mod = (const float*)(p.ws + OFF_MOD);
  float* ctxres = (float*)(p.ws + OFF_CTXRES);
  u16* H = (u16*)(p.ws);
  int lane = tid & 63, wv = tid >> 6;
  const int stride = gridDim.x * 8;
  for (int row0 = blockIdx.x * 8 + wv; row0 < nrows; row0 += 2 * stride) {
    float4 x[2][4];
    uint2 dv[2][4];
    const bool v1 = (row0 + stride) < nrows;
#pragma unroll
    for (int u = 0; u < 2; ++u) {
      const int row = row0 + u * stride;
      if (u == 0 || v1) {
        const float* src = (row < TL) ? ((from_input ? p.in[0] : p.out) + (size_t)row * 1024) : ((from_input ? p.in[2] : ctxres) + (size_t)(row - TL) * 1024);
        const bool upd = (delta != nullptr) && (row < drows);
#pragma unroll
        for (int q = 0; q < 4; ++q) {
          x[u][q] = *(const float4*)(src + q * 256 + lane * 4);
          dv[u][q] = make_uint2(0, 0);
          if (upd) dv[u][q] = *(const uint2*)(delta + (size_t)row * 1024 + q * 256 + lane * 4);
        }
      }
    }
#pragma unroll
    for (int u = 0; u < 2; ++u) {
      const int row = row0 + u * stride;
      if (u == 0 || v1) {
        float* dst = (row < TL) ? (p.out + (size_t)row * 1024) : (ctxres + (size_t)(row - TL) * 1024);
        const bool upd = (delta != nullptr) && (row < drows);
        float ss = 0.f;
#pragma unroll
        for (int q = 0; q < 4; ++q) {
          x[u][q].x += bflo(dv[u][q].x); x[u][q].y += bfhi(dv[u][q].x); x[u][q].z += bflo(dv[u][q].y); x[u][q].w += bfhi(dv[u][q].y);
          ss += x[u][q].x * x[u][q].x + x[u][q].y * x[u][q].y + x[u][q].z * x[u][q].z + x[u][q].w * x[u][q].w;
        }
        ss = wave_sum(ss);
        float rstd = rsqrtf(ss * (1.f / 1024.f) + 1e-6f);
        int j = (row < TL) ? (row >> 12) : 8;
        const float* mp = mod + (size_t)(layer * 9 + j) * 6144 + which * 3072;
#pragma unroll
        for (int q = 0; q < 4; ++q) {
          int col = q * 256 + lane * 4;
          if (from_input || upd) *(float4*)(dst + col) = x[u][q];
          float4 g = *(const float4*)(gam + col);
          float4 sh = *(const float4*)(mp + col);
          float4 sc = *(const float4*)(mp + 1024 + col);
          float h0 = x[u][q].x * rstd * g.x * (1.f + sc.x) + sh.x;
          float h1 = x[u][q].y * rstd * g.y * (1.f + sc.y) + sh.y;
          float h2 = x[u][q].z * rstd * g.z * (1.f + sc.z) + sh.z;
          float h3 = x[u][q].w * rstd * g.w * (1.f + sc.w) + sh.w;
          uint2 o; o.x = pack2(h0, h1); o.y = pack2(h2, h3);
          *(uint2*)(H + (size_t)row * 1024 + col) = o;
        }
      }
    }
  }
}

struct CJ { const float* src; int K, N, ld; u16* dst; int ldd, Kp, Np; };
__device__ __forceinline__ void get_cj(const Ctx& p, int layer, int j, CJ& c) {
  const int idx = layer >> 1;
  u16* wm = (u16*)(p.ws + OFF_WMIX);
  u16* wl = (u16*)(p.ws + OFF_WMLP);
  c.K = 1024; c.N = 1024; c.ld = 1024; c.ldd = 1024; c.Kp = 1024; c.Np = 1024; c.src = nullptr; c.dst = nullptr;
  if (j == 0) { c.src = p.in[8] + (size_t)layer * 4 * M1; c.N = 4096; c.ld = 4096; c.dst = wl; c.Np = 4096; }
  else if (j == 1) { c.src = p.in[9] + (size_t)layer * 4 * M1; c.K = 4096; c.dst = wl + 4 * M1; c.ldd = 4096; c.Kp = 4096; }
  else if (layer & 1) { c.src = p.in[31] + (size_t)idx * M1; c.dst = wm; }
  else if (j < 6) { c.src = p.in[11 + (j - 2)] + (size_t)idx * M1; c.dst = wm + (size_t)(j - 2) * M1; }
  else if (j < 10) {
    int d = j & 1; bool isa = j >= 8;
    c.src = p.in[isa ? 19 : 16] + (size_t)(idx * 2 + d) * 65536; c.N = 64; c.ld = 64; c.Np = 64;
    c.dst = wm + 4 * M1 + (isa ? 131072 : 0) + d * 65536;
  }
  else if (j == 10) { c.src = p.in[24] + (size_t)idx * 131072; c.N = 128; c.ld = 128; c.Np = 128; c.dst = wm + 4 * M1 + 2 * 131072; }
  else if (j == 11) { c.src = p.in[25] + (size_t)idx * 131072; c.K = 128; c.Kp = 128; c.ldd = 128; c.dst = wm + 4 * M1 + 4 * 131072; }
  else if (j == 12) { c.src = p.in[22]; c.N = 32; c.ld = 32; c.Np = 128; c.dst = wm + 4 * M1 + 3 * 131072; }
  else { c.src = p.in[23]; c.K = 32; c.Kp = 128; c.ldd = 128; c.dst = wm + 4 * M1 + 5 * 131072; }
}

__device__ __forceinline__ void convert_weights(const Ctx& p, char* smem, int layer, const int tid) {
  float* tile = (float*)smem;
  const int nj = (layer & 1) ? 3 : ((layer >> 1) == 1 ? 14 : 12);
  int rot = 0;
  for (int j = 0; j < nj; ++j) {
    CJ c; get_cj(p, layer, j, c);
    const int nnt = c.Np >> 6, ntiles = (c.Kp >> 6) * nnt;
    int start = (int)blockIdx.x - rot; if (start < 0) start += gridDim.x;
    for (int t = start; t < ntiles; t += gridDim.x) {
      int k0 = (t / nnt) << 6, n0 = (t % nnt) << 6;
      int r = tid >> 4, c4 = (tid & 15) * 4;
#pragma unroll
      for (int hh = 0; hh < 2; ++hh) {
        int rr = r + hh * 32;
        float4 v = make_float4(0.f, 0.f, 0.f, 0.f);
        if (k0 + rr < c.K && n0 + c4 < c.N) v = *(const float4*)(c.src + (size_t)(k0 + rr) * c.ld + n0 + c4);
        tile[(c4 + 0) * 65 + rr] = v.x; tile[(c4 + 1) * 65 + rr] = v.y; tile[(c4 + 2) * 65 + rr] = v.z; tile[(c4 + 3) * 65 + rr] = v.w;
      }
      __syncthreads();
      int n = tid >> 3, kc = (tid & 7) * 8;
      const float* tp = tile + n * 65 + kc;
      uint4 o;
      o.x = pack2(tp[0], tp[1]); o.y = pack2(tp[2], tp[3]); o.z = pack2(tp[4], tp[5]); o.w = pack2(tp[6], tp[7]);
      *(uint4*)(c.dst + (size_t)(n0 + n) * c.ldd + k0 + kc) = o;
      __syncthreads();
    }
    rot = (rot + ntiles) % (int)gridDim.x;
  }
}

__device__ __forceinline__ void fourier_tables(const Ctx& p, bool with_ctx, const int tid) {
  u16* wm = (u16*)(p.ws + OFF_WMIX);
  u16* dftT = wm + M1;
  u16* m1t = dftT + 131072;
  u16* m2t = m1t + 16384;
  u16* dftC = m2t + 8192;
  float2* tw = (float2*)(dftC + 131072);
  size_t gtid = (size_t)blockIdx.x * 512 + tid, gsz = (size_t)gridDim.x * 512;
  for (size_t e = gtid; e < 512 * 256 / 8; e += gsz) {
    int r = (int)(e >> 5), c0 = (int)(e & 31) * 8;
    int ri = r >> 8, m = r & 255;
    float v[8];
#pragma unroll
    for (int q = 0; q < 8; ++q) {
      int ph = (m * (c0 + q)) & 255;
      float s, c; sincospif((float)ph * (1.f / 128.f), &s, &c);
      v[q] = (ri ? s : c) * (1.f / 16.f);
    }
    uint4 o; o.x = pack2(v[0], v[1]); o.y = pack2(v[2], v[3]); o.z = pack2(v[4], v[5]); o.w = pack2(v[6], v[7]);
    *(uint4*)(dftT + (size_t)r * 256 + c0) = o;
  }
  for (size_t e = gtid; e < 128 * 128; e += gsz) {
    int rho = (int)(e >> 7), kap = (int)(e & 127);
    int qq = rho >> 5, part = qq & 1, k1 = (qq >> 1) * 32 + (rho & 31);
    int ri = kap >> 6, l1 = kap & 63;
    int ph = (k1 * l1) & 63;
    float s, c; sincospif((float)ph * (1.f / 32.f), &s, &c);
    float v = (part == 0) ? (ri == 0 ? c : -s) : (ri == 0 ? -s : -c);
    m1t[e] = f2bf(v);
  }
  for (size_t e = gtid; e < 64 * 128; e += gsz) {
    int k2 = (int)(e >> 7), kap = (int)(e & 127);
    int ri = kap >> 6, l2 = kap & 63;
    int ph = (k2 * l2) & 63;
    float s, c; sincospif((float)ph * (1.f / 32.f), &s, &c);
    m2t[e] = f2bf((ri == 0 ? c : s) * (1.f / 64.f));
  }
  for (size_t e = gtid; e < 64 * 64; e += gsz) {
    int k1 = (int)(e >> 6), l2 = (int)(e & 63);
    float s, c; sincospif((float)(k1 * l2) * (1.f / 2048.f), &s, &c);
    tw[e] = make_float2(c, s);
  }
  if (with_ctx) {
    for (size_t e = gtid; e < 256 * 512 / 8; e += gsz) {
      int k = (int)(e >> 6), kap = (int)(e & 63) * 8;
      int ri = kap >> 8, l0 = kap & 255;
      float v[8];
#pragma unroll
      for (int q = 0; q < 8; ++q) {
        int ph = (k * (l0 + q)) & 255;
        float s, c; sincospif((float)ph * (1.f / 128.f), &s, &c);
        v[q] = (ri ? -s : c) * (1.f / 16.f);
      }
      uint4 o; o.x = pack2(v[0], v[1]); o.y = pack2(v[2], v[3]); o.z = pack2(v[4], v[5]); o.w = pack2(v[6], v[7]);
      *(uint4*)(dftC + (size_t)k * 512 + kap) = o;
    }
  }
}

struct GD {
  const u16* A; long lda; int a_rowmask; int a_mode; const float* mu;
  const u16* B; long b_rs_hi, b_rs_lo; int b_kshift; long b_kstride; int b_perm; int a_kshift; long a_kstride;
  int K, m0, n0;
  int ep; u16* out; long ldo; u16* out2; const float* e0; const u16* gsrc;
};
__device__ __forceinline__ void gd_plainA(GD& g, const u16* A, long lda) { g.A = A; g.lda = lda; g.a_rowmask = 0x7fffffff; g.a_mode = 0; g.mu = nullptr; g.a_kshift = 30; g.a_kstride = 0; }
__device__ __forceinline__ void gd_mixA(GD& g, const u16* H, const float* mu) { g.A = H; g.lda = 1024; g.a_rowmask = 0x7fffffff; g.a_mode = 1; g.mu = mu; g.a_kshift = 30; g.a_kstride = 0; }
__device__ __forceinline__ void gd_plainB(GD& g, const u16* B, long ldb) { g.B = B; g.b_rs_hi = 256 * ldb; g.b_rs_lo = ldb; g.b_kshift = 30; g.b_kstride = 0; g.b_perm = 0; }

__device__ __forceinline__ unsigned mix2(unsigned h, unsigned s, float m0, float m1) {
  float h0 = bflo(h), h1 = bfhi(h), s0 = bflo(s), s1 = bfhi(s);
  return pack2(h0 + (s0 - h0) * m0, h1 + (s1 - h1) * m1);
}

#define EPI_LOOP(LD, BODY) \
  _Pragma("unroll") for (int i = 0; i < 2; ++i) { _Pragma("unroll") for (int j = 0; j < 2; ++j) { \
    _Pragma("unroll") for (int r = 0; r < 16; ++r) { \
      const int off = (32 * i + (r & 3) + 8 * (r >> 2)) * (LD) + 32 * j; \
      const float v = acc[i][j][r]; BODY } \
    asm volatile("" ::: "memory"); } }

struct Stg { uint4 a0, a1, a2, a3, b0, b1; };

__device__ __forceinline__ int mix_nb(int t, int k) {
  int nb = -1;
  if (t < TL) {
    int l = t & 4095, c = l & 63, r = l >> 6, qq = k >> 8;
    if (qq == 0) nb = (c > 0) ? t - 1 : -1;
    else if (qq == 1) nb = (c < 63) ? t + 1 : -1;
    else if (qq == 2) nb = (r > 0) ? t - 64 : -1;
    else nb = (r < 63) ? t + 64 : -1;
  } else {
    int pp = (t - TL) & 255;
    if (k < 512) nb = (pp > 0) ? t - 1 : -1; else nb = (pp < 255) ? t + 1 : -1;
  }
  return nb;
}
__device__ __forceinline__ uint4 ld16(const u16* ptr) { return *(const uint4*)ptr; }
__device__ __forceinline__ uint4 mix4(uint4 h, uint4 s, float4 m0, float4 m1) {
  uint4 o;
  o.x = mix2(h.x, s.x, m0.x, m0.y); o.y = mix2(h.y, s.y, m0.z, m0.w);
  o.z = mix2(h.z, s.z, m1.x, m1.y); o.w = mix2(h.w, s.w, m1.z, m1.w);
  return o;
}

#define GEMM_HALF(KH) { \
    bf16x8 fa0[2], fa1[2], fb0[2], fb1[2]; \
    _Pragma("unroll") for (int kk = 0; kk < 2; ++kk) { \
      fa0[kk] = *(const bf16x8*)(ab + ((KH) * 2 + kk) * 16); \
      fb0[kk] = *(const bf16x8*)(bb + ((KH) * 2 + kk) * 16); \
      fa1[kk] = *(const bf16x8*)(ab + 32 * 72 + ((KH) * 2 + kk) * 16); \
      fb1[kk] = *(const bf16x8*)(bb + 32 * 72 + ((KH) * 2 + kk) * 16); } \
    __builtin_amdgcn_sched_barrier(0); \
    _Pragma("unroll") for (int kk = 0; kk < 2; ++kk) { \
      acc[0][0] = __builtin_amdgcn_mfma_f32_32x32x16_bf16(fa0[kk], fb0[kk], acc[0][0], 0, 0, 0); \
      acc[0][1] = __builtin_amdgcn_mfma_f32_32x32x16_bf16(fa0[kk], fb1[kk], acc[0][1], 0, 0, 0); \
      acc[1][0] = __builtin_amdgcn_mfma_f32_32x32x16_bf16(fa1[kk], fb0[kk], acc[1][0], 0, 0, 0); \
      acc[1][1] = __builtin_amdgcn_mfma_f32_32x32x16_bf16(fa1[kk], fb1[kk], acc[1][1], 0, 0, 0); \
    } \
    __builtin_amdgcn_sched_barrier(0); }
#define GEMM_COMPUTE(BUF) { \
    const u16* ab = As + (BUF) * 256 * 72 + (64 * wm + (lane & 31)) * 72 + 8 * (lane >> 5); \
    const u16* bb = Bs + (BUF) * 128 * 72 + (64 * wn + (lane & 31)) * 72 + 8 * (lane >> 5); \
    __builtin_amdgcn_sched_barrier(0); \
    GEMM_HALF(0) GEMM_HALF(1) }
struct Frg { bf16x8 a00, a01, a10, a11, b00, b01, b10, b11; };
#define GEMM_READF(F, BUF, KH) { \
    const u16* ab_ = As + (BUF) * 256 * 72 + (64 * wm + (lane & 31)) * 72 + 8 * (lane >> 5) + (KH) * 32; \
    const u16* bb_ = Bs + (BUF) * 128 * 72 + (64 * wn + (lane & 31)) * 72 + 8 * (lane >> 5) + (KH) * 32; \
    F.a00 = *(const bf16x8*)(ab_);           F.a01 = *(const bf16x8*)(ab_ + 16); \
    F.b00 = *(const bf16x8*)(bb_);           F.b01 = *(const bf16x8*)(bb_ + 16); \
    F.a10 = *(const bf16x8*)(ab_ + 32 * 72); F.a11 = *(const bf16x8*)(ab_ + 32 * 72 + 16); \
    F.b10 = *(const bf16x8*)(bb_ + 32 * 72); F.b11 = *(const bf16x8*)(bb_ + 32 * 72 + 16); }
#define GEMM_MFMA8(F) { \
    acc[0][0] = __builtin_amdgcn_mfma_f32_32x32x16_bf16(F.a00, F.b00, acc[0][0], 0, 0, 0); \
    acc[0][1] = __builtin_amdgcn_mfma_f32_32x32x16_bf16(F.a00, F.b10, acc[0][1], 0, 0, 0); \
    acc[1][0] = __builtin_amdgcn_mfma_f32_32x32x16_bf16(F.a10, F.b00, acc[1][0], 0, 0, 0); \
    acc[1][1] = __builtin_amdgcn_mfma_f32_32x32x16_bf16(F.a10, F.b10, acc[1][1], 0, 0, 0); \
    acc[0][0] = __builtin_amdgcn_mfma_f32_32x32x16_bf16(F.a01, F.b01, acc[0][0], 0, 0, 0); \
    acc[0][1] = __builtin_amdgcn_mfma_f32_32x32x16_bf16(F.a01, F.b11, acc[0][1], 0, 0, 0); \
    acc[1][0] = __builtin_amdgcn_mfma_f32_32x32x16_bf16(F.a11, F.b01, acc[1][0], 0, 0, 0); \
    acc[1][1] = __builtin_amdgcn_mfma_f32_32x32x16_bf16(F.a11, F.b11, acc[1][1], 0, 0, 0); }
#define GEMM_KSTEP_LAST(BUF, RLOAD, LSRC, KT, RSTORE) { \
    GEMM_READF(F1, BUF, 1) \
    GEMM_LOADX(RLOAD, LSRC, KT) \
    __builtin_amdgcn_sched_barrier(0); \
    GEMM_MFMA8(F0) \
    __builtin_amdgcn_sched_barrier(0); \
    GEMM_STORE(RSTORE, (BUF) ^ 1) \
    __syncthreads(); \
    GEMM_MFMA8(F1) \
    __builtin_amdgcn_sched_barrier(0); }
#define GEMM_KSTEP(BUF, RLOAD, LSRC, KT, RSTORE) { \
    GEMM_READF(F1, BUF, 1) \
    GEMM_LOADX(RLOAD, LSRC, KT) \
    __builtin_amdgcn_sched_barrier(0); \
    GEMM_MFMA8(F0) \
    __builtin_amdgcn_sched_barrier(0); \
    GEMM_STORE(RSTORE, (BUF) ^ 1) \
    __syncthreads(); \
    GEMM_READF(F0, (BUF) ^ 1, 0) \
    __builtin_amdgcn_sched_barrier(0); \
    GEMM_MFMA8(F1) \
    __builtin_amdgcn_sched_barrier(0); }
#define GEMM_LOADX(R, L, KT) { const int k0_ = min((KT), L.nk - 1) * 64; \
    const int soa_ = __builtin_amdgcn_readfirstlane((int)(((long)(k0_ >> L.akshift) * L.akstride + (k0_ & L.akmask)) * 2)); \
    const int sob_ = __builtin_amdgcn_readfirstlane((int)(((long)(k0_ >> L.kshift) * L.kstride + (k0_ & L.kmask)) * 2)); \
    const __amdgpu_buffer_rsrc_t rsA_ = make_rsrc(L.baseA); const __amdgpu_buffer_rsrc_t rsB_ = make_rsrc(L.baseB); \
    R.a0 = bufld(rsA_, L.va0, soa_); R.a1 = bufld(rsA_, L.va1, soa_); R.a2 = bufld(rsA_, L.va2, soa_); R.a3 = bufld(rsA_, L.va3, soa_); \
    R.b0 = bufld(rsB_, L.vb0, sob_); R.b1 = bufld(rsB_, L.vb1, sob_); }
#define GEMM_STORE(R, BUF) { u16* ad_ = As + (BUF) * 256 * 72 + sto; u16* bd_ = Bs + (BUF) * 128 * 72 + sto; \
    *(uint4*)(ad_) = R.a0; *(uint4*)(ad_ + 64 * 72) = R.a1; *(uint4*)(ad_ + 128 * 72) = R.a2; *(uint4*)(ad_ + 192 * 72) = R.a3; \
    *(uint4*)(bd_) = R.b0; *(uint4*)(bd_ + 64 * 72) = R.b1; }

typedef __attribute__((ext_vector_type(4))) unsigned u32x4;
__device__ __forceinline__ __amdgpu_buffer_rsrc_t make_rsrc(const u16* q) {
  unsigned long long v = (unsigned long long)q;
  unsigned lo = __builtin_amdgcn_readfirstlane((unsigned)v), hi = __builtin_amdgcn_readfirstlane((unsigned)(v >> 32));
  void* up = (void*)(((unsigned long long)hi << 32) | lo);
  return __builtin_amdgcn_make_buffer_rsrc(up, (short)0, 0x7ffffff0, 0x00020000);
}
__device__ __forceinline__ uint4 bufld(__amdgpu_buffer_rsrc_t rs, unsigned voff, int soff) {
  u32x4 v = __builtin_amdgcn_raw_buffer_load_b128(rs, (int)voff, soff, 0);
  return make_uint4(v[0], v[1], v[2], v[3]);
}

struct LdSt { const u16* baseA; const u16* baseB; unsigned va0, va1, va2, va3, vb0, vb1; int nk, kshift, kmask; long kstride; int akshift, akmask; long akstride; };
__device__ __forceinline__ void ld_setup(LdSt& L, const GD& g, const int lr, const int lc) {
  L.baseA = g.A; L.baseB = g.B + (long)(g.n0 >> 8) * g.b_rs_hi;
  const unsigned nl = (unsigned)(g.n0 & 255) + (unsigned)lr;
  L.vb0 = (nl * (unsigned)g.b_rs_lo + (unsigned)lc) * 2u;
  L.vb1 = ((nl + 64u) * (unsigned)g.b_rs_lo + (unsigned)lc) * 2u;
  const int t0 = g.m0 + lr;
  const unsigned ulda = (unsigned)g.lda;
  L.va0 = ((unsigned)((t0) & g.a_rowmask) * ulda + (unsigned)lc) * 2u;
  L.va1 = ((unsigned)((t0 + 64) & g.a_rowmask) * ulda + (unsigned)lc) * 2u;
  L.va2 = ((unsigned)((t0 + 128) & g.a_rowmask) * ulda + (unsigned)lc) * 2u;
  L.va3 = ((unsigned)((t0 + 192) & g.a_rowmask) * ulda + (unsigned)lc) * 2u;
  L.nk = g.K >> 6; L.kshift = g.b_kshift; L.kmask = (1 << g.b_kshift) - 1; L.kstride = g.b_kstride;
  L.akshift = g.a_kshift; L.akmask = (1 << g.a_kshift) - 1; L.akstride = g.a_kstride;
  if (g.b_perm == 1) {
    const unsigned n_0 = (unsigned)g.n0 + (unsigned)lr, n_1 = n_0 + 64u;
    const unsigned tk0 = (n_0 & ~4095u) | ((n_0 & 63u) << 6) | ((n_0 >> 6) & 63u);
    const unsigned tk1 = (n_1 & ~4095u) | ((n_1 & 63u) << 6) | ((n_1 >> 6) & 63u);
    L.baseB = g.B;
    L.vb0 = (tk0 * 1024u + (unsigned)lc) * 2u; L.vb1 = (tk1 * 1024u + (unsigned)lc) * 2u;
  } else if (g.b_perm == 2) {
    const unsigned n_0 = (unsigned)g.n0 + (unsigned)lr, n_1 = n_0 + 64u;
    const unsigned r0 = (((n_0 & 1023u) * 8u + (n_0 >> 16)) * 64u + ((n_0 >> 10) & 63u));
    const unsigned r1 = (((n_1 & 1023u) * 8u + (n_1 >> 16)) * 64u + ((n_1 >> 10) & 63u));
    L.baseB = g.B;
    L.vb0 = (r0 * 128u + (unsigned)lc) * 2u; L.vb1 = (r1 * 128u + (unsigned)lc) * 2u;
  }
}
__device__ __forceinline__ void ld_select(LdSt& o, const bool c, const LdSt& a, const LdSt& b) {
  o.baseA = c ? a.baseA : b.baseA; o.baseB = c ? a.baseB : b.baseB;
  o.va0 = c ? a.va0 : b.va0; o.va1 = c ? a.va1 : b.va1; o.va2 = c ? a.va2 : b.va2; o.va3 = c ? a.va3 : b.va3;
  o.vb0 = c ? a.vb0 : b.vb0; o.vb1 = c ? a.vb1 : b.vb1;
  o.nk = c ? a.nk : b.nk; o.kshift = c ? a.kshift : b.kshift; o.kmask = c ? a.kmask : b.kmask; o.kstride = c ? a.kstride : b.kstride;
  o.akshift = c ? a.akshift : b.akshift; o.akmask = c ? a.akmask : b.akmask; o.akstride = c ? a.akstride : b.akstride;
}

__device__ __forceinline__ void gemm_epilogue(const Ctx& p, const GD& g, f32x16 (&acc)[2][2], const int tid);

__device__ __forceinline__ void gemm_tile_mix(const Ctx& p, char* smem, const GD& g, const int tid) {
  u16* As = (u16*)smem;
  u16* Bs = As + 2 * 256 * 72;
  const int lane = tid & 63, w = tid >> 6, wm = w >> 1, wn = w & 1;
  const int lr = tid >> 3, lc = (tid & 7) * 8;
  f32x16 acc[2][2];
#pragma unroll
  for (int i = 0; i < 2; ++i)
#pragma unroll
    for (int j = 0; j < 2; ++j)
#pragma unroll
      for (int r = 0; r < 16; ++r) acc[i][j][r] = 0.f;
  Stg R0, R1;
  LdSt L; ld_setup(L, g, lr, lc);
  const int nk = L.nk;
  const int t0 = g.m0 + lr;
  const int sto = lr * 72 + lc;
  {
    float4 mu0, mu1;
    int nbm = 0;
    const uint4 z4 = make_uint4(0, 0, 0, 0);
    int nq0[4], nq1[4], nq2[4], nq3[4];
#pragma unroll
    for (int q4 = 0; q4 < 4; ++q4) {
      nq0[q4] = mix_nb(t0, q4 * 256); nq1[q4] = mix_nb(t0 + 64, q4 * 256); nq2[q4] = mix_nb(t0 + 128, q4 * 256); nq3[q4] = mix_nb(t0 + 192, q4 * 256);
    }
    for (int kt = -1; kt < nk; ++kt) {
      const int cur = kt & 1;
      if (kt + 1 < nk) {
        const int k0 = (kt + 1) * 64;
        const int k = k0 + lc;
        GEMM_LOADX(R0, L, kt + 1)
        const __amdgpu_buffer_rsrc_t rsA = make_rsrc(L.baseA);
        mu0 = *(const float4*)(g.mu + k); mu1 = *(const float4*)(g.mu + k + 4);
        const int soa = __builtin_amdgcn_readfirstlane(k0 * 2);
        const int qq = __builtin_amdgcn_readfirstlane(k0 >> 8);
        const int nb0 = (qq == 0) ? nq0[0] : (qq == 1) ? nq0[1] : (qq == 2) ? nq0[2] : nq0[3];
        const int nb1 = (qq == 0) ? nq1[0] : (qq == 1) ? nq1[1] : (qq == 2) ? nq1[2] : nq1[3];
        const int nb2 = (qq == 0) ? nq2[0] : (qq == 1) ? nq2[1] : (qq == 2) ? nq2[2] : nq2[3];
        const int nb3 = (qq == 0) ? nq3[0] : (qq == 1) ? nq3[1] : (qq == 2) ? nq3[2] : nq3[3];
        nbm = (nb0 >= 0 ? 1 : 0) | (nb1 >= 0 ? 2 : 0) | (nb2 >= 0 ? 4 : 0) | (nb3 >= 0 ? 8 : 0);
        R1.a0 = bufld(rsA, nb0 >= 0 ? ((unsigned)nb0 * 1024u + (unsigned)lc) * 2u : 0xFFFFFFF0u, soa);
        R1.a1 = bufld(rsA, nb1 >= 0 ? ((unsigned)nb1 * 1024u + (unsigned)lc) * 2u : 0xFFFFFFF0u, soa);
        R1.a2 = bufld(rsA, nb2 >= 0 ? ((unsigned)nb2 * 1024u + (unsigned)lc) * 2u : 0xFFFFFFF0u, soa);
        R1.a3 = bufld(rsA, nb3 >= 0 ? ((unsigned)nb3 * 1024u + (unsigned)lc) * 2u : 0xFFFFFFF0u, soa);
      }
      if (kt >= 0) GEMM_COMPUTE(cur)
      if (kt + 1 < nk) {
        R0.a0 = mix4(R0.a0, R1.a0, mu0, mu1); R0.a1 = mix4(R0.a1, R1.a1, mu0, mu1);
        R0.a2 = mix4(R0.a2, R1.a2, mu0, mu1); R0.a3 = mix4(R0.a3, R1.a3, mu0, mu1);
        GEMM_STORE(R0, cur ^ 1)
      }
      __syncthreads();
    }
  }
  gemm_epilogue(p, g, acc, tid);
}

__device__ __forceinline__ void gemm_epilogue(const Ctx& p, const GD& g, f32x16 (&acc)[2][2], const int tid) {
  int te = tid;
  asm volatile("" : "+v"(te));
  const int le = te & 63, we = te >> 6;
  const int lrow0 = 64 * (we >> 1) + 4 * (le >> 5), lcol0 = 64 * (we & 1) + (le & 31);
  const int ldo = (int)g.ldo;
  switch (g.ep) {
    case 0: { u16* ob = g.out + (size_t)(g.m0 + lrow0) * g.ldo + g.n0 + lcol0; EPI_LOOP(ldo, { ob[off] = f2bf(v); }) } break;
    case 1: { u16* ob = g.out + (size_t)(g.m0 + lrow0) * g.ldo + g.n0 + lcol0; EPI_LOOP(ldo, { ob[off] = f2bf(tanhf(v)); }) } break;
    case 2: { u16* ob = g.out + (size_t)(g.m0 + lrow0) * g.ldo + g.n0 + lcol0; EPI_LOOP(ldo, { ob[off] = f2bf(sigmoidf_(v)); }) } break;
    case 3: { u16* ob = g.out + (size_t)(g.m0 + lrow0) * g.ldo + g.n0 + lcol0; EPI_LOOP(ldo, { float rr = fmaxf(v, 0.f); ob[off] = f2bf(rr * rr); }) } break;
    case 4: { u16* ob = g.out + (size_t)(g.m0 + lrow0) * 64 + g.n0 + lcol0; if (g.n0 + lcol0 < 32) { EPI_LOOP(64, { ob[off] = f2bf(v); }) } } break;
    case 5: {
      const int jb = (g.m0 < TL) ? (g.m0 >> 12) : 8;
      const float* gp = g.e0 + jb * 6144 + g.n0 + lcol0;
      const float g0 = gp[0], g1 = gp[32];
      u16* ob = g.out + (size_t)(g.m0 + lrow0) * 1024 + g.n0 + lcol0;
      EPI_LOOP(1024, { ob[off] = f2bf((j ? g1 : g0) * v); })
    } break;
    case 6: { u16* ob = g.out + (size_t)(g.m0 + lrow0) * g.ldo + g.n0 + lcol0; const float* bp = g.e0 + g.n0 + lcol0; const float c0 = bp[0], c1 = bp[32];
      EPI_LOOP(ldo, { ob[off] = f2bf(sigmoidf_((j ? c1 : c0) + v)); }) } break;
    case 7: {
      u16* ob = g.out + (size_t)(g.m0 + lrow0) * 1024 + g.n0 + lcol0; const u16* gs = g.gsrc + (size_t)(g.m0 + lrow0) * 1024 + g.n0 + lcol0;
      EPI_LOOP(1024, { float vf = bf2f(ob[off]); float gt = bf2f(gs[off]); ob[off] = f2bf(v + (vf - v) * gt); })
    } break;
    case 8: {
      u16* ob; int ld;
      if (g.n0 < TL) { ld = TL; ob = g.out + (size_t)(g.m0 + lrow0) * TL + g.n0 + lcol0; } else { ld = TC; ob = g.out2 + (size_t)(g.m0 + lrow0) * TC + (g.n0 - TL) + lcol0; }
      EPI_LOOP(ld, { ob[off] = f2bf(v); })
    } break;
    case 9: {
      const int gq = g.m0 >> 17, rloc = g.m0 & 131071;
      const int mmq = rloc >> 9, b = ((rloc & 511) >> 6) + (we >> 1);
      const int k1 = 32 * (we & 1) + (le & 31);
      const float2* tw = (const float2*)g.e0 + k1 * 64;
      u16* zb = g.out + ((size_t)(((gq * 256 + mmq) * 8 + b) * 64 + k1) * 2) * 64;
#pragma unroll
      for (int i = 0; i < 2; ++i) {
#pragma unroll
        for (int rq = 0; rq < 4; ++rq) {
          const int l20 = 32 * i + 8 * rq + 4 * (le >> 5);
          float zr[4], zi[4];
#pragma unroll
          for (int e = 0; e < 4; ++e) {
            const float2 t = tw[l20 + e];
            const float re = acc[i][0][rq * 4 + e], im = acc[i][1][rq * 4 + e];
            zr[e] = re * t.x + im * t.y; zi[e] = im * t.x - re * t.y;
          }
          *(uint2*)(zb + l20) = make_uint2(pack2(zr[0], zr[1]), pack2(zr[2], zr[3]));
          *(uint2*)(zb + 64 + l20) = make_uint2(pack2(zi[0], zi[1]), pack2(zi[2], zi[3]));
        }
        asm volatile("" ::: "memory");
      }
    } break;
    case 10: {
      if ((we >> 1) == 0) {
        const int b = g.n0 >> 16, k1 = (g.n0 >> 10) & 63, gm0 = (g.n0 & 1023) + lcol0;
        u16* ob = g.out + ((size_t)(b * 4096 + k1 + 64 * (4 * (le >> 5)))) * 1024 + gm0;
        EPI_LOOP(65536, { ob[off] = f2bf(v); })
      }
    } break;
    default: break;
  }
}

enum { G_RB = 0, G_RC, G_RC2, G_WO_R, G_FB, G_F1, G_F2, G_WO_F, G_MLP1, G_MLP2 };

__device__ __forceinline__ int gemm_total(int kind, int layer) {
  const int idx = layer >> 1;
  const bool ctx_in = layer <= 2, ctx_out = layer < 2;
  const int mt_out = (ctx_out ? T : TL) >> 8;
  switch (kind) {
    case G_RB: return 136 * ((idx == 0) ? 27 : 20);
    case G_RC: return 136 * ((idx == 0) ? 8 : 16);
    case G_RC2: return 136 * 8;
    case G_WO_R: return mt_out * 8;
    case G_FB: return 8 * (ctx_in ? 272 : 256);
    case G_F1: return 2048;
    case G_F2: return 4096 + (ctx_in ? 64 : 0);
    case G_WO_F: return mt_out * 8;
    case G_MLP1: return mt_out * 32;
    default: return mt_out * 8;
  }
}

__device__ __forceinline__ void make_gd(const Ctx& p, int kind, int layer, int tile, GD& g) {
  const int idx = layer >> 1;
  const u16* H = (const u16*)p.ws;
  const u16* wm = (const u16*)(p.ws + OFF_WMIX);
  const float* mu = p.in[10] + (size_t)idx * 6 * 1024;
  const float* mod = (const float*)(p.ws + OFF_MOD) + (size_t)layer * 9 * 6144;
  g.out = nullptr; g.out2 = nullptr; g.e0 = nullptr; g.gsrc = nullptr; g.ldo = 1024; g.ep = 0; g.K = 1024;
  switch (kind) {
    case G_RB: {
      const int CT = (idx == 0) ? 27 : 20;
      int tm = tile / CT, ct = tile % CT;
      g.m0 = tm * 256;
      int nv = (idx == 0) ? 8 : 0;
      if (ct < 8) { gd_mixA(g, H, mu + 0 * 1024); gd_plainB(g, wm + 0 * M1, 1024); g.n0 = ct * 128; g.out = (u16*)(p.ws + 1 * SLOT); }
      else if (ct < 16) { gd_mixA(g, H, mu + 2 * 1024); gd_plainB(g, wm + 1 * M1, 1024); g.n0 = (ct - 8) * 128; g.out = (u16*)(p.ws + 2 * SLOT); }
      else if (ct < 16 + nv) { gd_mixA(g, H, mu + 3 * 1024); gd_plainB(g, wm + 2 * M1, 1024); g.n0 = (ct - 16) * 128; g.out = (u16*)(p.ws + 5 * SLOT); }
      else {
        int q = ct - 16 - nv; g.n0 = 0;
        if (q == 0) { gd_mixA(g, H, mu + 1 * 1024); gd_plainB(g, wm + 4 * M1, 1024); g.ep = 1; g.out = (u16*)(p.ws + OFF_HW); g.ldo = 128; }
        else if (q == 1) { gd_mixA(g, H, mu + 4 * 1024); gd_plainB(g, wm + 4 * M1 + 131072, 1024); g.ep = 0; g.out = (u16*)(p.ws + OFF_HA); g.ldo = 128; }
        else if (q == 2) { gd_mixA(g, H, mu + 5 * 1024); gd_plainB(g, wm + 4 * M1 + 2 * 131072, 1024); g.ep = 2; g.out = (u16*)(p.ws + OFF_HG); g.ldo = 128; }
        else { gd_mixA(g, H, mu + 3 * 1024); gd_plainB(g, wm + 4 * M1 + 3 * 131072, 1024); g.ep = 0; g.out = (u16*)(p.ws + OFF_HV); g.ldo = 128; }
      }
    } break;
    case G_RC: {
      const int CT = (idx == 0) ? 8 : 16;
      int tm = tile / CT, ct = tile % CT;
      g.m0 = tm * 256;
      if (ct < 8) { gd_plainA(g, (const u16*)(p.ws + OFF_HG), 128); gd_plainB(g, wm + 4 * M1 + 4 * 131072, 128); g.K = 128; g.n0 = ct * 128; g.out = (u16*)(p.ws + 4 * SLOT); }
      else { gd_plainA(g, (const u16*)(p.ws + OFF_HV), 128); gd_plainB(g, wm + 4 * M1 + 5 * 131072, 128); g.K = 128; g.n0 = (ct - 8) * 128; g.ep = 6; g.e0 = p.in[21]; g.out = (u16*)(p.ws + 3 * SLOT); }
    } break;
    case G_RC2: {
      int tm = tile >> 3, ct = tile & 7;
      g.m0 = tm * 256; g.n0 = ct * 128;
      gd_mixA(g, H, mu + 3 * 1024); gd_plainB(g, wm + 2 * M1, 1024);
      g.ep = 7; g.out = (u16*)(p.ws + 5 * SLOT); g.gsrc = (const u16*)(p.ws + 3 * SLOT);
    } break;
    case G_WO_R: {
      int tm = tile >> 3, ct = tile & 7;
      g.m0 = tm * 256; g.n0 = ct * 128;
      gd_plainA(g, H, 1024); gd_plainB(g, wm + 3 * M1, 1024);
      g.ep = 5; g.e0 = mod + 2048; g.out = (u16*)(p.ws + 1 * SLOT);
    } break;
    case G_FB: {
      int tn = tile >> 3, tm = tile & 7;
      g.K = 256; g.m0 = tm * 256; g.n0 = tn * 128;
      gd_plainA(g, wm + M1, 256); g.a_rowmask = 511;
      gd_plainB(g, H + 256 * (tm >> 1), 1024);
      if (g.n0 < TL) g.b_perm = 1;
      g.ep = 8; g.out = (u16*)(p.ws + 1 * SLOT); g.out2 = g.out + (size_t)2048 * TL;
    } break;
    case G_F1: {
      const u16* YT = (const u16*)(p.ws + 1 * SLOT);
      const int gq = tile >> 9;
      g.K = 128; g.m0 = tile * 256; g.n0 = 0;
      gd_plainA(g, YT + (size_t)gq * 512 * TL - (size_t)gq * 131072 * 64, 64);
      g.a_kshift = 6; g.a_kstride = (long)256 * TL;
      gd_plainB(g, wm + M1 + 131072, 128);
      g.ep = 9; g.out = (u16*)(p.ws + 3 * SLOT); g.e0 = (const float*)(wm + M1 + 131072 + 16384 + 8192 + 131072);
    } break;
    case G_F2: {
      u16* fo = (u16*)(p.ws + 1 * SLOT);
      if (tile < 4096) {
        g.K = 128; g.m0 = 0; g.n0 = tile * 128;
        gd_plainA(g, wm + M1 + 131072 + 16384, 128); g.a_rowmask = 63;
        gd_plainB(g, (const u16*)(p.ws + 3 * SLOT), 128); g.b_perm = 2;
        g.ep = 10; g.out = fo;
      } else {
        const u16* dftC = wm + M1 + 131072 + 16384 + 8192;
        const u16* YTc = (const u16*)(p.ws + 1 * SLOT) + (size_t)2048 * TL;
        int t2 = tile - 4096; int b = t2 >> 3, ct = t2 & 7;
        g.K = 512; g.m0 = 0; g.n0 = ct * 128;
        gd_plainA(g, dftC, 512);
        g.B = YTc + (size_t)b * 256; g.b_rs_hi = (long)512 * TC; g.b_rs_lo = TC; g.b_kshift = 8; g.b_kstride = (long)256 * TC; g.b_perm = 0;
        g.out = fo + (size_t)(TL + b * 256) * 1024;
      }
    } break;
    case G_WO_F: {
      int tm = tile >> 3, ct = tile & 7;
      g.m0 = tm * 256; g.n0 = ct * 128;
      gd_plainA(g, (const u16*)(p.ws + 1 * SLOT), 1024); gd_plainB(g, wm, 1024);
      g.ep = 5; g.e0 = mod + 2048; g.out = (u16*)(p.ws + 2 * SLOT);
    } break;
    case G_MLP1: {
      const int grp = tile >> 7, ii = tile & 127;
      int tm = grp * 4 + ((ii & 31) >> 3), ct = (ii >> 5) * 8 + (ii & 7);
      g.m0 = tm * 256; g.n0 = ct * 128;
      gd_plainA(g, H, 1024); gd_plainB(g, (const u16*)(p.ws + OFF_WMLP), 1024);
      g.ep = 3; g.out = (u16*)(p.ws + 1 * SLOT); g.ldo = 4096;
    } break;
    default: {
      int tm = tile >> 3, ct = tile & 7;
      g.K = 4096; g.m0 = tm * 256; g.n0 = ct * 128;
      gd_plainA(g, (const u16*)(p.ws + 1 * SLOT), 4096); gd_plainB(g, (const u16*)(p.ws + OFF_WMLP) + 4 * M1, 4096);
      g.ep = 5; g.e0 = mod + 5 * 1024; g.out = (u16*)(p.ws);
    } break;
  }
}

#define SCAN_SA_TEXT \
      "v_mul_f32_dpp %0, %2, %3 row_newbcast:0 row_mask:0xf bank_mask:0xf\n\t" \
      "v_mul_f32_dpp %1, %2, %4 row_newbcast:1 row_mask:0xf bank_mask:0xf\n\t" \
      "v_fmac_f32_dpp %0, %2, %5 row_newbcast:2 row_mask:0xf bank_mask:0xf\n\t" \
      "v_fmac_f32_dpp %1, %2, %6 row_newbcast:3 row_mask:0xf bank_mask:0xf\n\t" \
      "v_fmac_f32_dpp %0, %2, %7 row_newbcast:4 row_mask:0xf bank_mask:0xf\n\t" \
      "v_fmac_f32_dpp %1, %2, %8 row_newbcast:5 row_mask:0xf bank_mask:0xf\n\t" \
      "v_fmac_f32_dpp %0, %2, %9 row_newbcast:6 row_mask:0xf bank_mask:0xf\n\t" \
      "v_fmac_f32_dpp %1, %2, %10 row_newbcast:7 row_mask:0xf bank_mask:0xf\n\t" \
      "v_fmac_f32_dpp %0, %2, %11 row_newbcast:8 row_mask:0xf bank_mask:0xf\n\t" \
      "v_fmac_f32_dpp %1, %2, %12 row_newbcast:9 row_mask:0xf bank_mask:0xf\n\t" \
      "v_fmac_f32_dpp %0, %2, %13 row_newbcast:10 row_mask:0xf bank_mask:0xf\n\t" \
      "v_fmac_f32_dpp %1, %2, %14 row_newbcast:11 row_mask:0xf bank_mask:0xf\n\t" \
      "v_fmac_f32_dpp %0, %2, %15 row_newbcast:12 row_mask:0xf bank_mask:0xf\n\t" \
      "v_fmac_f32_dpp %1, %2, %16 row_newbcast:13 row_mask:0xf bank_mask:0xf\n\t" \
      "v_fmac_f32_dpp %0, %2, %17 row_newbcast:14 row_mask:0xf bank_mask:0xf\n\t" \
      "v_fmac_f32_dpp %1, %2, %18 row_newbcast:15 row_mask:0xf bank_mask:0xf\n\t"
#define SCAN_SA(sa0, sa1, A) asm( \
      SCAN_SA_TEXT \
      : "=&v"(sa0), "=&v"(sa1) : "v"(A), "v"(S[0]), "v"(S[1]), "v"(S[2]), "v"(S[3]), "v"(S[4]), "v"(S[5]), "v"(S[6]), "v"(S[7]), \
        "v"(S[8]), "v"(S[9]), "v"(S[10]), "v"(S[11]), "v"(S[12]), "v"(S[13]), "v"(S[14]), "v"(S[15]))
#define SCAN_UP(B0, W, Bv, KD, sa, VV) asm( \
      "v_mul_f32_dpp %0, %16, %8 row_newbcast:0 row_mask:0xf bank_mask:0xf\n\t" \
      "v_mul_f32_dpp %1, %16, %9 row_newbcast:1 row_mask:0xf bank_mask:0xf\n\t" \
      "v_mul_f32_dpp %2, %16, %10 row_newbcast:2 row_mask:0xf bank_mask:0xf\n\t" \
      "v_mul_f32_dpp %3, %16, %11 row_newbcast:3 row_mask:0xf bank_mask:0xf\n\t" \
      "v_mul_f32_dpp %4, %16, %12 row_newbcast:4 row_mask:0xf bank_mask:0xf\n\t" \
      "v_mul_f32_dpp %5, %16, %13 row_newbcast:5 row_mask:0xf bank_mask:0xf\n\t" \
      "v_mul_f32_dpp %6, %16, %14 row_newbcast:6 row_mask:0xf bank_mask:0xf\n\t" \
      "v_mul_f32_dpp %7, %16, %15 row_newbcast:7 row_mask:0xf bank_mask:0xf\n\t" \
      "v_fmac_f32_dpp %0, %17, %19 row_newbcast:0 row_mask:0xf bank_mask:0xf\n\t" \
      "v_fmac_f32_dpp %1, %17, %19 row_newbcast:1 row_mask:0xf bank_mask:0xf\n\t" \
      "v_fmac_f32_dpp %2, %17, %19 row_newbcast:2 row_mask:0xf bank_mask:0xf\n\t" \
      "v_fmac_f32_dpp %3, %17, %19 row_newbcast:3 row_mask:0xf bank_mask:0xf\n\t" \
      "v_fmac_f32_dpp %4, %17, %19 row_newbcast:4 row_mask:0xf bank_mask:0xf\n\t" \
      "v_fmac_f32_dpp %5, %17, %19 row_newbcast:5 row_mask:0xf bank_mask:0xf\n\t" \
      "v_fmac_f32_dpp %6, %17, %19 row_newbcast:6 row_mask:0xf bank_mask:0xf\n\t" \
      "v_fmac_f32_dpp %7, %17, %19 row_newbcast:7 row_mask:0xf bank_mask:0xf\n\t" \
      "v_fmac_f32_dpp %0, %18, %20 row_newbcast:0 row_mask:0xf bank_mask:0xf\n\t" \
      "v_fmac_f32_dpp %1, %18, %20 row_newbcast:1 row_mask:0xf bank_mask:0xf\n\t" \
      "v_fmac_f32_dpp %2, %18, %20 row_newbcast:2 row_mask:0xf bank_mask:0xf\n\t" \
      "v_fmac_f32_dpp %3, %18, %20 row_newbcast:3 row_mask:0xf bank_mask:0xf\n\t" \
      "v_fmac_f32_dpp %4, %18, %20 row_newbcast:4 row_mask:0xf bank_mask:0xf\n\t" \
      "v_fmac_f32_dpp %5, %18, %20 row_newbcast:5 row_mask:0xf bank_mask:0xf\n\t" \
      "v_fmac_f32_dpp %6, %18, %20 row_newbcast:6 row_mask:0xf bank_mask:0xf\n\t" \
      "v_fmac_f32_dpp %7, %18, %20 row_newbcast:7 row_mask:0xf bank_mask:0xf\n\t" \
      : "=&v"(N[B0 + 0]), "=&v"(N[B0 + 1]), "=&v"(N[B0 + 2]), "=&v"(N[B0 + 3]), "=&v"(N[B0 + 4]), "=&v"(N[B0 + 5]), "=&v"(N[B0 + 6]), "=&v"(N[B0 + 7]) \
      : "v"(S[B0 + 0]), "v"(S[B0 + 1]), "v"(S[B0 + 2]), "v"(S[B0 + 3]), "v"(S[B0 + 4]), "v"(S[B0 + 5]), "v"(S[B0 + 6]), "v"(S[B0 + 7]), \
        "v"(W), "v"(Bv), "v"(KD), "v"(sa), "v"(VV))
#define SCAN_UP8(B0, W, Bv, KD, sa, VV) asm( \
      "v_mul_f32_dpp %0, %16, %8 row_newbcast:8 row_mask:0xf bank_mask:0xf\n\t" \
      "v_mul_f32_dpp %1, %16, %9 row_newbcast:9 row_mask:0xf bank_mask:0xf\n\t" \
      "v_mul_f32_dpp %2, %16, %10 row_newbcast:10 row_mask:0xf bank_mask:0xf\n\t" \
      "v_mul_f32_dpp %3, %16, %11 row_newbcast:11 row_mask:0xf bank_mask:0xf\n\t" \
      "v_mul_f32_dpp %4, %16, %12 row_newbcast:12 row_mask:0xf bank_mask:0xf\n\t" \
      "v_mul_f32_dpp %5, %16, %13 row_newbcast:13 row_mask:0xf bank_mask:0xf\n\t" \
      "v_mul_f32_dpp %6, %16, %14 row_newbcast:14 row_mask:0xf bank_mask:0xf\n\t" \
      "v_mul_f32_dpp %7, %16, %15 row_newbcast:15 row_mask:0xf bank_mask:0xf\n\t" \
      "v_fmac_f32_dpp %0, %17, %19 row_newbcast:8 row_mask:0xf bank_mask:0xf\n\t" \
      "v_fmac_f32_dpp %1, %17, %19 row_newbcast:9 row_mask:0xf bank_mask:0xf\n\t" \
      "v_fmac_f32_dpp %2, %17, %19 row_newbcast:10 row_mask:0xf bank_mask:0xf\n\t" \
      "v_fmac_f32_dpp %3, %17, %19 row_newbcast:11 row_mask:0xf bank_mask:0xf\n\t" \
      "v_fmac_f32_dpp %4, %17, %19 row_newbcast:12 row_mask:0xf bank_mask:0xf\n\t" \
      "v_fmac_f32_dpp %5, %17, %19 row_newbcast:13 row_mask:0xf bank_mask:0xf\n\t" \
      "v_fmac_f32_dpp %6, %17, %19 row_newbcast:14 row_mask:0xf bank_mask:0xf\n\t" \
      "v_fmac_f32_dpp %7, %17, %19 row_newbcast:15 row_mask:0xf bank_mask:0xf\n\t" \
      "v_fmac_f32_dpp %0, %18, %20 row_newbcast:8 row_mask:0xf bank_mask:0xf\n\t" \
      "v_fmac_f32_dpp %1, %18, %20 row_newbcast:9 row_mask:0xf bank_mask:0xf\n\t" \
      "v_fmac_f32_dpp %2, %18, %20 row_newbcast:10 row_mask:0xf bank_mask:0xf\n\t" \
      "v_fmac_f32_dpp %3, %18, %20 row_newbcast:11 row_mask:0xf bank_mask:0xf\n\t" \
      "v_fmac_f32_dpp %4, %18, %20 row_newbcast:12 row_mask:0xf bank_mask:0xf\n\t" \
      "v_fmac_f32_dpp %5, %18, %20 row_newbcast:13 row_mask:0xf bank_mask:0xf\n\t" \
      "v_fmac_f32_dpp %6, %18, %20 row_newbcast:14 row_mask:0xf bank_mask:0xf\n\t" \
      "v_fmac_f32_dpp %7, %18, %20 row_newbcast:15 row_mask:0xf bank_mask:0xf\n\t" \
      : "=&v"(N[B0 + 0]), "=&v"(N[B0 + 1]), "=&v"(N[B0 + 2]), "=&v"(N[B0 + 3]), "=&v"(N[B0 + 4]), "=&v"(N[B0 + 5]), "=&v"(N[B0 + 6]), "=&v"(N[B0 + 7]) \
      : "v"(S[B0 + 0]), "v"(S[B0 + 1]), "v"(S[B0 + 2]), "v"(S[B0 + 3]), "v"(S[B0 + 4]), "v"(S[B0 + 5]), "v"(S[B0 + 6]), "v"(S[B0 + 7]), \
        "v"(W), "v"(Bv), "v"(KD), "v"(sa), "v"(VV))
#define SCAN_Y(sa0, sa1, A) asm( \
      SCAN_SA_TEXT \
      : "=&v"(sa0), "=&v"(sa1) : "v"(A), "v"(N[0]), "v"(N[1]), "v"(N[2]), "v"(N[3]), "v"(N[4]), "v"(N[5]), "v"(N[6]), "v"(N[7]), \
        "v"(N[8]), "v"(N[9]), "v"(N[10]), "v"(N[11]), "v"(N[12]), "v"(N[13]), "v"(N[14]), "v"(N[15]))
#define SCAN_STEP(W, A, Bv, KD, R, VV, YP, PREFETCH) { \
      float sa0, sa1, y0, y1; float N[16]; \
      asm volatile("s_nop 1" : "+v"(A), "+v"(W), "+v"(Bv), "+v"(KD), "+v"(R)); \
      SCAN_SA(sa0, sa1, A); \
      PREFETCH \
      const float sa = xrow_sum(sa0 + sa1); \
      SCAN_UP(0, W, Bv, KD, sa, VV); \
      SCAN_UP8(8, W, Bv, KD, sa, VV); \
      SCAN_Y(y0, y1, R); \
      YP = y0 + y1; \
      _Pragma("unroll") for (int j_ = 0; j_ < 16; ++j_) S[j_] = N[j_]; }
#define SCAN_LOAD(W, A, Bv, KD, R, VV, SIDX) { const float* np_ = bp + (SIDX) * 384; \
      W = np_[lane]; A = np_[64 + lane]; Bv = np_[128 + lane]; KD = np_[192 + lane]; R = np_[256 + lane]; VV = np_[vo]; }

__device__ __forceinline__ int scan_row(int gstep, int b, int d) {
  if (gstep < 256) { int pp = d ? 255 - gstep : gstep; return TL + b * 256 + pp; }
  int l = gstep - 256; if (d) l = 4095 - l;
  return b * 4096 + l;
}

__device__ __forceinline__ void phase_scan(const Ctx& p, char* smem, int idx, bool ctx_y, const int tid) {
  if (blockIdx.x >= 256) return;
  const int item = blockIdx.x;
  const int d = item & 1, h = (item >> 1) & 15, b = item >> 5;
  float* buf = (float*)smem;
  float* ybuf = buf + 2 * 32 * 384;
  const int lane = tid & 63, w = tid >> 6;
  const u16* rbuf = (const u16*)(p.ws + 1 * SLOT);
  const u16* kbuf = (const u16*)(p.ws + 2 * SLOT);
  const u16* vbuf = (const u16*)(p.ws + 5 * SLOT);
  u16* ybase = (u16*)(p.ws + (d == 0 ? 0 : 3 * SLOT));
  const u16* hw = (const u16*)(p.ws + OFF_HW);
  const u16* ha = (const u16*)(p.ws + OFF_HA);
  float* bsum = (float*)(p.ws + OFF_BSUM);
  const int ch = h * 64;

  uint4* Bl = (uint4*)(ybuf + 2 * 2048);
  float w0v[4], a0v[4];
  float kkw = 0.f, kaw = 0.f, rkw = 0.f;
#pragma unroll
  for (int cb = 0; cb < 4; ++cb) { w0v[cb] = 0.f; a0v[cb] = 0.f; }
  if (w >= 4) {
    const float* w2 = p.in[17] + (size_t)(idx * 2 + d) * 64 * 1024;
    const float* a2 = p.in[20] + (size_t)(idx * 2 + d) * 64 * 1024;
#pragma unroll
    for (int cb = 0; cb < 4; ++cb) {
      int col = ch + 16 * cb + (lane & 15);
      w0v[cb] = p.in[15][(idx * 2 + d) * 1024 + col];
      a0v[cb] = p.in[18][(idx * 2 + d) * 1024 + col];
    }
    {
      const int cb = w - 4;
      const int col = ch + 16 * cb + (lane & 15);
#pragma unroll
      for (int i = 0; i < 2; ++i) {
        const int k0 = 32 * i + 8 * (lane >> 4);
        float fw[8], fa[8];
#pragma unroll
        for (int q = 0; q < 8; ++q) { fw[q] = w2[(size_t)(k0 + q) * 1024 + col]; fa[q] = a2[(size_t)(k0 + q) * 1024 + col]; }
        Bl[((0 * 4 + cb) * 2 + i) * 64 + lane] = make_uint4(pack2(fw[0], fw[1]), pack2(fw[2], fw[3]), pack2(fw[4], fw[5]), pack2(fw[6], fw[7]));
        Bl[((1 * 4 + cb) * 2 + i) * 64 + lane] = make_uint4(pack2(fa[0], fa[1]), pack2(fa[2], fa[3]), pack2(fa[4], fa[5]), pack2(fa[6], fa[7]));
      }
    }
    kkw = p.in[26][idx * 1024 + ch + lane];
    kaw = p.in[27][idx * 1024 + ch + lane];
    rkw = p.in[28][idx * 1024 + ch + lane];
  }
  __syncthreads();
  float S[16];
#pragma unroll
  for (int j = 0; j < 16; ++j) S[j] = 0.f;

  for (int it = 0; it <= 137; ++it) {
    if (w >= 4) {
      const int jw = w - 4;
      if (it >= 2) {
        int cy = it - 2;
        const float* yb = ybuf + (cy & 1) * 2048;
        if (cy >= 8 || ctx_y) {
          const int yrow0 = scan_row(cy * 32 + jw * 8, b, d);
#pragma unroll
          for (int s8 = 0; s8 < 8; ++s8) {
            int s = jw * 8 + s8;
            int row = yrow0 + (d ? -s8 : s8);
            ybase[(unsigned)row * 1024u + (unsigned)(ch + lane)] = f2bf(yb[s * 64 + lane]);
          }
        }
      }
      if (it < 136) {
        float* bp = buf + (it & 1) * 12288;
        const int s0 = jw * 8;
        const int prow0 = scan_row(it * 32 + s0, b, d);
        int rowm = prow0 + (d ? -(lane & 7) : (lane & 7));
        bf16x8 Aw0 = *(const bf16x8*)(hw + ((unsigned)rowm * 128u + (unsigned)(d * 64 + 8 * (lane >> 4))));
        bf16x8 Aw1 = *(const bf16x8*)(hw + ((unsigned)rowm * 128u + (unsigned)(d * 64 + 32 + 8 * (lane >> 4))));
        bf16x8 Aa0 = *(const bf16x8*)(ha + ((unsigned)rowm * 128u + (unsigned)(d * 64 + 8 * (lane >> 4))));
        bf16x8 Aa1 = *(const bf16x8*)(ha + ((unsigned)rowm * 128u + (unsigned)(d * 64 + 32 + 8 * (lane >> 4))));
        float kx[8], rx[8], vx[8];
#pragma unroll
        for (int s8 = 0; s8 < 8; ++s8) {
          int row = prow0 + (d ? -s8 : s8);
          const unsigned o = (unsigned)row * 1024u + (unsigned)(ch + lane);
          kx[s8] = bf2f(kbuf[o]); rx[s8] = bf2f(rbuf[o]); vx[s8] = bf2f(vbuf[o]);
        }
        const bool hiL = lane >= 32;
#pragma unroll
        for (int cbp = 0; cbp < 2; ++cbp) {
          f32x4 cwl = {0.f, 0.f, 0.f, 0.f}, cal = {0.f, 0.f, 0.f, 0.f}, cwh = {0.f, 0.f, 0.f, 0.f}, cah = {0.f, 0.f, 0.f, 0.f};
          {
            const int cb = cbp;
            const bf16x8 bw0 = __builtin_bit_cast(bf16x8, Bl[((0 * 4 + cb) * 2 + 0) * 64 + lane]);
            const bf16x8 bw1 = __builtin_bit_cast(bf16x8, Bl[((0 * 4 + cb) * 2 + 1) * 64 + lane]);
            const bf16x8 ba0 = __builtin_bit_cast(bf16x8, Bl[((1 * 4 + cb) * 2 + 0) * 64 + lane]);
            const bf16x8 ba1 = __builtin_bit_cast(bf16x8, Bl[((1 * 4 + cb) * 2 + 1) * 64 + lane]);
            cwl = __builtin_amdgcn_mfma_f32_16x16x32_bf16(Aw0, bw0, cwl, 0, 0, 0);
            cwl = __builtin_amdgcn_mfma_f32_16x16x32_bf16(Aw1, bw1, cwl, 0, 0, 0);
            cal = __builtin_amdgcn_mfma_f32_16x16x32_bf16(Aa0, ba0, cal, 0, 0, 0);
            cal = __builtin_amdgcn_mfma_f32_16x16x32_bf16(Aa1, ba1, cal, 0, 0, 0);
          }
          {
            const int cb = cbp + 2;
            const bf16x8 bw0 = __builtin_bit_cast(bf16x8, Bl[((0 * 4 + cb) * 2 + 0) * 64 + lane]);
            const bf16x8 bw1 = __builtin_bit_cast(bf16x8, Bl[((0 * 4 + cb) * 2 + 1) * 64 + lane]);
            const bf16x8 ba0 = __builtin_bit_cast(bf16x8, Bl[((1 * 4 + cb) * 2 + 0) * 64 + lane]);
            const bf16x8 ba1 = __builtin_bit_cast(bf16x8, Bl[((1 * 4 + cb) * 2 + 1) * 64 + lane]);
            cwh = __builtin_amdgcn_mfma_f32_16x16x32_bf16(Aw0, bw0, cwh, 0, 0, 0);
            cwh = __builtin_amdgcn_mfma_f32_16x16x32_bf16(Aw1, bw1, cwh, 0, 0, 0);
            cah = __builtin_amdgcn_mfma_f32_16x16x32_bf16(Aa0, ba0, cah, 0, 0, 0);
            cah = __builtin_amdgcn_mfma_f32_16x16x32_bf16(Aa1, ba1, cah, 0, 0, 0);
          }
          const float w0s = hiL ? w0v[cbp + 2] : w0v[cbp];
          const float a0s = hiL ? a0v[cbp + 2] : a0v[cbp];
          const int colb = 16 * (cbp + (hiL ? 2 : 0)) + (lane & 15);
#pragma unroll
          for (int r = 0; r < 4; ++r) {
            const int m = 4 * ((lane >> 4) & 1) + r;
            const float xw = (hiL ? cwh[r] : cwl[r]) + w0s;
            const float xa = (hiL ? cah[r] : cal[r]) + a0s;
            const float dec = __expf(-0.60653066f * sigmoidf_(xw));
            const float ic = sigmoidf_(xa);
            bp[(s0 + m) * 384 + 0 * 64 + colb] = dec;
            bp[(s0 + m) * 384 + 1 * 64 + colb] = ic;
          }
        }
        float icv[8], kkr[8], kdv[8], X[16];
#pragma unroll
        for (int s8 = 0; s8 < 8; ++s8) {
          icv[s8] = bp[(s0 + s8) * 384 + 64 + lane];
          kkr[s8] = kx[s8] * kkw;
          kdv[s8] = kx[s8] * (1.f + (icv[s8] - 1.f) * kaw);
          X[2 * s8] = kkr[s8] * kkr[s8];
          X[2 * s8 + 1] = rx[s8] * kdv[s8] * rkw;
        }
        float Yv[8], Zv[4];
#pragma unroll
        for (int m = 0; m < 8; ++m) {
          auto pp = __builtin_amdgcn_permlane32_swap(__float_as_uint(X[2 * m]), __float_as_uint(X[2 * m + 1]), false, false);
          Yv[m] = __uint_as_float(pp[0]) + __uint_as_float(pp[1]);
        }
#pragma unroll
        for (int n = 0; n < 4; ++n) {
          auto pq = __builtin_amdgcn_permlane16_swap(__float_as_uint(Yv[2 * n]), __float_as_uint(Yv[2 * n + 1]), false, false);
          float z = __uint_as_float(pq[0]) + __uint_as_float(pq[1]);
          DPP_ROR_ADD(z, 8); DPP_ROR_ADD(z, 4); DPP_ROR_ADD(z, 2); DPP_ROR_ADD(z, 1);
          Zv[n] = z;
        }
        float bsv = 0.f;
#pragma unroll
        for (int s8 = 0; s8 < 8; ++s8) {
          const int s = s0 + s8;
          const int zi = __float_as_int(Zv[s8 >> 1]);
          const float ss = __int_as_float(__builtin_amdgcn_readlane(zi, (s8 & 1) * 16));
          const float bs = __int_as_float(__builtin_amdgcn_readlane(zi, 32 + (s8 & 1) * 16));
          const float ic = icv[s8];
          const float kk = kkr[s8] * rsqrtf(fmaxf(ss, 1e-24f));
          bsv = (lane == s8) ? bs : bsv;
          bp[s * 384 + 64 + lane] = -kk;
          bp[s * 384 + 128 + lane] = kk * ic;
          bp[s * 384 + 192 + lane] = kdv[s8];
          bp[s * 384 + 256 + lane] = rx[s8];
          bp[s * 384 + 320 + lane] = vx[s8];
        }
        if (lane < 8) bsum[(unsigned)(prow0 + (d ? -lane : lane)) * 32u + (unsigned)(h * 2 + d)] = bsv;
      }
    } else {
      if (it >= 1 && it <= 136) {
        const float* bp = buf + ((it - 1) & 1) * 12288;
        float* yb = ybuf + ((it - 1) & 1) * 2048;
        const int vo = 320 + 16 * w + (lane & 15);
        float W0, A0, B0, K0, R0, V0, W1, A1, B1, K1, R1, V1;
        SCAN_LOAD(W0, A0, B0, K0, R0, V0, 0)
#pragma unroll 1
        for (int s = 0; s < 32; s += 4) {
          float yp0, yp1, yp2, yp3;
          SCAN_STEP(W0, A0, B0, K0, R0, V0, yp0, SCAN_LOAD(W1, A1, B1, K1, R1, V1, s + 1))
          SCAN_STEP(W1, A1, B1, K1, R1, V1, yp1, SCAN_LOAD(W0, A0, B0, K0, R0, V0, s + 2))
          SCAN_STEP(W0, A0, B0, K0, R0, V0, yp2, SCAN_LOAD(W1, A1, B1, K1, R1, V1, s + 3))
          const int s4 = (s + 4 < 32) ? s + 4 : 31;
          SCAN_STEP(W1, A1, B1, K1, R1, V1, yp3, SCAN_LOAD(W0, A0, B0, K0, R0, V0, s4))
          {
            auto p01 = __builtin_amdgcn_permlane32_swap(__float_as_uint(yp0), __float_as_uint(yp1), false, false);
            auto p23 = __builtin_amdgcn_permlane32_swap(__float_as_uint(yp2), __float_as_uint(yp3), false, false);
            const float u01 = __uint_as_float(p01[0]) + __uint_as_float(p01[1]);
            const float u23 = __uint_as_float(p23[0]) + __uint_as_float(p23[1]);
            auto pz = __builtin_amdgcn_permlane16_swap(__float_as_uint(u01), __float_as_uint(u23), false, false);
            const float z = __uint_as_float(pz[0]) + __uint_as_float(pz[1]);
            const int rho = lane >> 4;
            const int smap = ((rho & 1) << 1) | (rho >> 1);
            yb[(s + smap) * 64 + 16 * w + (lane & 15)] = z;
          }
        }
      }
    }
    __syncthreads();
  }
}

__device__ __forceinline__ void phase_readout(const Ctx& p, int idx, int nrows, const int tid) {
  u16* y0 = (u16*)(p.ws);
  const u16* y1 = (const u16*)(p.ws + 3 * SLOT);
  const u16* vb = (const u16*)(p.ws + 5 * SLOT);
  const u16* gb = (const u16*)(p.ws + 4 * SLOT);
  const float* bsum = (const float*)(p.ws + OFF_BSUM);
  const float* lw = p.in[29] + idx * 1024;
  const float* lb = p.in[30] + idx * 1024;
  int lane = tid & 63, wv = tid >> 6;
  const int stride = gridDim.x * 8;
  for (int row0 = blockIdx.x * 8 + wv; row0 < nrows; row0 += 2 * stride) {
    const bool v1 = (row0 + stride) < nrows;
    uint4 ld[2][8];
    float bs0[2], bs1[2];
#pragma unroll
    for (int u = 0; u < 2; ++u) {
      const int row = row0 + u * stride;
      if (u == 0 || v1) {
        const size_t o = (size_t)row * 1024 + lane * 16;
        ld[u][0] = *(const uint4*)(y0 + o); ld[u][1] = *(const uint4*)(y0 + o + 8);
        ld[u][2] = *(const uint4*)(y1 + o); ld[u][3] = *(const uint4*)(y1 + o + 8);
        ld[u][4] = *(const uint4*)(vb + o); ld[u][5] = *(const uint4*)(vb + o + 8);
        ld[u][6] = *(const uint4*)(gb + o); ld[u][7] = *(const uint4*)(gb + o + 8);
        const int hh = lane >> 2;
        bs0[u] = bsum[(size_t)row * 32 + hh * 2]; bs1[u] = bsum[(size_t)row * 32 + hh * 2 + 1];
      }
    }
#pragma unroll
    for (int u = 0; u < 2; ++u) {
      const int row = row0 + u * stride;
      if (u == 0 || v1) {
        const size_t o = (size_t)row * 1024 + lane * 16;
        const uint4 a0 = ld[u][0], a1 = ld[u][1], b0 = ld[u][2], b1 = ld[u][3], v0 = ld[u][4], v1q = ld[u][5], g0 = ld[u][6], g1 = ld[u][7];
        unsigned ya[8] = {a0.x, a0.y, a0.z, a0.w, a1.x, a1.y, a1.z, a1.w};
        unsigned yb[8] = {b0.x, b0.y, b0.z, b0.w, b1.x, b1.y, b1.z, b1.w};
        unsigned vv[8] = {v0.x, v0.y, v0.z, v0.w, v1q.x, v1q.y, v1q.z, v1q.w};
        unsigned gg[8] = {g0.x, g0.y, g0.z, g0.w, g1.x, g1.y, g1.z, g1.w};
        float y[16];
        float sum = 0.f;
#pragma unroll
        for (int q = 0; q < 8; ++q) {
          y[2 * q] = bflo(ya[q]) + bflo(yb[q]);
          y[2 * q + 1] = bfhi(ya[q]) + bfhi(yb[q]);
          sum += y[2 * q] + y[2 * q + 1];
        }
        sum += __shfl_xor(sum, 1); sum += __shfl_xor(sum, 2);
        float mean = sum * (1.f / 64.f);
        float var = 0.f;
#pragma unroll
        for (int q = 0; q < 16; ++q) { float dd = y[q] - mean; var += dd * dd; }
        var += __shfl_xor(var, 1); var += __shfl_xor(var, 2);
        float rstd = rsqrtf(var * (1.f / 64.f) + 64e-5f);
        float bon = bs0[u] + bs1[u];
        unsigned ov[8];
#pragma unroll
        for (int q = 0; q < 8; ++q) {
          int c = lane * 16 + 2 * q;
          float o0 = ((y[2 * q] - mean) * rstd * lw[c] + lb[c] + bon * bflo(vv[q])) * bflo(gg[q]);
          float o1 = ((y[2 * q + 1] - mean) * rstd * lw[c + 1] + lb[c + 1] + bon * bfhi(vv[q])) * bfhi(gg[q]);
          ov[q] = pack2(o0, o1);
        }
        *(uint4*)(y0 + o) = make_uint4(ov[0], ov[1], ov[2], ov[3]);
        *(uint4*)(y0 + o + 8) = make_uint4(ov[4], ov[5], ov[6], ov[7]);
      }
    }
  }
}

__device__ __forceinline__ void phase_final(const Ctx& p, const int tid) {
  const float* gam = p.in[32];
  int lane = tid & 63, wv = tid >> 6;
  for (int row = blockIdx.x * 8 + wv; row < TL; row += gridDim.x * 8) {
    float* src = p.out + (size_t)row * 1024;
    float4 x[4];
    float ss = 0.f;
#pragma unroll
    for (int q = 0; q < 4; ++q) {
      x[q] = *(const float4*)(src + q * 256 + lane * 4);
      {
        uint2 dv = *(const uint2*)((const u16*)p.ws + (size_t)row * 1024 + q * 256 + lane * 4);
        x[q].x += bflo(dv.x); x[q].y += bfhi(dv.x); x[q].z += bflo(dv.y); x[q].w += bfhi(dv.y);
      }
      ss += x[q].x * x[q].x + x[q].y * x[q].y + x[q].z * x[q].z + x[q].w * x[q].w;
    }
    ss = wave_sum(ss);
    float rstd = rsqrtf(ss * (1.f / 1024.f) + 1e-6f);
#pragma unroll
    for (int q = 0; q < 4; ++q) {
      int col = q * 256 + lane * 4;
      float4 g = *(const float4*)(gam + col);
      float4 o = make_float4(x[q].x * rstd * g.x, x[q].y * rstd * g.y, x[q].z * rstd * g.z, x[q].w * rstd * g.w);
#if PROBE_STEPS
      { long long tt = *(const long long*)(p.ws + OFF_PROBE); int n2 = (int)(tt / 100); if (n2 > 30000) n2 = 30000;
        if (q == 0 && lane == 0 && row < n2) o.x += 0.125f; }
#endif
      *(float4*)(src + col) = o;
    }
  }
}

__device__ __forceinline__ void gemm_run_plain(const Ctx& p, char* smem, const int kind, const int layer, const int total, const int vbid, int tid) {
  u16* As = (u16*)smem;
  u16* Bs = As + 2 * 256 * 72;
  int ntile = vbid;
  bool first = true;
  GD g; LdSt Lc;
  Stg R0, R1;
  Frg F0, F1;
  for (;;) {
    const bool has_next = ntile < total;
    asm volatile("" : "+v"(tid));
    const int lane = tid & 63, w = tid >> 6, wm = w >> 1, wn = w & 1;
    const int lr = tid >> 3, lc = (tid & 7) * 8;
    const int sto = lr * 72 + lc;
    GD gn; make_gd(p, kind, layer, has_next ? ntile : total - 1, gn);
    LdSt Ln; ld_setup(Ln, gn, lr, lc);
    __builtin_amdgcn_s_waitcnt(0xC07F);
    if (first) {
      if (!has_next) break;
      g = gn; Lc = Ln;
      GEMM_LOADX(R0, Lc, 0)
      GEMM_LOADX(R1, Lc, 1)
      GEMM_STORE(R0, 0)
      __syncthreads();
      GEMM_READF(F0, 0, 0)
      first = false; ntile += gridDim.x;
      continue;
    }
    f32x16 acc[2][2];
#pragma unroll
    for (int i = 0; i < 2; ++i)
#pragma unroll
      for (int j = 0; j < 2; ++j)
#pragma unroll
        for (int r = 0; r < 16; ++r) acc[i][j][r] = 0.f;
    const int nk = Lc.nk;
    if (nk > 2) {
      GEMM_KSTEP(0, R0, Lc, 2, R1)
      GEMM_KSTEP(1, R1, Lc, 3, R0)
    }
    __builtin_amdgcn_s_waitcnt(0x0070);
    for (int kt = 2; kt + 2 < nk; kt += 2) {
      GEMM_KSTEP(0, R0, Lc, kt + 2, R1)
      GEMM_KSTEP(1, R1, Lc, kt + 3, R0)
    }
    GEMM_KSTEP(0, R0, Ln, 0, R1)
    GEMM_KSTEP_LAST(1, R1, Ln, 1, R0)
    gemm_epilogue(p, g, acc, tid);
    if (!has_next) break;
    GEMM_READF(F0, 0, 0)
    g = gn; Lc = Ln; ntile += gridDim.x;
  }
  __syncthreads();
}

__global__ void __launch_bounds__(512) fwd_megakernel(Params p0) {
  Ctx p; p.in = p0.in; p.out = p0.out; p.ws = p0.ws;
  extern __shared__ __attribute__((aligned(16))) char smem[];
  cg::grid_group grid = cg::this_grid();

  int tid0 = threadIdx.x;
  asm volatile("" : "+v"(tid0));
  phase_mod(p, smem, tid0);
  grid.sync();
  for (int ph = 0; ph < 40; ++ph) {
    const int layer = ph / 10, step = ph % 10;
    const int idx = layer >> 1;
    const bool rw = (layer & 1) == 0;
    const bool ctx_in = layer <= 2, ctx_out = layer < 2;
    const int rows_in = ctx_in ? T : TL, rows_out = ctx_out ? T : TL;
    int gk = -1;
    int tid = threadIdx.x;
    Ctx q; q.in = p0.in;
    {
      unsigned long long w_ = (unsigned long long)p0.ws, o_ = (unsigned long long)p0.out;
      unsigned wl = __builtin_amdgcn_readfirstlane((unsigned)w_), wh = __builtin_amdgcn_readfirstlane((unsigned)(w_ >> 32));
      unsigned ol = __builtin_amdgcn_readfirstlane((unsigned)o_), oh = __builtin_amdgcn_readfirstlane((unsigned)(o_ >> 32));
      asm volatile("" : "+s"(wl), "+s"(wh), "+s"(ol), "+s"(oh));
      q.ws = (char*)(((unsigned long long)wh << 32) | wl);
      q.out = (float*)(((unsigned long long)oh << 32) | ol);
    }
#if PROBE_STEPS
    if (blockIdx.x == 0 && tid == 0) ((long long*)(q.ws + OFF_PROBE))[1] = wall_clock64();
#endif
#define OPAQUE_TID() asm volatile("" : "+v"(tid))
    if (step == 0 || step == 7) {
      OPAQUE_TID();
      {
        const u16* dl = (step == 7) ? (const u16*)(q.ws + (rw ? 1 : 2) * SLOT) : ((ph == 0) ? (const u16*)nullptr : (const u16*)q.ws);
        const int drows = (step == 7) ? rows_out : ((layer - 1) < 2 ? T : TL);
        prep_rows(q, layer, step == 0 ? 0 : 1, step == 0 ? rows_in : rows_out, ph == 0, dl, drows, tid);
      }
      if (step == 0) {
        OPAQUE_TID();
        convert_weights(q, smem, layer, tid);
        if (!rw) { OPAQUE_TID(); fourier_tables(q, ctx_in, tid); }
      }
    } else if (step == 1) gk = rw ? G_RB : G_FB;
    else if (step == 2) gk = rw ? G_RC : G_F1;
    else if (step == 3) { if (rw && idx != 1) continue; gk = rw ? G_RC2 : G_F2; }
    else if (step == 4) { if (!rw) continue; OPAQUE_TID(); phase_scan(q, smem, idx, ctx_out, tid); }
    else if (step == 5) { if (!rw) continue; OPAQUE_TID(); phase_readout(q, idx, rows_out, tid); }
    else if (step == 6) gk = rw ? G_WO_R : G_WO_F;
    else if (step == 8) gk = G_MLP1;
    else gk = G_MLP2;
    if (gk >= 0) {
      const int total = gemm_total(gk, layer);
      const int vbid = (int)(blockIdx.x & 7) * (int)(gridDim.x >> 3) + (int)(blockIdx.x >> 3);
      if (gk == G_RB || gk == G_RC2) {
        for (int tile = vbid; tile < total; tile += gridDim.x) {
          GD g;
          make_gd(q, gk, layer, tile, g);
          OPAQUE_TID();
          gemm_tile_mix(q, smem, g, tid);
        }
      } else {
        gemm_run_plain(q, smem, gk, layer, total, vbid, tid);
      }
    }
    grid.sync();
#if PROBE_STEPS
    if (blockIdx.x == 0 && threadIdx.x == 0) {
      long long* pr = (long long*)(p.ws + OFF_PROBE);
      if (ph == 0) pr[0] = 0;
      if (((PROBE_STEPS >> step) & 1) && ((PROBE_LAYERS >> layer) & 1)) pr[0] += wall_clock64() - pr[1];
    }
#endif
  }
#if PROBE_STEPS
  grid.sync();
#endif
  int tid1 = threadIdx.x;
  asm volatile("" : "+v"(tid1));
  phase_final(p, tid1);
}

extern "C" void kernel_launch(void* const* d_in, const int* in_sizes, int n_in,
                              void* d_out, int out_size, void* d_ws, size_t ws_size,
                              hipStream_t stream) {
  static int grid_blocks = 0;
  if (!grid_blocks) {
    int dev = 0, cus = 0, per_cu = 0;
    (void)hipGetDevice(&dev);
    (void)hipDeviceGetAttribute(&cus, hipDeviceAttributeMultiprocessorCount, dev);
    if (hipFuncSetAttribute((const void*)fwd_megakernel, hipFuncAttributeMaxDynamicSharedMemorySize, LDS_BYTES) != hipSuccess)
      fprintf(stderr, "hipFuncSetAttribute failed\n");
    (void)hipOccupancyMaxActiveBlocksPerMultiprocessor(&per_cu, (const void*)fwd_megakernel, 512, LDS_BYTES);
    if (per_cu < 1) { fprintf(stderr, "occupancy query returned %d\n", per_cu); per_cu = 1; }
    (void)hipGetLastError();
    grid_blocks = cus;
    if (ws_size < WS_END) fprintf(stderr, "workspace too small: %zu < %zu\n", ws_size, (size_t)WS_END);
  }
  Params p{};
  for (int i = 0; i < 33; ++i) p.in[i] = (const float*)d_in[i];
  p.out = (float*)d_out;
  p.ws = (char*)d_ws;
  void* args[] = {&p};
  hipError_t e = hipLaunchCooperativeKernel((const void*)fwd_megakernel, dim3(grid_blocks), dim3(512), args, LDS_BYTES, stream);
  if (e != hipSuccess) fprintf(stderr, "cooperative launch failed: %s (grid %d)\n", hipGetErrorString(e), grid_blocks);
}
```

```cpp
#include <hip/hip_runtime.h>
#include <hip/hip_cooperative_groups.h>
#include <cstdio>
namespace cg = cooperative_groups;

typedef unsigned short u16;
typedef __attribute__((ext_vector_type(8))) short bf16x8;
typedef __attribute__((ext_vector_type(16))) float f32x16;
typedef __attribute__((ext_vector_type(4))) float f32x4;
typedef __attribute__((ext_vector_type(2))) float f32x2;
typedef __attribute__((ext_vector_type(2))) __bf16 bf16x2v;

constexpr int TL = 8 * 4096, TC = 8 * 256, T = TL + TC;
constexpr size_t SLOT = (size_t)T * 1024 * 2;
constexpr size_t OFF_CTXRES = 6 * SLOT;
constexpr size_t OFF_MOD = OFF_CTXRES + (size_t)TC * 1024 * 4;
constexpr size_t OFF_HW = OFF_MOD + 4 * 9 * 6144 * 4;
constexpr size_t OFF_HA = OFF_HW + (size_t)T * 128 * 2;
constexpr size_t OFF_HG = OFF_HA + (size_t)T * 128 * 2;
constexpr size_t OFF_HV = OFF_HG + (size_t)T * 128 * 2;
constexpr size_t OFF_BSUM = OFF_HV + (size_t)T * 128 * 2;
constexpr size_t OFF_WMIX = OFF_BSUM + (size_t)T * 32 * 4;
constexpr size_t M1 = 1048576;
constexpr size_t WMIX_ELEMS = 4 * M1 + 6 * 131072;
constexpr size_t OFF_WMLP = OFF_WMIX + WMIX_ELEMS * 2;
constexpr size_t WS_END = OFF_WMLP + 2 * 4 * M1 * 2;
constexpr int LDS_BYTES = 131072;
#ifndef PROBE_STEPS
#define PROBE_STEPS 0
#endif
#ifndef PROBE_LAYERS
#define PROBE_LAYERS 15
#endif
constexpr size_t OFF_PROBE = WS_END;

struct Params {
  const float* in[33];
  float* out;
  char* ws;
};
struct Ctx { const float* const* in; float* out; char* ws; };

__device__ __forceinline__ unsigned pack2(float a, float b) {
  f32x2 v = {a, b};
  bf16x2v r = __builtin_convertvector(v, bf16x2v);
  return __builtin_bit_cast(unsigned, r);
}
__device__ __forceinline__ u16 f2bf(float a) { return (u16)(pack2(a, 0.f) & 0xffffu); }
__device__ __forceinline__ float bflo(unsigned u) { return __uint_as_float(u << 16); }
__device__ __forceinline__ float bfhi(unsigned u) { return __uint_as_float(u & 0xffff0000u); }
__device__ __forceinline__ float bf2f(u16 h) { return __uint_as_float(((unsigned)h) << 16); }
__device__ __forceinline__ float wave_sum(float v) {
#pragma unroll
  for (int o = 32; o > 0; o >>= 1) v += __shfl_xor(v, o);
  return v;
}
#define DPP_ROR_ADD(x, n) x += __builtin_bit_cast(float, __builtin_amdgcn_update_dpp(0, __builtin_bit_cast(int, x), 0x120 + (n), 0xf, 0xf, true))
__device__ __forceinline__ float sigmoidf_(float x) { return __builtin_amdgcn_rcpf(1.f + __expf(-x)); }
__device__ __forceinline__ float xrow_sum(float x) {
  unsigned u = __float_as_uint(x);
  auto r = __builtin_amdgcn_permlane32_swap(u, u, false, false);
  float s = __uint_as_float(r[0]) + __uint_as_float(r[1]);
  u = __float_as_uint(s);
  auto r2 = __builtin_amdgcn_permlane16_swap(u, u, false, false);
  return __uint_as_float(r2[0]) + __uint_as_float(r2[1]);
}

__device__ __forceinline__ float wave_sum_fast(float x) {
  DPP_ROR_ADD(x, 8); DPP_ROR_ADD(x, 4); DPP_ROR_ADD(x, 2); DPP_ROR_ADD(x, 1);
  return xrow_sum(x);
}

__device__ __forceinline__ void phase_mod(const Ctx& p, char* smem, const int tid) {
  float* sv = (float*)smem;
  float* red = sv + 9 * 1024;
  const float* c = p.in[1];
  const float* cc = p.in[3];
  const float* mod_w = p.in[6];
  const float* mod_b = p.in[7];
  float* mod = (float*)(p.ws + OFF_MOD);
  for (int e = tid; e < 9 * 1024; e += 512) {
    int j = e >> 10, k = e & 1023;
    float v = (j < 8) ? c[j * 1024 + k] : cc[k];
    sv[e] = v / (1.f + expf(-v));
  }
  __syncthreads();
  for (int item = blockIdx.x; item < 384; item += gridDim.x) {
    int layer = item / 96, c0 = (item % 96) * 64;
    int kq = tid >> 6, col = tid & 63;
    const float* w = mod_w + (size_t)layer * 1024 * 6144 + c0 + col;
    float acc[9];
#pragma unroll
    for (int j = 0; j < 9; ++j) acc[j] = 0.f;
#pragma unroll 8
    for (int k = kq * 128; k < kq * 128 + 128; ++k) {
      float wv = w[(size_t)k * 6144];
#pragma unroll
      for (int j = 0; j < 9; ++j) acc[j] += sv[j * 1024 + k] * wv;
    }
#pragma unroll
    for (int j = 0; j < 9; ++j) red[(kq * 9 + j) * 64 + col] = acc[j];
    __syncthreads();
    for (int e = tid; e < 9 * 64; e += 512) {
      int j = e >> 6, cx = e & 63;
      float s = 0.f;
#pragma unroll
      for (int q = 0; q < 8; ++q) s += red[(q * 9 + j) * 64 + cx];
      s += mod_b[layer * 6144 + c0 + cx];
      mod[(layer * 9 + j) * 6144 + c0 + cx] = s;
    }
    __syncthreads();
  }
}

__device__ __forceinline__ void prep_rows(const Ctx& p, int layer, int which, int nrows, bool from_input, const u16* delta, int drows, const int tid) {
  const float* gam = (which == 0 ? p.in[4] : p.in[5]) + layer * 1024;
  const float* mod = (const float*)(p.ws + OFF_MOD);
  float* ctxres = (float*)(p.ws + OFF_CTXRES);
  u16* H = (u16*)(p.ws);
  int lane = tid & 63, wv = tid >> 6;
  const int stride = gridDim.x * 8;
  for (int row0 = blockIdx.x * 8 + wv; row0 < nrows; row0 += 2 * stride) {
    float4 x[2][4];
    uint2 dv[2][4];
    const bool v1 = (row0 + stride) < nrows;
#pragma unroll
    for (int u = 0; u < 2; ++u) {
      const int row = row0 + u * stride;
      if (u == 0 || v1) {
        const float* src = (row < TL) ? ((from_input ? p.in[0] : p.out) + (size_t)row * 1024) : ((from_input ? p.in[2] : ctxres) + (size_t)(row - TL) * 1024);
        const bool upd = (delta != nullptr) && (row < drows);
#pragma unroll
        for (int q = 0; q < 4; ++q) {
          x[u][q] = *(const float4*)(src + q * 256 + lane * 4);
          dv[u][q] = make_uint2(0, 0);
          if (upd) dv[u][q] = *(const uint2*)(delta + (size_t)row * 1024 + q * 256 + lane * 4);
        }
      }
    }
#pragma unroll
    for (int u = 0; u < 2; ++u) {
      const int row = row0 + u * stride;
      if (u == 0 || v1) {
        float* dst = (row < TL) ? (p.out + (size_t)row * 1024) : (ctxres + (size_t)(row - TL) * 1024);
        const bool upd = (delta != nullptr) && (row < drows);
        float ss = 0.f;
#pragma unroll
        for (int q = 0; q < 4; ++q) {
          x[u][q].x += bflo(dv[u][q].x); x[u][q].y += bfhi(dv[u][q].x); x[u][q].z += bflo(dv[u][q].y); x[u][q].w += bfhi(dv[u][q].y);
          ss += x[u][q].x * x[u][q].x + x[u][q].y * x[u][q].y + x[u][q].z * x[u][q].z + x[u][q].w * x[u][q].w;
        }
        ss = wave_sum(ss);
        float rstd = rsqrtf(ss * (1.f / 1024.f) + 1e-6f);
        int j = (row < TL) ? (row >> 12) : 8;
        const float* mp = mod + (size_t)(layer * 9 + j) * 6144 + which * 3072;
#pragma unroll
        for (int q = 0; q < 4; ++q) {
          int col = q * 256 + lane * 4;
          if (from_input || upd) *(float4*)(dst + col) = x[u][q];
          float4 g = *(const float4*)(gam + col);
          float4 sh = *(const float4*)(mp + col);
          float4 sc = *(const float4*)(mp + 1024 + col);
          float h0 = x[u][q].x * rstd * g.x * (1.f + sc.x) + sh.x;
          float h1 = x[u][q].y * rstd * g.y * (1.f + sc.y) + sh.y;
          float h2 = x[u][q].z * rstd * g.z * (1.f + sc.z) + sh.z;
          float h3 = x[u][q].w * rstd * g.w * (1.f + sc.w) + sh.w;
          uint2 o; o.x = pack2(h0, h1); o.y = pack2(h2, h3);
          *(uint2*)(H + (size_t)row * 1024 + col) = o;
        }
      }
    }
  }
}

struct CJ { const float* src; int K, N, ld; u16* dst; int ldd, Kp, Np; };
__device__ __forceinline__ void get_cj(const Ctx& p, int layer, int j, CJ& c) {
  const int idx = layer >> 1;
  u16* wm = (u16*)(p.ws + OFF_WMIX);
  u16* wl = (u16*)(p.ws + OFF_WMLP);
  c.K = 1024; c.N = 1024; c.ld = 1024; c.ldd = 1024; c.Kp = 1024; c.Np = 1024; c.src = nullptr; c.dst = nullptr;
  if (j == 0) { c.src = p.in[8] + (size_t)layer * 4 * M1; c.N = 4096; c.ld = 4096; c.dst = wl; c.Np = 4096; }
  else if (j == 1) { c.src = p.in[9] + (size_t)layer * 4 * M1; c.K = 4096; c.dst = wl + 4 * M1; c.ldd = 4096; c.Kp = 4096; }
  else if (layer & 1) { c.src = p.in[31] + (size_t)idx * M1; c.dst = wm; }
  else if (j < 6) { c.src = p.in[11 + (j - 2)] + (size_t)idx * M1; c.dst = wm + (size_t)(j - 2) * M1; }
  else if (j < 10) {
    int d = j & 1; bool isa = j >= 8;
    c.src = p.in[isa ? 19 : 16] + (size_t)(idx * 2 + d) * 65536; c.N = 64; c.ld = 64; c.Np = 64;
    c.dst = wm + 4 * M1 + (isa ? 131072 : 0) + d * 65536;
  }
  else if (j == 10) { c.src = p.in[24] + (size_t)idx * 131072; c.N = 128; c.ld = 128; c.Np = 128; c.dst = wm + 4 * M1 + 2 * 131072; }
  else if (j == 11) { c.src = p.in[25] + (size_t)idx * 131072; c.K = 128; c.Kp = 128; c.ldd = 128; c.dst = wm + 4 * M1 + 4 * 131072; }
  else if (j == 12) { c.src = p.in[22]; c.N = 32; c.ld = 32; c.Np = 128; c.dst = wm + 4 * M1 + 3 * 131072; }
  else { c.src = p.in[23]; c.K = 32; c.Kp = 128; c.ldd = 128; c.dst = wm + 4 * M1 + 5 * 131072; }
}

__device__ __forceinline__ void convert_weights(const Ctx& p, char* smem, int layer, const int tid) {
  float* tile = (float*)smem;
  const int nj = (layer & 1) ? 3 : ((layer >> 1) == 1 ? 14 : 12);
  int rot = 0;
  for (int j = 0; j < nj; ++j) {
    CJ c; get_cj(p, layer, j, c);
    const int nnt = c.Np >> 6, ntiles = (c.Kp >> 6) * nnt;
    int start = (int)blockIdx.x - rot; if (start < 0) start += gridDim.x;
    for (int t = start; t < ntiles; t += gridDim.x) {
      int k0 = (t / nnt) << 6, n0 = (t % nnt) << 6;
      int r = tid >> 4, c4 = (tid & 15) * 4;
#pragma unroll
      for (int hh = 0; hh < 2; ++hh) {
        int rr = r + hh * 32;
        float4 v = make_float4(0.f, 0.f, 0.f, 0.f);
        if (k0 + rr < c.K && n0 + c4 < c.N) v = *(const float4*)(c.src + (size_t)(k0 + rr) * c.ld + n0 + c4);
        tile[(c4 + 0) * 65 + rr] = v.x; tile[(c4 + 1) * 65 + rr] = v.y; tile[(c4 + 2) * 65 + rr] = v.z; tile[(c4 + 3) * 65 + rr] = v.w;
      }
      __syncthreads();
      int n = tid >> 3, kc = (tid & 7) * 8;
      const float* tp = tile + n * 65 + kc;
      uint4 o;
      o.x = pack2(tp[0], tp[1]); o.y = pack2(tp[2], tp[3]); o.z = pack2(tp[4], tp[5]); o.w = pack2(tp[6], tp[7]);
      *(uint4*)(c.dst + (size_t)(n0 + n) * c.ldd + k0 + kc) = o;
      __syncthreads();
    }
    rot = (rot + ntiles) % (int)gridDim.x;
  }
}

__device__ __forceinline__ void fourier_tables(const Ctx& p, bool with_ctx, const int tid) {
  u16* wm = (u16*)(p.ws + OFF_WMIX);
  u16* dftT = wm + M1;
  u16* m1t = dftT + 131072;
  u16* m2t = m1t + 16384;
  u16* dftC = m2t + 8192;
  float2* tw = (float2*)(dftC + 131072);
  size_t gtid = (size_t)blockIdx.x * 512 + tid, gsz = (size_t)gridDim.x * 512;
  for (size_t e = gtid; e < 512 * 256 / 8; e += gsz) {
    int r = (int)(e >> 5), c0 = (int)(e & 31) * 8;
    int ri = r >> 8, m = r & 255;
    float v[8];
#pragma unroll
    for (int q = 0; q < 8; ++q) {
      int ph = (m * (c0 + q)) & 255;
      float s, c; sincospif((float)ph * (1.f / 128.f), &s, &c);
      v[q] = (ri ? s : c) * (1.f / 16.f);
    }
    uint4 o; o.x = pack2(v[0], v[1]); o.y = pack2(v[2], v[3]); o.z = pack2(v[4], v[5]); o.w = pack2(v[6], v[7]);
    *(uint4*)(dftT + (size_t)r * 256 + c0) = o;
  }
  for (size_t e = gtid; e < 128 * 128; e += gsz) {
    int rho = (int)(e >> 7), kap = (int)(e & 127);
    int qq = rho >> 5, part = qq & 1, k1 = (qq >> 1) * 32 + (rho & 31);
    int ri = kap >> 6, l1 = kap & 63;
    int ph = (k1 * l1) & 63;
    float s, c; sincospif((float)ph * (1.f / 32.f), &s, &c);
    float v = (part == 0) ? (ri == 0 ? c : -s) : (ri == 0 ? -s : -c);
    m1t[e] = f2bf(v);
  }
  for (size_t e = gtid; e < 64 * 128; e += gsz) {
    int k2 = (int)(e >> 7), kap = (int)(e & 127);
    int ri = kap >> 6, l2 = kap & 63;
    int ph = (k2 * l2) & 63;
    float s, c; sincospif((float)ph * (1.f / 32.f), &s, &c);
    m2t[e] = f2bf((ri == 0 ? c : s) * (1.f / 64.f));
  }
  for (size_t e = gtid; e < 64 * 64; e += gsz) {
    int k1 = (int)(e >> 6), l2 = (int)(e & 63);
    float s, c; sincospif((float)(k1 * l2) * (1.f / 2048.f), &s, &c);
    tw[e] = make_float2(c, s);
  }
  if (with_ctx) {
    for (size_t e = gtid; e < 256 * 512 / 8; e += gsz) {
      int k = (int)(e >> 6), kap = (int)(e & 63) * 8;
      int ri = kap >> 8, l0 = kap & 255;
      float v[8];
#pragma unroll
      for (int q = 0; q < 8; ++q) {
        int ph = (k * (l0 + q)) & 255;
        float s, c; sincospif((float)ph * (1.f / 128.f), &s, &c);
        v[q] = (ri ? -s : c) * (1.f / 16.f);
      }
      uint4 o; o.x = pack2(v[0], v[1]); o.y = pack2(v[2], v[3]); o.z = pack2(v[4], v[5]); o.w = pack2(v[6], v[7]);
      *(uint4*)(dftC + (size_t)k * 512 + kap) = o;
    }
  }
}

struct GD {
  const u16* A; long lda; int a_rowmask; int a_mode; const float* mu;
  const u16* B; long b_rs_hi, b_rs_lo; int b_kshift; long b_kstride; int b_perm; int a_kshift; long a_kstride;
  int K, m0, n0;
  int ep; u16* out; long ldo; u16* out2; const float* e0; const u16* gsrc;
};
__device__ __forceinline__ void gd_plainA(GD& g, const u16* A, long lda) { g.A = A; g.lda = lda; g.a_rowmask = 0x7fffffff; g.a_mode = 0; g.mu = nullptr; g.a_kshift = 30; g.a_kstride = 0; }
__device__ __forceinline__ void gd_mixA(GD& g, const u16* H, const float* mu) { g.A = H; g.lda = 1024; g.a_rowmask = 0x7fffffff; g.a_mode = 1; g.mu = mu; g.a_kshift = 30; g.a_kstride = 0; }
__device__ __forceinline__ void gd_plainB(GD& g, const u16* B, long ldb) { g.B = B; g.b_rs_hi = 256 * ldb; g.b_rs_lo = ldb; g.b_kshift = 30; g.b_kstride = 0; g.b_perm = 0; }

__device__ __forceinline__ unsigned mix2(unsigned h, unsigned s, float m0, float m1) {
  float h0 = bflo(h), h1 = bfhi(h), s0 = bflo(s), s1 = bfhi(s);
  return pack2(h0 + (s0 - h0) * m0, h1 + (s1 - h1) * m1);
}

#define EPI_LOOP(LD, BODY) \
  _Pragma("unroll") for (int i = 0; i < 2; ++i) { _Pragma("unroll") for (int j = 0; j < 2; ++j) { \
    _Pragma("unroll") for (int r = 0; r < 16; ++r) { \
      const int off = (32 * i + (r & 3) + 8 * (r >> 2)) * (LD) + 32 * j; \
      const float v = acc[i][j][r]; BODY } \
    asm volatile("" ::: "memory"); } }

struct Stg { uint4 a0, a1, a2, a3, b0, b1; };

__device__ __forceinline__ int mix_nb(int t, int k) {
  int nb = -1;
  if (t < TL) {
    int l = t & 4095, c = l & 63, r = l >> 6, qq = k >> 8;
    if (qq == 0) nb = (c > 0) ? t - 1 : -1;
    else if (qq == 1) nb = (c < 63) ? t + 1 : -1;
    else if (qq == 2) nb = (r > 0) ? t - 64 : -1;
    else nb = (r < 63) ? t + 64 : -1;
  } else {
    int pp = (t - TL) & 255;
    if (k < 512) nb = (pp > 0) ? t - 1 : -1; else nb = (pp < 255) ? t + 1 : -1;
  }
  return nb;
}
__device__ __forceinline__ uint4 ld16(const u16* ptr) { return *(const uint4*)ptr; }
__device__ __forceinline__ uint4 mix4(uint4 h, uint4 s, float4 m0, float4 m1) {
  uint4 o;
  o.x = mix2(h.x, s.x, m0.x, m0.y); o.y = mix2(h.y, s.y, m0.z, m0.w);
  o.z = mix2(h.z, s.z, m1.x, m1.y); o.w = mix2(h.w, s.w, m1.z, m1.w);
  return o;
}

#define GEMM_HALF(KH) { \
    bf16x8 fa0[2], fa1[2], fb0[2], fb1[2]; \
    _Pragma("unroll") for (int kk = 0; kk < 2; ++kk) { \
      fa0[kk] = *(const bf16x8*)(ab + ((KH) * 2 + kk) * 16); \
      fb0[kk] = *(const bf16x8*)(bb + ((KH) * 2 + kk) * 16); \
      fa1[kk] = *(const bf16x8*)(ab + 32 * 72 + ((KH) * 2 + kk) * 16); \
      fb1[kk] = *(const bf16x8*)(bb + 32 * 72 + ((KH) * 2 + kk) * 16); } \
    __builtin_amdgcn_sched_barrier(0); \
    _Pragma("unroll") for (int kk = 0; kk < 2; ++kk) { \
      acc[0][0] = __builtin_amdgcn_mfma_f32_32x32x16_bf16(fa0[kk], fb0[kk], acc[0][0], 0, 0, 0); \
      acc[0][1] = __builtin_amdgcn_mfma_f32_32x32x16_bf16(fa0[kk], fb1[kk], acc[0][1], 0, 0, 0); \
      acc[1][0] = __builtin_amdgcn_mfma_f32_32x32x16_bf16(fa1[kk], fb0[kk], acc[1][0], 0, 0, 0); \
      acc[1][1] = __builtin_amdgcn_mfma_f32_32x32x16_bf16(fa1[kk], fb1[kk], acc[1][1], 0, 0, 0); \
    } \
    __builtin_amdgcn_sched_barrier(0); }
#define GEMM_COMPUTE(BUF) { \
    const u16* ab = As + (BUF) * 256 * 72 + (64 * wm + (lane & 31)) * 72 + 8 * (lane >> 5); \
    const u16* bb = Bs + (BUF) * 128 * 72 + (64 * wn + (lane & 31)) * 72 + 8 * (lane >> 5); \
    __builtin_amdgcn_sched_barrier(0); \
    GEMM_HALF(0) GEMM_HALF(1) }
struct Frg { bf16x8 a00, a01, a10, a11, b00, b01, b10, b11; };
#define GEMM_READF(F, BUF, KH) { \
    const u16* ab_ = As + (BUF) * 256 * 72 + (64 * wm + (lane & 31)) * 72 + 8 * (lane >> 5) + (KH) * 32; \
    const u16* bb_ = Bs + (BUF) * 128 * 72 + (64 * wn + (lane & 31)) * 72 + 8 * (lane >> 5) + (KH) * 32; \
    F.a00 = *(const bf16x8*)(ab_);           F.a01 = *(const bf16x8*)(ab_ + 16); \
    F.b00 = *(const bf16x8*)(bb_);           F.b01 = *(const bf16x8*)(bb_ + 16); \
    F.a10 = *(const bf16x8*)(ab_ + 32 * 72); F.a11 = *(const bf16x8*)(ab_ + 32 * 72 + 16); \
    F.b10 = *(const bf16x8*)(bb_ + 32 * 72); F.b11 = *(const bf16x8*)(bb_ + 32 * 72 + 16); }
#define GEMM_MFMA8(F) { \
    acc[0][0] = __builtin_amdgcn_mfma_f32_32x32x16_bf16(F.a00, F.b00, acc[0][0], 0, 0, 0); \
    acc[0][1] = __builtin_amdgcn_mfma_f32_32x32x16_bf16(F.a00, F.b10, acc[0][1], 0, 0, 0); \
    acc[1][0] = __builtin_amdgcn_mfma_f32_32x32x16_bf16(F.a10, F.b00, acc[1][0], 0, 0, 0); \
    acc[1][1] = __builtin_amdgcn_mfma_f32_32x32x16_bf16(F.a10, F.b10, acc[1][1], 0, 0, 0); \
    acc[0][0] = __builtin_amdgcn_mfma_f32_32x32x16_bf16(F.a01, F.b01, acc[0][0], 0, 0, 0); \
    acc[0][1] = __builtin_amdgcn_mfma_f32_32x32x16_bf16(F.a01, F.b11, acc[0][1], 0, 0, 0); \
    acc[1][0] = __builtin_amdgcn_mfma_f32_32x32x16_bf16(F.a11, F.b01, acc[1][0], 0, 0, 0); \
    acc[1][1] = __builtin_amdgcn_mfma_f32_32x32x16_bf16(F.a11, F.b11, acc[1][1], 0, 0, 0); }
#define GEMM_KSTEP_LAST(BUF, RLOAD, LSRC, KT, RSTORE) { \
    GEMM_READF(F1, BUF, 1) \
    GEMM_LOADX(RLOAD, LSRC, KT) \
    __builtin_amdgcn_sched_barrier(0); \
    GEMM_MFMA8(F0) \
    __builtin_amdgcn_sched_barrier(0); \
    GEMM_STORE(RSTORE, (BUF) ^ 1) \
    __syncthreads(); \
    GEMM_MFMA8(F1) \
    __builtin_amdgcn_sched_barrier(0); }
#define GEMM_KSTEP(BUF, RLOAD, LSRC, KT, RSTORE) { \
    GEMM_READF(F1, BUF, 1) \
    GEMM_LOADX(RLOAD, LSRC, KT) \
    __builtin_amdgcn_sched_barrier(0); \
    GEMM_MFMA8(F0) \
    __builtin_amdgcn_sched_barrier(0); \
    GEMM_STORE(RSTORE, (BUF) ^ 1) \
    __syncthreads(); \
    GEMM_READF(F0, (BUF) ^ 1, 0) \
    __builtin_amdgcn_sched_barrier(0); \
    GEMM_MFMA8(F1) \
    __builtin_amdgcn_sched_barrier(0); }
#define GEMM_LOADX(R, L, KT) { const int k0_ = min((KT), L.nk - 1) * 64; \
    const int soa_ = __builtin_amdgcn_readfirstlane((int)(((long)(k0_ >> L.akshift) * L.akstride + (k0_ & L.akmask)) * 2)); \
    const int sob_ = __builtin_amdgcn_readfirstlane((int)(((long)(k0_ >> L.kshift) * L.kstride + (k0_ & L.kmask)) * 2)); \
    const __amdgpu_buffer_rsrc_t rsA_ = make_rsrc(L.baseA); const __amdgpu_buffer_rsrc_t rsB_ = make_rsrc(L.baseB); \
    R.a0 = bufld(rsA_, L.va0, soa_); R.a1 = bufld(rsA_, L.va1, soa_); R.a2 = bufld(rsA_, L.va2, soa_); R.a3 = bufld(rsA_, L.va3, soa_); \
    R.b0 = bufld(rsB_, L.vb0, sob_); R.b1 = bufld(rsB_, L.vb1, sob_); }
#define GEMM_STORE(R, BUF) { u16* ad_ = As + (BUF) * 256 * 72 + sto; u16* bd_ = Bs + (BUF) * 128 * 72 + sto; \
    *(uint4*)(ad_) = R.a0; *(uint4*)(ad_ + 64 * 72) = R.a1; *(uint4*)(ad_ + 128 * 72) = R.a2; *(uint4*)(ad_ + 192 * 72) = R.a3; \
    *(uint4*)(bd_) = R.b0; *(uint4*)(bd_ + 64 * 72) = R.b1; }

typedef __attribute__((ext_vector_type(4))) unsigned u32x4;
__device__ __forceinline__ __amdgpu_buffer_rsrc_t make_rsrc(const u16* q) {
  unsigned long long v = (unsigned long long)q;
  unsigned lo = __builtin_amdgcn_readfirstlane((unsigned)v), hi = __builtin_amdgcn_readfirstlane((unsigned)(v >> 32));
  void* up = (void*)(((unsigned long long)hi << 32) | lo);
  return __builtin_amdgcn_make_buffer_rsrc(up, (short)0, 0x7ffffff0, 0x00020000);
}
__device__ __forceinline__ uint4 bufld(__amdgpu_buffer_rsrc_t rs, unsigned voff, int soff) {
  u32x4 v = __builtin_amdgcn_raw_buffer_load_b128(rs, (int)voff, soff, 0);
  return make_uint4(v[0], v[1], v[2], v[3]);
}

struct LdSt { const u16* baseA; const u16* baseB; unsigned va0, va1, va2, va3, vb0, vb1; int nk, kshift, kmask; long kstride; int akshift, akmask; long akstride; };
__device__ __forceinline__ void ld_setup(LdSt& L, const GD& g, const int lr, const int lc) {
  L.baseA = g.A; L.baseB = g.B + (long)(g.n0 >> 8) * g.b_rs_hi;
  const unsigned nl = (unsigned)(g.n0 & 255) + (unsigned)lr;
  L.vb0 = (nl * (unsigned)g.b_rs_lo + (unsigned)lc) * 2u;
  L.vb1 = ((nl + 64u) * (unsigned)g.b_rs_lo + (unsigned)lc) * 2u;
  const int t0 = g.m0 + lr;
  const unsigned ulda = (unsigned)g.lda;
  L.va0 = ((unsigned)((t0) & g.a_rowmask) * ulda + (unsigned)lc) * 2u;
  L.va1 = ((unsigned)((t0 + 64) & g.a_rowmask) * ulda + (unsigned)lc) * 2u;
  L.va2 = ((unsigned)((t0 + 128) & g.a_rowmask) * ulda + (unsigned)lc) * 2u;
  L.va3 = ((unsigned)((t0 + 192) & g.a_rowmask) * ulda + (unsigned)lc) * 2u;
  L.nk = g.K >> 6; L.kshift = g.b_kshift; L.kmask = (1 << g.b_kshift) - 1; L.kstride = g.b_kstride;
  L.akshift = g.a_kshift; L.akmask = (1 << g.a_kshift) - 1; L.akstride = g.a_kstride;
  if (g.b_perm == 1) {
    const unsigned n_0 = (unsigned)g.n0 + (unsigned)lr, n_1 = n_0 + 64u;
    const unsigned tk0 = (n_0 & ~4095u) | ((n_0 & 63u) << 6) | ((n_0 >> 6) & 63u);
    const unsigned tk1 = (n_1 & ~4095u) | ((n_1 & 63u) << 6) | ((n_1 >> 6) & 63u);
    L.baseB = g.B;
    L.vb0 = (tk0 * 1024u + (unsigned)lc) * 2u; L.vb1 = (tk1 * 1024u + (unsigned)lc) * 2u;
  } else if (g.b_perm == 2) {
    const unsigned n_0 = (unsigned)g.n0 + (unsigned)lr, n_1 = n_0 + 64u;
    const unsigned r0 = (((n_0 & 1023u) * 8u + (n_0 >> 16)) * 64u + ((n_0 >> 10) & 63u));
    const unsigned r1 = (((n_1 & 1023u) * 8u + (n_1 >> 16)) * 64u + ((n_1 >> 10) & 63u));
    L.baseB = g.B;
    L.vb0 = (r0 * 128u + (unsigned)lc) * 2u; L.vb1 = (r1 * 128u + (unsigned)lc) * 2u;
  }
}
__device__ __forceinline__ void ld_select(LdSt& o, const bool c, const LdSt& a, const LdSt& b) {
  o.baseA = c ? a.baseA : b.baseA; o.baseB = c ? a.baseB : b.baseB;
  o.va0 = c ? a.va0 : b.va0; o.va1 = c ? a.va1 : b.va1; o.va2 = c ? a.va2 : b.va2; o.va3 = c ? a.va3 : b.va3;
  o.vb0 = c ? a.vb0 : b.vb0; o.vb1 = c ? a.vb1 : b.vb1;
  o.nk = c ? a.nk : b.nk; o.kshift = c ? a.kshift : b.kshift; o.kmask = c ? a.kmask : b.kmask; o.kstride = c ? a.kstride : b.kstride;
  o.akshift = c ? a.akshift : b.akshift; o.akmask = c ? a.akmask : b.akmask; o.akstride = c ? a.akstride : b.akstride;
}

__device__ __forceinline__ void gemm_epilogue(const Ctx& p, const GD& g, f32x16 (&acc)[2][2], const int tid);

__device__ __forceinline__ void gemm_tile_mix(const Ctx& p, char* smem, const GD& g, const int tid) {
  u16* As = (u16*)smem;
  u16* Bs = As + 2 * 256 * 72;
  const int lane = tid & 63, w = tid >> 6, wm = w >> 1, wn = w & 1;
  const int lr = tid >> 3, lc = (tid & 7) * 8;
  f32x16 acc[2][2];
#pragma unroll
  for (int i = 0; i < 2; ++i)
#pragma unroll
    for (int j = 0; j < 2; ++j)
#pragma unroll
      for (int r = 0; r < 16; ++r) acc[i][j][r] = 0.f;
  Stg R0, R1;
  LdSt L; ld_setup(L, g, lr, lc);
  const int nk = L.nk;
  const int t0 = g.m0 + lr;
  const int sto = lr * 72 + lc;
  {
    float4 mu0, mu1;
    int nbm = 0;
    const uint4 z4 = make_uint4(0, 0, 0, 0);
    int nq0[4], nq1[4], nq2[4], nq3[4];
#pragma unroll
    for (int q4 = 0; q4 < 4; ++q4) {
      nq0[q4] = mix_nb(t0, q4 * 256); nq1[q4] = mix_nb(t0 + 64, q4 * 256); nq2[q4] = mix_nb(t0 + 128, q4 * 256); nq3[q4] = mix_nb(t0 + 192, q4 * 256);
    }
    for (int kt = -1; kt < nk; ++kt) {
      const int cur = kt & 1;
      if (kt + 1 < nk) {
        const int k0 = (kt + 1) * 64;
        const int k = k0 + lc;
        GEMM_LOADX(R0, L, kt + 1)
        const __amdgpu_buffer_rsrc_t rsA = make_rsrc(L.baseA);
        mu0 = *(const float4*)(g.mu + k); mu1 = *(const float4*)(g.mu + k + 4);
        const int soa = __builtin_amdgcn_readfirstlane(k0 * 2);
        const int qq = __builtin_amdgcn_readfirstlane(k0 >> 8);
        const int nb0 = (qq == 0) ? nq0[0] : (qq == 1) ? nq0[1] : (qq == 2) ? nq0[2] : nq0[3];
        const int nb1 = (qq == 0) ? nq1[0] : (qq == 1) ? nq1[1] : (qq == 2) ? nq1[2] : nq1[3];
        const int nb2 = (qq == 0) ? nq2[0] : (qq == 1) ? nq2[1] : (qq == 2) ? nq2[2] : nq2[3];
        const int nb3 = (qq == 0) ? nq3[0] : (qq == 1) ? nq3[1] : (qq == 2) ? nq3[2] : nq3[3];
        nbm = (nb0 >= 0 ? 1 : 0) | (nb1 >= 0 ? 2 : 0) | (nb2 >= 0 ? 4 : 0) | (nb3 >= 0 ? 8 : 0);
        R1.a0 = bufld(rsA, nb0 >= 0 ? ((unsigned)nb0 * 1024u + (unsigned)lc) * 2u : 0x80000000u, soa);
        R1.a1 = bufld(rsA, nb1 >= 0 ? ((unsigned)nb1 * 1024u + (unsigned)lc) * 2u : 0x80000000u, soa);
        R1.a2 = bufld(rsA, nb2 >= 0 ? ((unsigned)nb2 * 1024u + (unsigned)lc) * 2u : 0x80000000u, soa);
        R1.a3 = bufld(rsA, nb3 >= 0 ? ((unsigned)nb3 * 1024u + (unsigned)lc) * 2u : 0x80000000u, soa);
      }
      if (kt >= 0) GEMM_COMPUTE(cur)
      if (kt + 1 < nk) {
        R0.a0 = mix4(R0.a0, R1.a0, mu0, mu1); R0.a1 = mix4(R0.a1, R1.a1, mu0, mu1);
        R0.a2 = mix4(R0.a2, R1.a2, mu0, mu1); R0.a3 = mix4(R0.a3, R1.a3, mu0, mu1);
        GEMM_STORE(R0, cur ^ 1)
      }
      __syncthreads();
    }
  }
  gemm_epilogue(p, g, acc, tid);
}

__device__ __forceinline__ void gemm_epilogue(const Ctx& p, const GD& g, f32x16 (&acc)[2][2], const int tid) {
  int te = tid;
  asm volatile("" : "+v"(te));
  const int le = te & 63, we = te >> 6;
  const int lrow0 = 64 * (we >> 1) + 4 * (le >> 5), lcol0 = 64 * (we & 1) + (le & 31);
  const int ldo = (int)g.ldo;
  switch (g.ep) {
    case 0: { u16* ob = g.out + (size_t)(g.m0 + lrow0) * g.ldo + g.n0 + lcol0; EPI_LOOP(ldo, { ob[off] = f2bf(v); }) } break;
    case 1: { u16* ob = g.out + (size_t)(g.m0 + lrow0) * g.ldo + g.n0 + lcol0; EPI_LOOP(ldo, { ob[off] = f2bf(tanhf(v)); }) } break;
    case 2: { u16* ob = g.out + (size_t)(g.m0 + lrow0) * g.ldo + g.n0 + lcol0; EPI_LOOP(ldo, { ob[off] = f2bf(sigmoidf_(v)); }) } break;
    case 3: { u16* ob = g.out + (size_t)(g.m0 + lrow0) * g.ldo + g.n0 + lcol0; EPI_LOOP(ldo, { float rr = fmaxf(v, 0.f); ob[off] = f2bf(rr * rr); }) } break;
    case 4: { u16* ob = g.out + (size_t)(g.m0 + lrow0) * 64 + g.n0 + lcol0; if (g.n0 + lcol0 < 32) { EPI_LOOP(64, { ob[off] = f2bf(v); }) } } break;
    case 5: {
      const int jb = (g.m0 < TL) ? (g.m0 >> 12) : 8;
      const float* gp = g.e0 + jb * 6144 + g.n0 + lcol0;
      const float g0 = gp[0], g1 = gp[32];
      u16* ob = g.out + (size_t)(g.m0 + lrow0) * 1024 + g.n0 + lcol0;
      EPI_LOOP(1024, { ob[off] = f2bf((j ? g1 : g0) * v); })
    } break;
    case 6: { u16* ob = g.out + (size_t)(g.m0 + lrow0) * g.ldo + g.n0 + lcol0; const float* bp = g.e0 + g.n0 + lcol0; const float c0 = bp[0], c1 = bp[32];
      EPI_LOOP(ldo, { ob[off] = f2bf(sigmoidf_((j ? c1 : c0) + v)); }) } break;
    case 7: {
      u16* ob = g.out + (size_t)(g.m0 + lrow0) * 1024 + g.n0 + lcol0; const u16* gs = g.gsrc + (size_t)(g.m0 + lrow0) * 1024 + g.n0 + lcol0;
      EPI_LOOP(1024, { float vf = bf2f(ob[off]); float gt = bf2f(gs[off]); ob[off] = f2bf(v + (vf - v) * gt); })
    } break;
    case 8: {
      u16* ob; int ld;
      if (g.n0 < TL) { ld = TL; ob = g.out + (size_t)(g.m0 + lrow0) * TL + g.n0 + lcol0; } else { ld = TC; ob = g.out2 + (size_t)(g.m0 + lrow0) * TC + (g.n0 - TL) + lcol0; }
      EPI_LOOP(ld, { ob[off] = f2bf(v); })
    } break;
    case 9: {
      const int gq = g.m0 >> 17, rloc = g.m0 & 131071;
      const int mmq = rloc >> 9, b = ((rloc & 511) >> 6) + (we >> 1);
      const int k1 = 32 * (we & 1) + (le & 31);
      const float2* tw = (const float2*)g.e0 + k1 * 64;
      u16* zb = g.out + ((size_t)(((gq * 256 + mmq) * 8 + b) * 64 + k1) * 2) * 64;
#pragma unroll
      for (int i = 0; i < 2; ++i) {
#pragma unroll
        for (int rq = 0; rq < 4; ++rq) {
          const int l20 = 32 * i + 8 * rq + 4 * (le >> 5);
          float zr[4], zi[4];
#pragma unroll
          for (int e = 0; e < 4; ++e) {
            const float2 t = tw[l20 + e];
            const float re = acc[i][0][rq * 4 + e], im = acc[i][1][rq * 4 + e];
            zr[e] = re * t.x + im * t.y; zi[e] = im * t.x - re * t.y;
          }
          *(uint2*)(zb + l20) = make_uint2(pack2(zr[0], zr[1]), pack2(zr[2], zr[3]));
          *(uint2*)(zb + 64 + l20) = make_uint2(pack2(zi[0], zi[1]), pack2(zi[2], zi[3]));
        }
        asm volatile("" ::: "memory");
      }
    } break;
    case 10: {
      if ((we >> 1) == 0) {
        const int b = g.n0 >> 16, k1 = (g.n0 >> 10) & 63, gm0 = (g.n0 & 1023) + lcol0;
        u16* ob = g.out + ((size_t)(b * 4096 + k1 + 64 * (4 * (le >> 5)))) * 1024 + gm0;
        EPI_LOOP(65536, { ob[off] = f2bf(v); })
      }
    } break;
    default: break;
  }
}

enum { G_RB = 0, G_RC, G_RC2, G_WO_R, G_FB, G_F1, G_F2, G_WO_F, G_MLP1, G_MLP2 };

__device__ __forceinline__ int gemm_total(int kind, int layer) {
  const int idx = layer >> 1;
  const bool ctx_in = layer <= 2, ctx_out = layer < 2;
  const int mt_out = (ctx_out ? T : TL) >> 8;
  switch (kind) {
    case G_RB: return 136 * ((idx == 0) ? 27 : 20);
    case G_RC: return 136 * ((idx == 0) ? 8 : 16);
    case G_RC2: return 136 * 8;
    case G_WO_R: return mt_out * 8;
    case G_FB: return 8 * (ctx_in ? 272 : 256);
    case G_F1: return 2048;
    case G_F2: return 4096 + (ctx_in ? 64 : 0);
    case G_WO_F: return mt_out * 8;
    case G_MLP1: return mt_out * 32;
    default: return mt_out * 8;
  }
}

__device__ __forceinline__ void make_gd(const Ctx& p, int kind, int layer, int tile, GD& g) {
  const int idx = layer >> 1;
  const u16* H = (const u16*)p.ws;
  const u16* wm = (const u16*)(p.ws + OFF_WMIX);
  const float* mu = p.in[10] + (size_t)idx * 6 * 1024;
  const float* mod = (const float*)(p.ws + OFF_MOD) + (size_t)layer * 9 * 6144;
  g.out = nullptr; g.out2 = nullptr; g.e0 = nullptr; g.gsrc = nullptr; g.ldo = 1024; g.ep = 0; g.K = 1024;
  switch (kind) {
    case G_RB: {
      const int CT = (idx == 0) ? 27 : 20;
      int tm = tile / CT, ct = tile % CT;
      g.m0 = tm * 256;
      int nv = (idx == 0) ? 8 : 0;
      if (ct < 8) { gd_mixA(g, H, mu + 0 * 1024); gd_plainB(g, wm + 0 * M1, 1024); g.n0 = ct * 128; g.out = (u16*)(p.ws + 1 * SLOT); }
      else if (ct < 16) { gd_mixA(g, H, mu + 2 * 1024); gd_plainB(g, wm + 1 * M1, 1024); g.n0 = (ct - 8) * 128; g.out = (u16*)(p.ws + 2 * SLOT); }
      else if (ct < 16 + nv) { gd_mixA(g, H, mu + 3 * 1024); gd_plainB(g, wm + 2 * M1, 1024); g.n0 = (ct - 16) * 128; g.out = (u16*)(p.ws + 5 * SLOT); }
      else {
        int q = ct - 16 - nv; g.n0 = 0;
        if (q == 0) { gd_mixA(g, H, mu + 1 * 1024); gd_plainB(g, wm + 4 * M1, 1024); g.ep = 1; g.out = (u16*)(p.ws + OFF_HW); g.ldo = 128; }
        else if (q == 1) { gd_mixA(g, H, mu + 4 * 1024); gd_plainB(g, wm + 4 * M1 + 131072, 1024); g.ep = 0; g.out = (u16*)(p.ws + OFF_HA); g.ldo = 128; }
        else if (q == 2) { gd_mixA(g, H, mu + 5 * 1024); gd_plainB(g, wm + 4 * M1 + 2 * 131072, 1024); g.ep = 2; g.out = (u16*)(p.ws + OFF_HG); g.ldo = 128; }
        else { gd_mixA(g, H, mu + 3 * 1024); gd_plainB(g, wm + 4 * M1 + 3 * 131072, 1024); g.ep = 0; g.out = (u16*)(p.ws + OFF_HV); g.ldo = 128; }
      }
    } break;
    case G_RC: {
      const int CT = (idx == 0) ? 8 : 16;
      int tm = tile / CT, ct = tile % CT;
      g.m0 = tm * 256;
      if (ct < 8) { gd_plainA(g, (const u16*)(p.ws + OFF_HG), 128); gd_plainB(g, wm + 4 * M1 + 4 * 131072, 128); g.K = 128; g.n0 = ct * 128; g.out = (u16*)(p.ws + 4 * SLOT); }
      else { gd_plainA(g, (const u16*)(p.ws + OFF_HV), 128); gd_plainB(g, wm + 4 * M1 + 5 * 131072, 128); g.K = 128; g.n0 = (ct - 8) * 128; g.ep = 6; g.e0 = p.in[21]; g.out = (u16*)(p.ws + 3 * SLOT); }
    } break;
    case G_RC2: {
      int tm = tile >> 3, ct = tile & 7;
      g.m0 = tm * 256; g.n0 = ct * 128;
      gd_mixA(g, H, mu + 3 * 1024); gd_plainB(g, wm + 2 * M1, 1024);
      g.ep = 7; g.out = (u16*)(p.ws + 5 * SLOT); g.gsrc = (const u16*)(p.ws + 3 * SLOT);
    } break;
    case G_WO_R: {
      int tm = tile >> 3, ct = tile & 7;
      g.m0 = tm * 256; g.n0 = ct * 128;
      gd_plainA(g, H, 1024); gd_plainB(g, wm + 3 * M1, 1024);
      g.ep = 5; g.e0 = mod + 2048; g.out = (u16*)(p.ws + 1 * SLOT);
    } break;
    case G_FB: {
      int tn = tile >> 3, tm = tile & 7;
      g.K = 256; g.m0 = tm * 256; g.n0 = tn * 128;
      gd_plainA(g, wm + M1, 256); g.a_rowmask = 511;
      gd_plainB(g, H + 256 * (tm >> 1), 1024);
      if (g.n0 < TL) g.b_perm = 1;
      g.ep = 8; g.out = (u16*)(p.ws + 1 * SLOT); g.out2 = g.out + (size_t)2048 * TL;
    } break;
    case G_F1: {
      const u16* YT = (const u16*)(p.ws + 1 * SLOT);
      const int gq = tile >> 9;
      g.K = 128; g.m0 = tile * 256; g.n0 = 0;
      gd_plainA(g, YT + (size_t)gq * 512 * TL - (size_t)gq * 131072 * 64, 64);
      g.a_kshift = 6; g.a_kstride = (long)256 * TL;
      gd_plainB(g, wm + M1 + 131072, 128);
      g.ep = 9; g.out = (u16*)(p.ws + 3 * SLOT); g.e0 = (const float*)(wm + M1 + 131072 + 16384 + 8192 + 131072);
    } break;
    case G_F2: {
      u16* fo = (u16*)(p.ws + 1 * SLOT);
      if (tile < 4096) {
        g.K = 128; g.m0 = 0; g.n0 = tile * 128;
        gd_plainA(g, wm + M1 + 131072 + 16384, 128); g.a_rowmask = 63;
        gd_plainB(g, (const u16*)(p.ws + 3 * SLOT), 128); g.b_perm = 2;
        g.ep = 10; g.out = fo;
      } else {
        const u16* dftC = wm + M1 + 131072 + 16384 + 8192;
        const u16* YTc = (const u16*)(p.ws + 1 * SLOT) + (size_t)2048 * TL;
        int t2 = tile - 4096; int b = t2 >> 3, ct = t2 & 7;
        g.K = 512; g.m0 = 0; g.n0 = ct * 128;
        gd_plainA(g, dftC, 512);
        g.B = YTc + (size_t)b * 256; g.b_rs_hi = (long)512 * TC; g.b_rs_lo = TC; g.b_kshift = 8; g.b_kstride = (long)256 * TC; g.b_perm = 0;
        g.out = fo + (size_t)(TL + b * 256) * 1024;
      }
    } break;
    case G_WO_F: {
      int tm = tile >> 3, ct = tile & 7;
      g.m0 = tm * 256; g.n0 = ct * 128;
      gd_plainA(g, (const u16*)(p.ws + 1 * SLOT), 1024); gd_plainB(g, wm, 1024);
      g.ep = 5; g.e0 = mod + 2048; g.out = (u16*)(p.ws + 2 * SLOT);
    } break;
    case G_MLP1: {
      const int grp = tile >> 7, ii = tile & 127;
      int tm = grp * 4 + ((ii & 31) >> 3), ct = (ii >> 5) * 8 + (ii & 7);
      g.m0 = tm * 256; g.n0 = ct * 128;
      gd_plainA(g, H, 1024); gd_plainB(g, (const u16*)(p.ws + OFF_WMLP), 1024);
      g.ep = 3; g.out = (u16*)(p.ws + 1 * SLOT); g.ldo = 4096;
    } break;
    default: {
      int tm = tile >> 3, ct = tile & 7;
      g.K = 4096; g.m0 = tm * 256; g.n0 = ct * 128;
      gd_plainA(g, (const u16*)(p.ws + 1 * SLOT), 4096); gd_plainB(g, (const u16*)(p.ws + OFF_WMLP) + 4 * M1, 4096);
      g.ep = 5; g.e0 = mod + 5 * 1024; g.out = (u16*)(p.ws);
    } break;
  }
}

#define SCAN_SA_TEXT \
      "v_mul_f32_dpp %0, %2, %3 row_newbcast:0 row_mask:0xf bank_mask:0xf\n\t" \
      "v_mul_f32_dpp %1, %2, %4 row_newbcast:1 row_mask:0xf bank_mask:0xf\n\t" \
      "v_fmac_f32_dpp %0, %2, %5 row_newbcast:2 row_mask:0xf bank_mask:0xf\n\t" \
      "v_fmac_f32_dpp %1, %2, %6 row_newbcast:3 row_mask:0xf bank_mask:0xf\n\t" \
      "v_fmac_f32_dpp %0, %2, %7 row_newbcast:4 row_mask:0xf bank_mask:0xf\n\t" \
      "v_fmac_f32_dpp %1, %2, %8 row_newbcast:5 row_mask:0xf bank_mask:0xf\n\t" \
      "v_fmac_f32_dpp %0, %2, %9 row_newbcast:6 row_mask:0xf bank_mask:0xf\n\t" \
      "v_fmac_f32_dpp %1, %2, %10 row_newbcast:7 row_mask:0xf bank_mask:0xf\n\t" \
      "v_fmac_f32_dpp %0, %2, %11 row_newbcast:8 row_mask:0xf bank_mask:0xf\n\t" \
      "v_fmac_f32_dpp %1, %2, %12 row_newbcast:9 row_mask:0xf bank_mask:0xf\n\t" \
      "v_fmac_f32_dpp %0, %2, %13 row_newbcast:10 row_mask:0xf bank_mask:0xf\n\t" \
      "v_fmac_f32_dpp %1, %2, %14 row_newbcast:11 row_mask:0xf bank_mask:0xf\n\t" \
      "v_fmac_f32_dpp %0, %2, %15 row_newbcast:12 row_mask:0xf bank_mask:0xf\n\t" \
      "v_fmac_f32_dpp %1, %2, %16 row_newbcast:13 row_mask:0xf bank_mask:0xf\n\t" \
      "v_fmac_f32_dpp %0, %2, %17 row_newbcast:14 row_mask:0xf bank_mask:0xf\n\t" \
      "v_fmac_f32_dpp %1, %2, %18 row_newbcast:15 row_mask:0xf bank_mask:0xf\n\t"
#define SCAN_SA(sa0, sa1, A) asm( \
      SCAN_SA_TEXT \
      : "=&v"(sa0), "=&v"(sa1) : "v"(A), "v"(S[0]), "v"(S[1]), "v"(S[2]), "v"(S[3]), "v"(S[4]), "v"(S[5]), "v"(S[6]), "v"(S[7]), \
        "v"(S[8]), "v"(S[9]), "v"(S[10]), "v"(S[11]), "v"(S[12]), "v"(S[13]), "v"(S[14]), "v"(S[15]))
#define SCAN_UP(B0, W, Bv, KD, sa, VV) asm( \
      "v_mul_f32_dpp %0, %16, %8 row_newbcast:0 row_mask:0xf bank_mask:0xf\n\t" \
      "v_mul_f32_dpp %1, %16, %9 row_newbcast:1 row_mask:0xf bank_mask:0xf\n\t" \
      "v_mul_f32_dpp %2, %16, %10 row_newbcast:2 row_mask:0xf bank_mask:0xf\n\t" \
      "v_mul_f32_dpp %3, %16, %11 row_newbcast:3 row_mask:0xf bank_mask:0xf\n\t" \
      "v_mul_f32_dpp %4, %16, %12 row_newbcast:4 row_mask:0xf bank_mask:0xf\n\t" \
      "v_mul_f32_dpp %5, %16, %13 row_newbcast:5 row_mask:0xf bank_mask:0xf\n\t" \
      "v_mul_f32_dpp %6, %16, %14 row_newbcast:6 row_mask:0xf bank_mask:0xf\n\t" \
      "v_mul_f32_dpp %7, %16, %15 row_newbcast:7 row_mask:0xf bank_mask:0xf\n\t" \
      "v_fmac_f32_dpp %0, %17, %19 row_newbcast:0 row_mask:0xf bank_mask:0xf\n\t" \
      "v_fmac_f32_dpp %1, %17, %19 row_newbcast:1 row_mask:0xf bank_mask:0xf\n\t" \
      "v_fmac_f32_dpp %2, %17, %19 row_newbcast:2 row_mask:0xf bank_mask:0xf\n\t" \
      "v_fmac_f32_dpp %3, %17, %19 row_newbcast:3 row_mask:0xf bank_mask:0xf\n\t" \
      "v_fmac_f32_dpp %4, %17, %19 row_newbcast:4 row_mask:0xf bank_mask:0xf\n\t" \
      "v_fmac_f32_dpp %5, %17, %19 row_newbcast:5 row_mask:0xf bank_mask:0xf\n\t" \
      "v_fmac_f32_dpp %6, %17, %19 row_newbcast:6 row_mask:0xf bank_mask:0xf\n\t" \
      "v_fmac_f32_dpp %7, %17, %19 row_newbcast:7 row_mask:0xf bank_mask:0xf\n\t" \
      "v_fmac_f32_dpp %0, %18, %20 row_newbcast:0 row_mask:0xf bank_mask:0xf\n\t" \
      "v_fmac_f32_dpp %1, %18, %20 row_newbcast:1 row_mask:0xf bank_mask:0xf\n\t" \
      "v_fmac_f32_dpp %2, %18, %20 row_newbcast:2 row_mask:0xf bank_mask:0xf\n\t" \
      "v_fmac_f32_dpp %3, %18, %20 row_newbcast:3 row_mask:0xf bank_mask:0xf\n\t" \
      "v_fmac_f32_dpp %4, %18, %20 row_newbcast:4 row_mask:0xf bank_mask:0xf\n\t" \
      "v_fmac_f32_dpp %5, %18, %20 row_newbcast:5 row_mask:0xf bank_mask:0xf\n\t" \
      "v_fmac_f32_dpp %6, %18, %20 row_newbcast:6 row_mask:0xf bank_mask:0xf\n\t" \
      "v_fmac_f32_dpp %7, %18, %20 row_newbcast:7 row_mask:0xf bank_mask:0xf\n\t" \
      : "=&v"(N[B0 + 0]), "=&v"(N[B0 + 1]), "=&v"(N[B0 + 2]), "=&v"(N[B0 + 3]), "=&v"(N[B0 + 4]), "=&v"(N[B0 + 5]), "=&v"(N[B0 + 6]), "=&v"(N[B0 + 7]) \
      : "v"(S[B0 + 0]), "v"(S[B0 + 1]), "v"(S[B0 + 2]), "v"(S[B0 + 3]), "v"(S[B0 + 4]), "v"(S[B0 + 5]), "v"(S[B0 + 6]), "v"(S[B0 + 7]), \
        "v"(W), "v"(Bv), "v"(KD), "v"(sa), "v"(VV))
#define SCAN_UP8(B0, W, Bv, KD, sa, VV) asm( \
      "v_mul_f32_dpp %0, %16, %8 row_newbcast:8 row_mask:0xf bank_mask:0xf\n\t" \
      "v_mul_f32_dpp %1, %16, %9 row_newbcast:9 row_mask:0xf bank_mask:0xf\n\t" \
      "v_mul_f32_dpp %2, %16, %10 row_newbcast:10 row_mask:0xf bank_mask:0xf\n\t" \
      "v_mul_f32_dpp %3, %16, %11 row_newbcast:11 row_mask:0xf bank_mask:0xf\n\t" \
      "v_mul_f32_dpp %4, %16, %12 row_newbcast:12 row_mask:0xf bank_mask:0xf\n\t" \
      "v_mul_f32_dpp %5, %16, %13 row_newbcast:13 row_mask:0xf bank_mask:0xf\n\t" \
      "v_mul_f32_dpp %6, %16, %14 row_newbcast:14 row_mask:0xf bank_mask:0xf\n\t" \
      "v_mul_f32_dpp %7, %16, %15 row_newbcast:15 row_mask:0xf bank_mask:0xf\n\t" \
      "v_fmac_f32_dpp %0, %17, %19 row_newbcast:8 row_mask:0xf bank_mask:0xf\n\t" \
      "v_fmac_f32_dpp %1, %17, %19 row_newbcast:9 row_mask:0xf bank_mask:0xf\n\t" \
      "v_fmac_f32_dpp %2, %17, %19 row_newbcast:10 row_mask:0xf bank_mask:0xf\n\t" \
      "v_fmac_f32_dpp %3, %17, %19 row_newbcast:11 row_mask:0xf bank_mask:0xf\n\t" \
      "v_fmac_f32_dpp %4, %17, %19 row_newbcast:12 row_mask:0xf bank_mask:0xf\n\t" \
      "v_fmac_f32_dpp %5, %17, %19 row_newbcast:13 row_mask:0xf bank_mask:0xf\n\t" \
      "v_fmac_f32_dpp %6, %17, %19 row_newbcast:14 row_mask:0xf bank_mask:0xf\n\t" \
      "v_fmac_f32_dpp %7, %17, %19 row_newbcast:15 row_mask:0xf bank_mask:0xf\n\t" \
      "v_fmac_f32_dpp %0, %18, %20 row_newbcast:8 row_mask:0xf bank_mask:0xf\n\t" \
      "v_fmac_f32_dpp %1, %18, %20 row_newbcast:9 row_mask:0xf bank_mask:0xf\n\t" \
      "v_fmac_f32_dpp %2, %18, %20 row_newbcast:10 row_mask:0xf bank_mask:0xf\n\t" \
      "v_fmac_f32_dpp %3, %18, %20 row_newbcast:11 row_mask:0xf bank_mask:0xf\n\t" \
      "v_fmac_f32_dpp %4, %18, %20 row_newbcast:12 row_mask:0xf bank_mask:0xf\n\t" \
      "v_fmac_f32_dpp %5, %18, %20 row_newbcast:13 row_mask:0xf bank_mask:0xf\n\t" \
      "v_fmac_f32_dpp %6, %18, %20 row_newbcast:14 row_mask:0xf bank_mask:0xf\n\t" \
      "v_fmac_f32_dpp %7, %18, %20 row_newbcast:15 row_mask:0xf bank_mask:0xf\n\t" \
      : "=&v"(N[B0 + 0]), "=&v"(N[B0 + 1]), "=&v"(N[B0 + 2]), "=&v"(N[B0 + 3]), "=&v"(N[B0 + 4]), "=&v"(N[B0 + 5]), "=&v"(N[B0 + 6]), "=&v"(N[B0 + 7]) \
      : "v"(S[B0 + 0]), "v"(S[B0 + 1]), "v"(S[B0 + 2]), "v"(S[B0 + 3]), "v"(S[B0 + 4]), "v"(S[B0 + 5]), "v"(S[B0 + 6]), "v"(S[B0 + 7]), \
        "v"(W), "v"(Bv), "v"(KD), "v"(sa), "v"(VV))
#define SCAN_Y(sa0, sa1, A) asm( \
      SCAN_SA_TEXT \
      : "=&v"(sa0), "=&v"(sa1) : "v"(A), "v"(N[0]), "v"(N[1]), "v"(N[2]), "v"(N[3]), "v"(N[4]), "v"(N[5]), "v"(N[6]), "v"(N[7]), \
        "v"(N[8]), "v"(N[9]), "v"(N[10]), "v"(N[11]), "v"(N[12]), "v"(N[13]), "v"(N[14]), "v"(N[15]))
#define SCAN_STEP(W, A, Bv, KD, R, VV, YP, PREFETCH) { \
      float sa0, sa1, y0, y1; float N[16]; \
      asm volatile("s_nop 1" : "+v"(A), "+v"(W), "+v"(Bv), "+v"(KD), "+v"(R)); \
      SCAN_SA(sa0, sa1, A); \
      PREFETCH \
      const float sa = xrow_sum(sa0 + sa1); \
      SCAN_UP(0, W, Bv, KD, sa, VV); \
      SCAN_UP8(8, W, Bv, KD, sa, VV); \
      SCAN_Y(y0, y1, R); \
      YP = y0 + y1; \
      _Pragma("unroll") for (int j_ = 0; j_ < 16; ++j_) S[j_] = N[j_]; }
#define SCAN_LOAD(W, A, Bv, KD, R, VV, SIDX) { const float* np_ = bp + (SIDX) * 384; \
      W = np_[lane]; A = np_[64 + lane]; Bv = np_[128 + lane]; KD = np_[192 + lane]; R = np_[256 + lane]; VV = np_[vo]; }

__device__ __forceinline__ int scan_row(int gstep, int b, int d) {
  if (gstep < 256) { int pp = d ? 255 - gstep : gstep; return TL + b * 256 + pp; }
  int l = gstep - 256; if (d) l = 4095 - l;
  return b * 4096 + l;
}

__device__ __forceinline__ void phase_scan(const Ctx& p, char* smem, int idx, bool ctx_y, const int tid) {
  if (blockIdx.x >= 256) return;
  const int item = blockIdx.x;
  const int d = item & 1, h = (item >> 1) & 15, b = item >> 5;
  float* buf = (float*)smem;
  float* ybuf = buf + 2 * 32 * 384;
  const int lane = tid & 63, w = tid >> 6;
  const u16* rbuf = (const u16*)(p.ws + 1 * SLOT);
  const u16* kbuf = (const u16*)(p.ws + 2 * SLOT);
  const u16* vbuf = (const u16*)(p.ws + 5 * SLOT);
  u16* ybase = (u16*)(p.ws + (d == 0 ? 0 : 3 * SLOT));
  const u16* hw = (const u16*)(p.ws + OFF_HW);
  const u16* ha = (const u16*)(p.ws + OFF_HA);
  float* bsum = (float*)(p.ws + OFF_BSUM);
  const int ch = h * 64;

  uint4* Bl = (uint4*)(ybuf + 2 * 2048);
  float w0v[4], a0v[4];
  float kkw = 0.f, kaw = 0.f, rkw = 0.f;
#pragma unroll
  for (int cb = 0; cb < 4; ++cb) { w0v[cb] = 0.f; a0v[cb] = 0.f; }
  if (w >= 4) {
    const float* w2 = p.in[17] + (size_t)(idx * 2 + d) * 64 * 1024;
    const float* a2 = p.in[20] + (size_t)(idx * 2 + d) * 64 * 1024;
#pragma unroll
    for (int cb = 0; cb < 4; ++cb) {
      int col = ch + 16 * cb + (lane & 15);
      w0v[cb] = p.in[15][(idx * 2 + d) * 1024 + col];
      a0v[cb] = p.in[18][(idx * 2 + d) * 1024 + col];
    }
    {
      const int cb = w - 4;
      const int col = ch + 16 * cb + (lane & 15);
#pragma unroll
      for (int i = 0; i < 2; ++i) {
        const int k0 = 32 * i + 8 * (lane >> 4);
        float fw[8], fa[8];
#pragma unroll
        for (int q = 0; q < 8; ++q) { fw[q] = w2[(size_t)(k0 + q) * 1024 + col]; fa[q] = a2[(size_t)(k0 + q) * 1024 + col]; }
        Bl[((0 * 4 + cb) * 2 + i) * 64 + lane] = make_uint4(pack2(fw[0], fw[1]), pack2(fw[2], fw[3]), pack2(fw[4], fw[5]), pack2(fw[6], fw[7]));
        Bl[((1 * 4 + cb) * 2 + i) * 64 + lane] = make_uint4(pack2(fa[0], fa[1]), pack2(fa[2], fa[3]), pack2(fa[4], fa[5]), pack2(fa[6], fa[7]));
      }
    }
    kkw = p.in[26][idx * 1024 + ch + lane];
    kaw = p.in[27][idx * 1024 + ch + lane];
    rkw = p.in[28][idx * 1024 + ch + lane];
  }
  __syncthreads();
  float S[16];
#pragma unroll
  for (int j = 0; j < 16; ++j) S[j] = 0.f;

  for (int it = 0; it <= 137; ++it) {
    if (w >= 4) {
      const int jw = w - 4;
      if (it >= 2) {
        int cy = it - 2;
        const float* yb = ybuf + (cy & 1) * 2048;
        if (cy >= 8 || ctx_y) {
          const int yrow0 = scan_row(cy * 32 + jw * 8, b, d);
#pragma unroll
          for (int s8 = 0; s8 < 8; ++s8) {
            int s = jw * 8 + s8;
            int row = yrow0 + (d ? -s8 : s8);
            ybase[(unsigned)row * 1024u + (unsigned)(ch + lane)] = f2bf(yb[s * 64 + lane]);
          }
        }
      }
      if (it < 136) {
        float* bp = buf + (it & 1) * 12288;
        const int s0 = jw * 8;
        const int prow0 = scan_row(it * 32 + s0, b, d);
        int rowm = prow0 + (d ? -(lane & 7) : (lane & 7));
        bf16x8 Aw0 = *(const bf16x8*)(hw + ((unsigned)rowm * 128u + (unsigned)(d * 64 + 8 * (lane >> 4))));
        bf16x8 Aw1 = *(const bf16x8*)(hw + ((unsigned)rowm * 128u + (unsigned)(d * 64 + 32 + 8 * (lane >> 4))));
        bf16x8 Aa0 = *(const bf16x8*)(ha + ((unsigned)rowm * 128u + (unsigned)(d * 64 + 8 * (lane >> 4))));
        bf16x8 Aa1 = *(const bf16x8*)(ha + ((unsigned)rowm * 128u + (unsigned)(d * 64 + 32 + 8 * (lane >> 4))));
        float kx[8], rx[8], vx[8];
#pragma unroll
        for (int s8 = 0; s8 < 8; ++s8) {
          int row = prow0 + (d ? -s8 : s8);
          const unsigned o = (unsigned)row * 1024u + (unsigned)(ch + lane);
          kx[s8] = bf2f(kbuf[o]); rx[s8] = bf2f(rbuf[o]); vx[s8] = bf2f(vbuf[o]);
        }
        const bool hiL = lane >= 32;
#pragma unroll
        for (int cbp = 0; cbp < 2; ++cbp) {
          f32x4 cwl = {0.f, 0.f, 0.f, 0.f}, cal = {0.f, 0.f, 0.f, 0.f}, cwh = {0.f, 0.f, 0.f, 0.f}, cah = {0.f, 0.f, 0.f, 0.f};
          {
            const int cb = cbp;
            const bf16x8 bw0 = __builtin_bit_cast(bf16x8, Bl[((0 * 4 + cb) * 2 + 0) * 64 + lane]);
            const bf16x8 bw1 = __builtin_bit_cast(bf16x8, Bl[((0 * 4 + cb) * 2 + 1) * 64 + lane]);
            const bf16x8 ba0 = __builtin_bit_cast(bf16x8, Bl[((1 * 4 + cb) * 2 + 0) * 64 + lane]);
            const bf16x8 ba1 = __builtin_bit_cast(bf16x8, Bl[((1 * 4 + cb) * 2 + 1) * 64 + lane]);
            cwl = __builtin_amdgcn_mfma_f32_16x16x32_bf16(Aw0, bw0, cwl, 0, 0, 0);
            cwl = __builtin_amdgcn_mfma_f32_16x16x32_bf16(Aw1, bw1, cwl, 0, 0, 0);
            cal = __builtin_amdgcn_mfma_f32_16x16x32_bf16(Aa0, ba0, cal, 0, 0, 0);
            cal = __builtin_amdgcn_mfma_f32_16x16x32_bf16(Aa1, ba1, cal, 0, 0, 0);
          }
          {
            const int cb = cbp + 2;
            const bf16x8 bw0 = __builtin_bit_cast(bf16x8, Bl[((0 * 4 + cb) * 2 + 0) * 64 + lane]);
            const bf16x8 bw1 = __builtin_bit_cast(bf16x8, Bl[((0 * 4 + cb) * 2 + 1) * 64 + lane]);
            const bf16x8 ba0 = __builtin_bit_cast(bf16x8, Bl[((1 * 4 + cb) * 2 + 0) * 64 + lane]);
            const bf16x8 ba1 = __builtin_bit_cast(bf16x8, Bl[((1 * 4 + cb) * 2 + 1) * 64 + lane]);
            cwh = __builtin_amdgcn_mfma_f32_16x16x32_bf16(Aw0, bw0, cwh, 0, 0, 0);
            cwh = __builtin_amdgcn_mfma_f32_16x16x32_bf16(Aw1, bw1, cwh, 0, 0, 0);
            cah = __builtin_amdgcn_mfma_f32_16x16x32_bf16(Aa0, ba0, cah, 0, 0, 0);
            cah = __builtin_amdgcn_mfma_f32_16x16x32_bf16(Aa1, ba1, cah, 0, 0, 0);
          }
          const float w0s = hiL ? w0v[cbp + 2] : w0v[cbp];
          const float a0s = hiL ? a0v[cbp + 2] : a0v[cbp];
          const int colb = 16 * (cbp + (hiL ? 2 : 0)) + (lane & 15);
#pragma unroll
          for (int r = 0; r < 4; ++r) {
            const int m = 4 * ((lane >> 4) & 1) + r;
            const float xw = (hiL ? cwh[r] : cwl[r]) + w0s;
            const float xa = (hiL ? cah[r] : cal[r]) + a0s;
            const float dec = __expf(-0.60653066f * sigmoidf_(xw));
            const float ic = sigmoidf_(xa);
            bp[(s0 + m) * 384 + 0 * 64 + colb] = dec;
            bp[(s0 + m) * 384 + 1 * 64 + colb] = ic;
          }
        }
        float icv[8], kkr[8], kdv[8], X[16];
#pragma unroll
        for (int s8 = 0; s8 < 8; ++s8) {
          icv[s8] = bp[(s0 + s8) * 384 + 64 + lane];
          kkr[s8] = kx[s8] * kkw;
          kdv[s8] = kx[s8] * (1.f + (icv[s8] - 1.f) * kaw);
          X[2 * s8] = kkr[s8] * kkr[s8];
          X[2 * s8 + 1] = rx[s8] * kdv[s8] * rkw;
        }
        float Yv[8], Zv[4];
#pragma unroll
        for (int m = 0; m < 8; ++m) {
          auto pp = __builtin_amdgcn_permlane32_swap(__float_as_uint(X[2 * m]), __float_as_uint(X[2 * m + 1]), false, false);
          Yv[m] = __uint_as_float(pp[0]) + __uint_as_float(pp[1]);
        }
#pragma unroll
        for (int n = 0; n < 4; ++n) {
          auto pq = __builtin_amdgcn_permlane16_swap(__float_as_uint(Yv[2 * n]), __float_as_uint(Yv[2 * n + 1]), false, false);
          float z = __uint_as_float(pq[0]) + __uint_as_float(pq[1]);
          DPP_ROR_ADD(z, 8); DPP_ROR_ADD(z, 4); DPP_ROR_ADD(z, 2); DPP_ROR_ADD(z, 1);
          Zv[n] = z;
        }
        float bsv = 0.f;
#pragma unroll
        for (int s8 = 0; s8 < 8; ++s8) {
          const int s = s0 + s8;
          const int zi = __float_as_int(Zv[s8 >> 1]);
          const float ss = __int_as_float(__builtin_amdgcn_readlane(zi, (s8 & 1) * 16));
          const float bs = __int_as_float(__builtin_amdgcn_readlane(zi, 32 + (s8 & 1) * 16));
          const float ic = icv[s8];
          const float kk = kkr[s8] * rsqrtf(fmaxf(ss, 1e-24f));
          bsv = (lane == s8) ? bs : bsv;
          bp[s * 384 + 64 + lane] = -kk;
          bp[s * 384 + 128 + lane] = kk * ic;
          bp[s * 384 + 192 + lane] = kdv[s8];
          bp[s * 384 + 256 + lane] = rx[s8];
          bp[s * 384 + 320 + lane] = vx[s8];
        }
        if (lane < 8) bsum[(unsigned)(prow0 + (d ? -lane : lane)) * 32u + (unsigned)(h * 2 + d)] = bsv;
      }
    } else {
      if (it >= 1 && it <= 136) {
        const float* bp = buf + ((it - 1) & 1) * 12288;
        float* yb = ybuf + ((it - 1) & 1) * 2048;
        const int vo = 320 + 16 * w + (lane & 15);
        float W0, A0, B0, K0, R0, V0, W1, A1, B1, K1, R1, V1;
        SCAN_LOAD(W0, A0, B0, K0, R0, V0, 0)
#pragma unroll 1
        for (int s = 0; s < 32; s += 4) {
          float yp0, yp1, yp2, yp3;
          SCAN_STEP(W0, A0, B0, K0, R0, V0, yp0, SCAN_LOAD(W1, A1, B1, K1, R1, V1, s + 1))
          SCAN_STEP(W1, A1, B1, K1, R1, V1, yp1, SCAN_LOAD(W0, A0, B0, K0, R0, V0, s + 2))
          SCAN_STEP(W0, A0, B0, K0, R0, V0, yp2, SCAN_LOAD(W1, A1, B1, K1, R1, V1, s + 3))
          const int s4 = (s + 4 < 32) ? s + 4 : 31;
          SCAN_STEP(W1, A1, B1, K1, R1, V1, yp3, SCAN_LOAD(W0, A0, B0, K0, R0, V0, s4))
          {
            auto p01 = __builtin_amdgcn_permlane32_swap(__float_as_uint(yp0), __float_as_uint(yp1), false, false);
            auto p23 = __builtin_amdgcn_permlane32_swap(__float_as_uint(yp2), __float_as_uint(yp3), false, false);
            const float u01 = __uint_as_float(p01[0]) + __uint_as_float(p01[1]);
            const float u23 = __uint_as_float(p23[0]) + __uint_as_float(p23[1]);
            auto pz = __builtin_amdgcn_permlane16_swap(__float_as_uint(u01), __float_as_uint(u23), false, false);
            const float z = __uint_as_float(pz[0]) + __uint_as_float(pz[1]);
            const int rho = lane >> 4;
            const int smap = ((rho & 1) << 1) | (rho >> 1);
            yb[(s + smap) * 64 + 16 * w + (lane & 15)] = z;
          }
        }
      }
    }
    __syncthreads();
  }
}

__device__ __forceinline__ void phase_readout(const Ctx& p, int idx, int nrows, const int tid) {
  u16* y0 = (u16*)(p.ws);
  const u16* y1 = (const u16*)(p.ws + 3 * SLOT);
  const u16* vb = (const u16*)(p.ws + 5 * SLOT);
  const u16* gb = (const u16*)(p.ws + 4 * SLOT);
  const float* bsum = (const float*)(p.ws + OFF_BSUM);
  const float* lw = p.in[29] + idx * 1024;
  const float* lb = p.in[30] + idx * 1024;
  int lane = tid & 63, wv = tid >> 6;
  const int stride = gridDim.x * 8;
  for (int row0 = blockIdx.x * 8 + wv; row0 < nrows; row0 += 2 * stride) {
    const bool v1 = (row0 + stride) < nrows;
    uint4 ld[2][8];
    float bs0[2], bs1[2];
#pragma unroll
    for (int u = 0; u < 2; ++u) {
      const int row = row0 + u * stride;
      if (u == 0 || v1) {
        const size_t o = (size_t)row * 1024 + lane * 16;
        ld[u][0] = *(const uint4*)(y0 + o); ld[u][1] = *(const uint4*)(y0 + o + 8);
        ld[u][2] = *(const uint4*)(y1 + o); ld[u][3] = *(const uint4*)(y1 + o + 8);
        ld[u][4] = *(const uint4*)(vb + o); ld[u][5] = *(const uint4*)(vb + o + 8);
        ld[u][6] = *(const uint4*)(gb + o); ld[u][7] = *(const uint4*)(gb + o + 8);
        const int hh = lane >> 2;
        bs0[u] = bsum[(size_t)row * 32 + hh * 2]; bs1[u] = bsum[(size_t)row * 32 + hh * 2 + 1];
      }
    }
#pragma unroll
    for (int u = 0; u < 2; ++u) {
      const int row = row0 + u * stride;
      if (u == 0 || v1) {
        const size_t o = (size_t)row * 1024 + lane * 16;
        const uint4 a0 = ld[u][0], a1 = ld[u][1], b0 = ld[u][2], b1 = ld[u][3], v0 = ld[u][4], v1q = ld[u][5], g0 = ld[u][6], g1 = ld[u][7];
        unsigned ya[8] = {a0.x, a0.y, a0.z, a0.w, a1.x, a1.y, a1.z, a1.w};
        unsigned yb[8] = {b0.x, b0.y, b0.z, b0.w, b1.x, b1.y, b1.z, b1.w};
        unsigned vv[8] = {v0.x, v0.y, v0.z, v0.w, v1q.x, v1q.y, v1q.z, v1q.w};
        unsigned gg[8] = {g0.x, g0.y, g0.z, g0.w, g1.x, g1.y, g1.z, g1.w};
        float y[16];
        float sum = 0.f;
#pragma unroll
        for (int q = 0; q < 8; ++q) {
          y[2 * q] = bflo(ya[q]) + bflo(yb[q]);
          y[2 * q + 1] = bfhi(ya[q]) + bfhi(yb[q]);
          sum += y[2 * q] + y[2 * q + 1];
        }
        sum += __shfl_xor(sum, 1); sum += __shfl_xor(sum, 2);
        float mean = sum * (1.f / 64.f);
        float var = 0.f;
#pragma unroll
        for (int q = 0; q < 16; ++q) { float dd = y[q] - mean; var += dd * dd; }
        var += __shfl_xor(var, 1); var += __shfl_xor(var, 2);
        float rstd = rsqrtf(var * (1.f / 64.f) + 64e-5f);
        float bon = bs0[u] + bs1[u];
        unsigned ov[8];
#pragma unroll
        for (int q = 0; q < 8; ++q) {
          int c = lane * 16 + 2 * q;
          float o0 = ((y[2 * q] - mean) * rstd * lw[c] + lb[c] + bon * bflo(vv[q])) * bflo(gg[q]);
          float o1 = ((y[2 * q + 1] - mean) * rstd * lw[c + 1] + lb[c + 1] + bon * bfhi(vv[q])) * bfhi(gg[q]);
          ov[q] = pack2(o0, o1);
        }
        *(uint4*)(y0 + o) = make_uint4(ov[0], ov[1], ov[2], ov[3]);
        *(uint4*)(y0 + o + 8) = make_uint4(ov[4], ov[5], ov[6], ov[7]);
      }
    }
  }
}

__device__ __forceinline__ void phase_final(const Ctx& p, const int tid) {
  const float* gam = p.in[32];
  int lane = tid & 63, wv = tid >> 6;
  for (int row = blockIdx.x * 8 + wv; row < TL; row += gridDim.x * 8) {
    float* src = p.out + (size_t)row * 1024;
    float4 x[4];
    float ss = 0.f;
#pragma unroll
    for (int q = 0; q < 4; ++q) {
      x[q] = *(const float4*)(src + q * 256 + lane * 4);
      {
        uint2 dv = *(const uint2*)((const u16*)p.ws + (size_t)row * 1024 + q * 256 + lane * 4);
        x[q].x += bflo(dv.x); x[q].y += bfhi(dv.x); x[q].z += bflo(dv.y); x[q].w += bfhi(dv.y);
      }
      ss += x[q].x * x[q].x + x[q].y * x[q].y + x[q].z * x[q].z + x[q].w * x[q].w;
    }
    ss = wave_sum(ss);
    float rstd = rsqrtf(ss * (1.f / 1024.f) + 1e-6f);
#pragma unroll
    for (int q = 0; q < 4; ++q) {
      int col = q * 256 + lane * 4;
      float4 g = *(const float4*)(gam + col);
      float4 o = make_float4(x[q].x * rstd * g.x, x[q].y * rstd * g.y, x[q].z * rstd * g.z, x[q].w * rstd * g.w);
#if PROBE_STEPS
      { long long tt = *(const long long*)(p.ws + OFF_PROBE); int n2 = (int)(tt / 100); if (n2 > 30000) n2 = 30000;
        if (q == 0 && lane == 0 && row < n2) o.x += 0.125f; }
#endif
      *(float4*)(src + col) = o;
    }
  }
}

__device__ __forceinline__ void gemm_run_plain(const Ctx& p, char* smem, const int kind, const int layer, const int total, const int vbid, int tid) {
  u16* As = (u16*)smem;
  u16* Bs = As + 2 * 256 * 72;
  int ntile = vbid;
  bool first = true;
  GD g; LdSt Lc;
  Stg R0, R1;
  Frg F0, F1;
  for (;;) {
    const bool has_next = ntile < total;
    asm volatile("" : "+v"(tid));
    const int lane = tid & 63, w = tid >> 6, wm = w >> 1, wn = w & 1;
    const int lr = tid >> 3, lc = (tid & 7) * 8;
    const int sto = lr * 72 + lc;
    GD gn; make_gd(p, kind, layer, has_next ? ntile : total - 1, gn);
    LdSt Ln; ld_setup(Ln, gn, lr, lc);
    __builtin_amdgcn_s_waitcnt(0xC07F);
    if (first) {
      if (!has_next) break;
      g = gn; Lc = Ln;
      GEMM_LOADX(R0, Lc, 0)
      GEMM_LOADX(R1, Lc, 1)
      GEMM_STORE(R0, 0)
      __syncthreads();
      GEMM_READF(F0, 0, 0)
      first = false; ntile += gridDim.x;
      continue;
    }
    f32x16 acc[2][2];
#pragma unroll
    for (int i = 0; i < 2; ++i)
#pragma unroll
      for (int j = 0; j < 2; ++j)
#pragma unroll
        for (int r = 0; r < 16; ++r) acc[i][j][r] = 0.f;
    const int nk = Lc.nk;
    if (nk > 2) {
      GEMM_KSTEP(0, R0, Lc, 2, R1)
      GEMM_KSTEP(1, R1, Lc, 3, R0)
    }
    __builtin_amdgcn_s_waitcnt(0x0070);
    for (int kt = 2; kt + 2 < nk; kt += 2) {
      GEMM_KSTEP(0, R0, Lc, kt + 2, R1)
      GEMM_KSTEP(1, R1, Lc, kt + 3, R0)
    }
    GEMM_KSTEP(0, R0, Ln, 0, R1)
    GEMM_KSTEP_LAST(1, R1, Ln, 1, R0)
    gemm_epilogue(p, g, acc, tid);
    if (!has_next) break;
    GEMM_READF(F0, 0, 0)
    g = gn; Lc = Ln; ntile += gridDim.x;
  }
  __syncthreads();
}

__global__ void __launch_bounds__(512) fwd_megakernel(Params p0) {
  Ctx p; p.in = p0.in; p.out = p0.out; p.ws = p0.ws;
  extern __shared__ __attribute__((aligned(16))) char smem[];
  cg::grid_group grid = cg::this_grid();

  int tid0 = threadIdx.x;
  asm volatile("" : "+v"(tid0));
  phase_mod(p, smem, tid0);
  grid.sync();
  for (int ph = 0; ph < 40; ++ph) {
    const int layer = ph / 10, step = ph % 10;
    const int idx = layer >> 1;
    const bool rw = (layer & 1) == 0;
    const bool ctx_in = layer <= 2, ctx_out = layer < 2;
    const int rows_in = ctx_in ? T : TL, rows_out = ctx_out ? T : TL;
    int gk = -1;
    int tid = threadIdx.x;
    Ctx q; q.in = p0.in;
    {
      unsigned long long w_ = (unsigned long long)p0.ws, o_ = (unsigned long long)p0.out;
      unsigned wl = __builtin_amdgcn_readfirstlane((unsigned)w_), wh = __builtin_amdgcn_readfirstlane((unsigned)(w_ >> 32));
      unsigned ol = __builtin_amdgcn_readfirstlane((unsigned)o_), oh = __builtin_amdgcn_readfirstlane((unsigned)(o_ >> 32));
      asm volatile("" : "+s"(wl), "+s"(wh), "+s"(ol), "+s"(oh));
      q.ws = (char*)(((unsigned long long)wh << 32) | wl);
      q.out = (float*)(((unsigned long long)oh << 32) | ol);
    }
#if PROBE_STEPS
    if (blockIdx.x == 0 && tid == 0) ((long long*)(q.ws + OFF_PROBE))[1] = wall_clock64();
#endif
#define OPAQUE_TID() asm volatile("" : "+v"(tid))
    if (step == 0 || step == 7) {
      OPAQUE_TID();
      {
        const u16* dl = (step == 7) ? (const u16*)(q.ws + (rw ? 1 : 2) * SLOT) : ((ph == 0) ? (const u16*)nullptr : (const u16*)q.ws);
        const int drows = (step == 7) ? rows_out : ((layer - 1) < 2 ? T : TL);
        prep_rows(q, layer, step == 0 ? 0 : 1, step == 0 ? rows_in : rows_out, ph == 0, dl, drows, tid);
      }
      if (step == 0) {
        OPAQUE_TID();
        convert_weights(q, smem, layer, tid);
        if (!rw) { OPAQUE_TID(); fourier_tables(q, ctx_in, tid); }
      }
    } else if (step == 1) gk = rw ? G_RB : G_FB;
    else if (step == 2) gk = rw ? G_RC : G_F1;
    else if (step == 3) { if (rw && idx != 1) continue; gk = rw ? G_RC2 : G_F2; }
    else if (step == 4) { if (!rw) continue; OPAQUE_TID(); phase_scan(q, smem, idx, ctx_out, tid); }
    else if (step == 5) { if (!rw) continue; OPAQUE_TID(); phase_readout(q, idx, rows_out, tid); }
    else if (step == 6) gk = rw ? G_WO_R : G_WO_F;
    else if (step == 8) gk = G_MLP1;
    else gk = G_MLP2;
    if (gk >= 0) {
      const int total = gemm_total(gk, layer);
      const int vbid = (int)(blockIdx.x & 7) * (int)(gridDim.x >> 3) + (int)(blockIdx.x >> 3);
      if (gk == G_RB || gk == G_RC2) {
        for (int tile = vbid; tile < total; tile += gridDim.x) {
          GD g;
          make_gd(q, gk, layer, tile, g);
          OPAQUE_TID();
          gemm_tile_mix(q, smem, g, tid);
        }
      } else {
        gemm_run_plain(q, smem, gk, layer, total, vbid, tid);
      }
    }
    grid.sync();
#if PROBE_STEPS
    if (blockIdx.x == 0 && threadIdx.x == 0) {
      long long* pr = (long long*)(p.ws + OFF_PROBE);
      if (ph == 0) pr[0] = 0;
      if (((PROBE_STEPS >> step) & 1) && ((PROBE_LAYERS >> layer) & 1)) pr[0] += wall_clock64() - pr[1];
    }
#endif
  }
#if PROBE_STEPS
  grid.sync();
#endif
  int tid1 = threadIdx.x;
  asm volatile("" : "+v"(tid1));
  phase_final(p, tid1);
}

extern "C" void kernel_launch(void* const* d_in, const int* in_sizes, int n_in,
                              void* d_out, int out_size, void* d_ws, size_t ws_size,
                              hipStream_t stream) {
  static int grid_blocks = 0;
  if (!grid_blocks) {
    int dev = 0, cus = 0, per_cu = 0;
    (void)hipGetDevice(&dev);
    (void)hipDeviceGetAttribute(&cus, hipDeviceAttributeMultiprocessorCount, dev);
    if (hipFuncSetAttribute((const void*)fwd_megakernel, hipFuncAttributeMaxDynamicSharedMemorySize, LDS_BYTES) != hipSuccess)
      fprintf(stderr, "hipFuncSetAttribute failed\n");
    (void)hipOccupancyMaxActiveBlocksPerMultiprocessor(&per_cu, (const void*)fwd_megakernel, 512, LDS_BYTES);
    if (per_cu < 1) { fprintf(stderr, "occupancy query returned %d\n", per_cu); per_cu = 1; }
    (void)hipGetLastError();
    grid_blocks = cus;
    if (ws_size < WS_END) fprintf(stderr, "workspace too small: %zu < %zu\n", ws_size, (size_t)WS_END);
  }
  Params p{};
  for (int i = 0; i < 33; ++i) p.in[i] = (const float*)d_in[i];
  p.out = (float*)d_out;
  p.ws = (char*)d_ws;
  void* args[] = {&p};
  hipError_t e = hipLaunchCooperativeKernel((const void*)fwd_megakernel, dim3(grid_blocks), dim3(512), args, LDS_BYTES, stream);
  if (e != hipSuccess) fprintf(stderr, "cooperative launch failed: %s (grid %d)\n", hipGetErrorString(e), grid_blocks);
}
```

```cpp
#include <hip/hip_runtime.h>
#include <hip/hip_cooperative_groups.h>
#include <cstdio>
namespace cg = cooperative_groups;

typedef unsigned short u16;
typedef __attribute__((ext_vector_type(8))) short bf16x8;
typedef __attribute__((ext_vector_type(16))) float f32x16;
typedef __attribute__((ext_vector_type(4))) float f32x4;
typedef __attribute__((ext_vector_type(2))) float f32x2;
typedef __attribute__((ext_vector_type(2))) __bf16 bf16x2v;

constexpr int TL = 8 * 4096, TC = 8 * 256, T = TL + TC;
constexpr size_t SLOT = (size_t)T * 1024 * 2;
constexpr size_t OFF_CTXRES = 6 * SLOT;
constexpr size_t OFF_MOD = OFF_CTXRES + (size_t)TC * 1024 * 4;
constexpr size_t OFF_HW = OFF_MOD + 4 * 9 * 6144 * 4;
constexpr size_t OFF_HA = OFF_HW + (size_t)T * 128 * 2;
constexpr size_t OFF_HG = OFF_HA + (size_t)T * 128 * 2;
constexpr size_t OFF_HV = OFF_HG + (size_t)T * 128 * 2;
constexpr size_t OFF_BSUM = OFF_HV + (size_t)T * 128 * 2;
constexpr size_t OFF_WMIX = OFF_BSUM + (size_t)T * 32 * 4;
constexpr size_t M1 = 1048576;
constexpr size_t WMIX_ELEMS = 4 * M1 + 6 * 131072;
constexpr size_t OFF_WMLP = OFF_WMIX + WMIX_ELEMS * 2;
constexpr size_t WS_END = OFF_WMLP + 2 * 4 * M1 * 2;
constexpr int LDS_BYTES = 131072;
#ifndef PROBE_STEPS
#define PROBE_STEPS 0
#endif
#ifndef PROBE_LAYERS
#define PROBE_LAYERS 15
#endif
constexpr size_t OFF_PROBE = WS_END;

struct Params {
  const float* in[33];
  float* out;
  char* ws;
};
struct Ctx { const float* const* in; float* out; char* ws; };

__device__ __forceinline__ unsigned pack2(float a, float b) {
  f32x2 v = {a, b};
  bf16x2v r = __builtin_convertvector(v, bf16x2v);
  return __builtin_bit_cast(unsigned, r);
}
__device__ __forceinline__ u16 f2bf(float a) { return (u16)(pack2(a, 0.f) & 0xffffu); }
__device__ __forceinline__ float bflo(unsigned u) { return __uint_as_float(u << 16); }
__device__ __forceinline__ float bfhi(unsigned u) { return __uint_as_float(u & 0xffff0000u); }
__device__ __forceinline__ float bf2f(u16 h) { return __uint_as_float(((unsigned)h) << 16); }
typedef __attribute__((ext_vector_type(4))) float nf4;
typedef __attribute__((ext_vector_type(2))) unsigned nu2;
__device__ __forceinline__ float4 ntload4(const float* ptr) { nf4 v = __builtin_nontemporal_load((const nf4*)ptr); return make_float4(v[0], v[1], v[2], v[3]); }
__device__ __forceinline__ uint2 ntload2(const u16* ptr) { nu2 v = __builtin_nontemporal_load((const nu2*)ptr); return make_uint2(v[0], v[1]); }
__device__ __forceinline__ void ntstore4(float* ptr, float4 x) { nf4 v = {x.x, x.y, x.z, x.w}; __builtin_nontemporal_store(v, (nf4*)ptr); }
__device__ __forceinline__ float wave_sum(float v) {
#pragma unroll
  for (int o = 32; o > 0; o >>= 1) v += __shfl_xor(v, o);
  return v;
}
#define DPP_ROR_ADD(x, n) x += __builtin_bit_cast(float, __builtin_amdgcn_update_dpp(0, __builtin_bit_cast(int, x), 0x120 + (n), 0xf, 0xf, true))
__device__ __forceinline__ float sigmoidf_(float x) { return __builtin_amdgcn_rcpf(1.f + __expf(-x)); }
__device__ __forceinline__ float xrow_sum(float x) {
  unsigned u = __float_as_uint(x);
  auto r = __builtin_amdgcn_permlane32_swap(u, u, false, false);
  float s = __uint_as_float(r[0]) + __uint_as_float(r[1]);
  u = __float_as_uint(s);
  auto r2 = __builtin_amdgcn_permlane16_swap(u, u, false, false);
  return __uint_as_float(r2[0]) + __uint_as_float(r2[1]);
}

__device__ __forceinline__ float wave_sum_fast(float x) {
  DPP_ROR_ADD(x, 8); DPP_ROR_ADD(x, 4); DPP_ROR_ADD(x, 2); DPP_ROR_ADD(x, 1);
  return xrow_sum(x);
}

__device__ __forceinline__ void phase_mod(const Ctx& p, char* smem, const int tid) {
  float* sv = (float*)smem;
  float* red = sv + 9 * 1024;
  const float* c = p.in[1];
  const float* cc = p.in[3];
  const float* mod_w = p.in[6];
  const float* mod_b = p.in[7];
  float* mod = (float*)(p.ws + OFF_MOD);
  for (int e = tid; e < 9 * 1024; e += 512) {
    int j = e >> 10, k = e & 1023;
    float v = (j < 8) ? c[j * 1024 + k] : cc[k];
    sv[e] = v / (1.f + expf(-v));
  }
  __syncthreads();
  for (int item = blockIdx.x; item < 384; item += gridDim.x) {
    int layer = item / 96, c0 = (item % 96) * 64;
    int kq = tid >> 6, col = tid & 63;
    const float* w = mod_w + (size_t)layer * 1024 * 6144 + c0 + col;
    float acc[9];
#pragma unroll
    for (int j = 0; j < 9; ++j) acc[j] = 0.f;
#pragma unroll 8
    for (int k = kq * 128; k < kq * 128 + 128; ++k) {
      float wv = w[(size_t)k * 6144];
#pragma unroll
      for (int j = 0; j < 9; ++j) acc[j] += sv[j * 1024 + k] * wv;
    }
#pragma unroll
    for (int j = 0; j < 9; ++j) red[(kq * 9 + j) * 64 + col] = acc[j];
    __syncthreads();
    for (int e = tid; e < 9 * 64; e += 512) {
      int j = e >> 6, cx = e & 63;
      float s = 0.f;
#pragma unroll
      for (int q = 0; q < 8; ++q) s += red[(q * 9 + j) * 64 + cx];
      s += mod_b[layer * 6144 + c0 + cx];
      mod[(layer * 9 + j) * 6144 + c0 + cx] = s;
    }
    __syncthreads();
  }
}

__device__ __forceinline__ void prep_rows(const Ctx& p, int layer, int which, int nrows, bool from_input, const u16* delta, int drows, const int tid) {
  const float* gam = (which == 0 ? p.in[4] : p.in[5]) + layer * 1024;
  const float* mod = (const float*)(p.ws + OFF_MOD);
  float* ctxres = (float*)(p.ws + OFF_CTXRES);
  u16* H = (u16*)(p.ws);
  int lane = tid & 63, wv = tid >> 6;
  const int stride = gridDim.x * 8;
  for (int row0 = blockIdx.x * 8 + wv; row0 < nrows; row0 += 2 * stride) {
    float4 x[2][4];
    uint2 dv[2][4];
    const bool v1 = (row0 + stride) < nrows;
#pragma unroll
    for (int u = 0; u < 2; ++u) {
      const int row = row0 + u * stride;
      if (u == 0 || v1) {
        const float* src = (row < TL) ? ((from_input ? p.in[0] : p.out) + (size_t)row * 1024) : ((from_input ? p.in[2] : ctxres) + (size_t)(row - TL) * 1024);
        const bool upd = (delta != nullptr) && (row < drows);
#pragma unroll
        for (int q = 0; q < 4; ++q) {
          x[u][q] = ntload4(src + q * 256 + lane * 4);
          dv[u][q] = make_uint2(0, 0);
          if (upd) dv[u][q] = ntload2(delta + (size_t)row * 1024 + q * 256 + lane * 4);
        }
      }
    }
#pragma unroll
    for (int u = 0; u < 2; ++u) {
      const int row = row0 + u * stride;
      if (u == 0 || v1) {
        float* dst = (row < TL) ? (p.out + (size_t)row * 1024) : (ctxres + (size_t)(row - TL) * 1024);
        const bool upd = (delta != nullptr) && (row < drows);
        float ss = 0.f;
#pragma unroll
        for (int q = 0; q < 4; ++q) {
          x[u][q].x += bflo(dv[u][q].x); x[u][q].y += bfhi(dv[u][q].x); x[u][q].z += bflo(dv[u][q].y); x[u][q].w += bfhi(dv[u][q].y);
          ss += x[u][q].x * x[u][q].x + x[u][q].y * x[u][q].y + x[u][q].z * x[u][q].z + x[u][q].w * x[u][q].w;
        }
        ss = wave_sum(ss);
        float rstd = rsqrtf(ss * (1.f / 1024.f) + 1e-6f);
        int j = (row < TL) ? (row >> 12) : 8;
        const float* mp = mod + (size_t)(layer * 9 + j) * 6144 + which * 3072;
#pragma unroll
        for (int q = 0; q < 4; ++q) {
          int col = q * 256 + lane * 4;
          if (from_input || upd) ntstore4(dst + col, x[u][q]);
          float4 g = *(const float4*)(gam + col);
          float4 sh = *(const float4*)(mp + col);
          float4 sc = *(const float4*)(mp + 1024 + col);
          float h0 = x[u][q].x * rstd * g.x * (1.f + sc.x) + sh.x;
          float h1 = x[u][q].y * rstd * g.y * (1.f + sc.y) + sh.y;
          float h2 = x[u][q].z * rstd * g.z * (1.f + sc.z) + sh.z;
          float h3 = x[u][q].w * rstd * g.w * (1.f + sc.w) + sh.w;
          uint2 o; o.x = pack2(h0, h1); o.y = pack2(h2, h3);
          *(uint2*)(H + (size_t)row * 1024 + col) = o;
        }
      }
    }
  }
}

struct CJ { const float* src; int K, N, ld; u16* dst; int ldd, Kp, Np; };
__device__ __forceinline__ void get_cj(const Ctx& p, int layer, int j, CJ& c) {
  const int idx = layer >> 1;
  u16* wm = (u16*)(p.ws + OFF_WMIX);
  u16* wl = (u16*)(p.ws + OFF_WMLP);
  c.K = 1024; c.N = 1024; c.ld = 1024; c.ldd = 1024; c.Kp = 1024; c.Np = 1024; c.src = nullptr; c.dst = nullptr;
  if (j == 0) { c.src = p.in[8] + (size_t)layer * 4 * M1; c.N = 4096; c.ld = 4096; c.dst = wl; c.Np = 4096; }
  else if (j == 1) { c.src = p.in[9] + (size_t)layer * 4 * M1; c.K = 4096; c.dst = wl + 4 * M1; c.ldd = 4096; c.Kp = 4096; }
  else if (layer & 1) { c.src = p.in[31] + (size_t)idx * M1; c.dst = wm; }
  else if (j < 6) { c.src = p.in[11 + (j - 2)] + (size_t)idx * M1; c.dst = wm + (size_t)(j - 2) * M1; }
  else if (j < 10) {
    int d = j & 1; bool isa = j >= 8;
    c.src = p.in[isa ? 19 : 16] + (size_t)(idx * 2 + d) * 65536; c.N = 64; c.ld = 64; c.Np = 64;
    c.dst = wm + 4 * M1 + (isa ? 131072 : 0) + d * 65536;
  }
  else if (j == 10) { c.src = p.in[24] + (size_t)idx * 131072; c.N = 128; c.ld = 128; c.Np = 128; c.dst = wm + 4 * M1 + 2 * 131072; }
  else if (j == 11) { c.src = p.in[25] + (size_t)idx * 131072; c.K = 128; c.Kp = 128; c.ldd = 128; c.dst = wm + 4 * M1 + 4 * 131072; }
  else if (j == 12) { c.src = p.in[22]; c.N = 32; c.ld = 32; c.Np = 128; c.dst = wm + 4 * M1 + 3 * 131072; }
  else { c.src = p.in[23]; c.K = 32; c.Kp = 128; c.ldd = 128; c.dst = wm + 4 * M1 + 5 * 131072; }
}

__device__ __forceinline__ void convert_weights(const Ctx& p, char* smem, int layer, const int tid) {
  float* tile = (float*)smem;
  const int nj = (layer & 1) ? 3 : ((layer >> 1) == 1 ? 14 : 12);
  int rot = 0;
  for (int j = 0; j < nj; ++j) {
    CJ c; get_cj(p, layer, j, c);
    const int nnt = c.Np >> 6, ntiles = (c.Kp >> 6) * nnt;
    int start = (int)blockIdx.x - rot; if (start < 0) start += gridDim.x;
    for (int t = start; t < ntiles; t += gridDim.x) {
      int k0 = (t / nnt) << 6, n0 = (t % nnt) << 6;
      int r = tid >> 4, c4 = (tid & 15) * 4;
#pragma unroll
      for (int hh = 0; hh < 2; ++hh) {
        int rr = r + hh * 32;
        float4 v = make_float4(0.f, 0.f, 0.f, 0.f);
        if (k0 + rr < c.K && n0 + c4 < c.N) v = *(const float4*)(c.src + (size_t)(k0 + rr) * c.ld + n0 + c4);
        tile[(c4 + 0) * 65 + rr] = v.x; tile[(c4 + 1) * 65 + rr] = v.y; tile[(c4 + 2) * 65 + rr] = v.z; tile[(c4 + 3) * 65 + rr] = v.w;
      }
      __syncthreads();
      int n = tid >> 3, kc = (tid & 7) * 8;
      const float* tp = tile + n * 65 + kc;
      uint4 o;
      o.x = pack2(tp[0], tp[1]); o.y = pack2(tp[2], tp[3]); o.z = pack2(tp[4], tp[5]); o.w = pack2(tp[6], tp[7]);
      *(uint4*)(c.dst + (size_t)(n0 + n) * c.ldd + k0 + kc) = o;
      __syncthreads();
    }
    rot = (rot + ntiles) % (int)gridDim.x;
  }
}

__device__ __forceinline__ void fourier_tables(const Ctx& p, bool with_ctx, const int tid) {
  u16* wm = (u16*)(p.ws + OFF_WMIX);
  u16* dftT = wm + M1;
  u16* m1t = dftT + 131072;
  u16* m2t = m1t + 16384;
  u16* dftC = m2t + 8192;
  float2* tw = (float2*)(dftC + 131072);
  size_t gtid = (size_t)blockIdx.x * 512 + tid, gsz = (size_t)gridDim.x * 512;
  for (size_t e = gtid; e < 512 * 256 / 8; e += gsz) {
    int r = (int)(e >> 5), c0 = (int)(e & 31) * 8;
    int ri = r >> 8, m = r & 255;
    float v[8];
#pragma unroll
    for (int q = 0; q < 8; ++q) {
      int ph = (m * (c0 + q)) & 255;
      float s, c; sincospif((float)ph * (1.f / 128.f), &s, &c);
      v[q] = (ri ? s : c) * (1.f / 16.f);
    }
    uint4 o; o.x = pack2(v[0], v[1]); o.y = pack2(v[2], v[3]); o.z = pack2(v[4], v[5]); o.w = pack2(v[6], v[7]);
    *(uint4*)(dftT + (size_t)r * 256 + c0) = o;
  }
  for (size_t e = gtid; e < 128 * 128; e += gsz) {
    int rho = (int)(e >> 7), kap = (int)(e & 127);
    int qq = rho >> 5, part = qq & 1, k1 = (qq >> 1) * 32 + (rho & 31);
    int ri = kap >> 6, l1 = kap & 63;
    int ph = (k1 * l1) & 63;
    float s, c; sincospif((float)ph * (1.f / 32.f), &s, &c);
    float v = (part == 0) ? (ri == 0 ? c : -s) : (ri == 0 ? -s : -c);
    m1t[e] = f2bf(v);
  }
  for (size_t e = gtid; e < 64 * 128; e += gsz) {
    int k2 = (int)(e >> 7), kap = (int)(e & 127);
    int ri = kap >> 6, l2 = kap & 63;
    int ph = (k2 * l2) & 63;
    float s, c; sincospif((float)ph * (1.f / 32.f), &s, &c);
    m2t[e] = f2bf((ri == 0 ? c : s) * (1.f / 64.f));
  }
  for (size_t e = gtid; e < 64 * 64; e += gsz) {
    int k1 = (int)(e >> 6), l2 = (int)(e & 63);
    float s, c; sincospif((float)(k1 * l2) * (1.f / 2048.f), &s, &c);
    tw[e] = make_float2(c, s);
  }
  if (with_ctx) {
    for (size_t e = gtid; e < 256 * 512 / 8; e += gsz) {
      int k = (int)(e >> 6), kap = (int)(e & 63) * 8;
      int ri = kap >> 8, l0 = kap & 255;
      float v[8];
#pragma unroll
      for (int q = 0; q < 8; ++q) {
        int ph = (k * (l0 + q)) & 255;
        float s, c; sincospif((float)ph * (1.f / 128.f), &s, &c);
        v[q] = (ri ? -s : c) * (1.f / 16.f);
      }
      uint4 o; o.x = pack2(v[0], v[1]); o.y = pack2(v[2], v[3]); o.z = pack2(v[4], v[5]); o.w = pack2(v[6], v[7]);
      *(uint4*)(dftC + (size_t)k * 512 + kap) = o;
    }
  }
}

struct GD {
  const u16* A; long lda; int a_rowmask; int a_mode; const float* mu;
  const u16* B; long b_rs_hi, b_rs_lo; int b_kshift; long b_kstride; int b_perm; int a_kshift; long a_kstride;
  int K, m0, n0;
  int ep; u16* out; long ldo; u16* out2; const float* e0; const u16* gsrc;
};
__device__ __forceinline__ void gd_plainA(GD& g, const u16* A, long lda) { g.A = A; g.lda = lda; g.a_rowmask = 0x7fffffff; g.a_mode = 0; g.mu = nullptr; g.a_kshift = 30; g.a_kstride = 0; }
__device__ __forceinline__ void gd_mixA(GD& g, const u16* H, const float* mu) { g.A = H; g.lda = 1024; g.a_rowmask = 0x7fffffff; g.a_mode = 1; g.mu = mu; g.a_kshift = 30; g.a_kstride = 0; }
__device__ __forceinline__ void gd_plainB(GD& g, const u16* B, long ldb) { g.B = B; g.b_rs_hi = 256 * ldb; g.b_rs_lo = ldb; g.b_kshift = 30; g.b_kstride = 0; g.b_perm = 0; }

__device__ __forceinline__ unsigned mix2(unsigned h, unsigned s, float m0, float m1) {
  float h0 = bflo(h), h1 = bfhi(h), s0 = bflo(s), s1 = bfhi(s);
  return pack2(h0 + (s0 - h0) * m0, h1 + (s1 - h1) * m1);
}

#define EPI_LOOP(LD, BODY) \
  _Pragma("unroll") for (int i = 0; i < 2; ++i) { _Pragma("unroll") for (int j = 0; j < 2; ++j) { \
    _Pragma("unroll") for (int r = 0; r < 16; ++r) { \
      const int off = (32 * i + (r & 3) + 8 * (r >> 2)) * (LD) + 32 * j; \
      const float v = acc[i][j][r]; BODY } \
    asm volatile("" ::: "memory"); } }

struct Stg { uint4 a0, a1, a2, a3, b0, b1; };

__device__ __forceinline__ int mix_nb(int t, int k) {
  int nb = -1;
  if (t < TL) {
    int l = t & 4095, c = l & 63, r = l >> 6, qq = k >> 8;
    if (qq == 0) nb = (c > 0) ? t - 1 : -1;
    else if (qq == 1) nb = (c < 63) ? t + 1 : -1;
    else if (qq == 2) nb = (r > 0) ? t - 64 : -1;
    else nb = (r < 63) ? t + 64 : -1;
  } else {
    int pp = (t - TL) & 255;
    if (k < 512) nb = (pp > 0) ? t - 1 : -1; else nb = (pp < 255) ? t + 1 : -1;
  }
  return nb;
}
__device__ __forceinline__ uint4 ld16(const u16* ptr) { return *(const uint4*)ptr; }
__device__ __forceinline__ uint4 mix4(uint4 h, uint4 s, float4 m0, float4 m1) {
  uint4 o;
  o.x = mix2(h.x, s.x, m0.x, m0.y); o.y = mix2(h.y, s.y, m0.z, m0.w);
  o.z = mix2(h.z, s.z, m1.x, m1.y); o.w = mix2(h.w, s.w, m1.z, m1.w);
  return o;
}

#define GEMM_HALF(KH) { \
    bf16x8 fa0[2], fa1[2], fb0[2], fb1[2]; \
    _Pragma("unroll") for (int kk = 0; kk < 2; ++kk) { \
      fa0[kk] = *(const bf16x8*)(ab + ((KH) * 2 + kk) * 16); \
      fb0[kk] = *(const bf16x8*)(bb + ((KH) * 2 + kk) * 16); \
      fa1[kk] = *(const bf16x8*)(ab + 32 * 72 + ((KH) * 2 + kk) * 16); \
      fb1[kk] = *(const bf16x8*)(bb + 32 * 72 + ((KH) * 2 + kk) * 16); } \
    __builtin_amdgcn_sched_barrier(0); \
    _Pragma("unroll") for (int kk = 0; kk < 2; ++kk) { \
      acc[0][0] = __builtin_amdgcn_mfma_f32_32x32x16_bf16(fa0[kk], fb0[kk], acc[0][0], 0, 0, 0); \
      acc[0][1] = __builtin_amdgcn_mfma_f32_32x32x16_bf16(fa0[kk], fb1[kk], acc[0][1], 0, 0, 0); \
      acc[1][0] = __builtin_amdgcn_mfma_f32_32x32x16_bf16(fa1[kk], fb0[kk], acc[1][0], 0, 0, 0); \
      acc[1][1] = __builtin_amdgcn_mfma_f32_32x32x16_bf16(fa1[kk], fb1[kk], acc[1][1], 0, 0, 0); \
    } \
    __builtin_amdgcn_sched_barrier(0); }
#define GEMM_COMPUTE(BUF) { \
    const u16* ab = As + (BUF) * 256 * 72 + (64 * wm + (lane & 31)) * 72 + 8 * (lane >> 5); \
    const u16* bb = Bs + (BUF) * 128 * 72 + (64 * wn + (lane & 31)) * 72 + 8 * (lane >> 5); \
    __builtin_amdgcn_sched_barrier(0); \
    GEMM_HALF(0) GEMM_HALF(1) }
struct Frg { bf16x8 a00, a01, a10, a11, b00, b01, b10, b11; };
#define GEMM_READF(F, BUF, KH) { \
    const u16* ab_ = As + (BUF) * 256 * 72 + (64 * wm + (lane & 31)) * 72 + 8 * (lane >> 5) + (KH) * 32; \
    const u16* bb_ = Bs + (BUF) * 128 * 72 + (64 * wn + (lane & 31)) * 72 + 8 * (lane >> 5) + (KH) * 32; \
    F.a00 = *(const bf16x8*)(ab_);           F.a01 = *(const bf16x8*)(ab_ + 16); \
    F.b00 = *(const bf16x8*)(bb_);           F.b01 = *(const bf16x8*)(bb_ + 16); \
    F.a10 = *(const bf16x8*)(ab_ + 32 * 72); F.a11 = *(const bf16x8*)(ab_ + 32 * 72 + 16); \
    F.b10 = *(const bf16x8*)(bb_ + 32 * 72); F.b11 = *(const bf16x8*)(bb_ + 32 * 72 + 16); }
#define GEMM_MFMA8(F) { \
    acc[0][0] = __builtin_amdgcn_mfma_f32_32x32x16_bf16(F.a00, F.b00, acc[0][0], 0, 0, 0); \
    acc[0][1] = __builtin_amdgcn_mfma_f32_32x32x16_bf16(F.a00, F.b10, acc[0][1], 0, 0, 0); \
    acc[1][0] = __builtin_amdgcn_mfma_f32_32x32x16_bf16(F.a10, F.b00, acc[1][0], 0, 0, 0); \
    acc[1][1] = __builtin_amdgcn_mfma_f32_32x32x16_bf16(F.a10, F.b10, acc[1][1], 0, 0, 0); \
    acc[0][0] = __builtin_amdgcn_mfma_f32_32x32x16_bf16(F.a01, F.b01, acc[0][0], 0, 0, 0); \
    acc[0][1] = __builtin_amdgcn_mfma_f32_32x32x16_bf16(F.a01, F.b11, acc[0][1], 0, 0, 0); \
    acc[1][0] = __builtin_amdgcn_mfma_f32_32x32x16_bf16(F.a11, F.b01, acc[1][0], 0, 0, 0); \
    acc[1][1] = __builtin_amdgcn_mfma_f32_32x32x16_bf16(F.a11, F.b11, acc[1][1], 0, 0, 0); }
#define GEMM_KSTEP_LAST(BUF, RLOAD, LSRC, KT, RSTORE) { \
    GEMM_READF(F1, BUF, 1) \
    GEMM_LOADX(RLOAD, LSRC, KT) \
    __builtin_amdgcn_sched_barrier(0); \
    GEMM_MFMA8(F0) \
    __builtin_amdgcn_sched_barrier(0); \
    GEMM_STORE(RSTORE, (BUF) ^ 1) \
    __syncthreads(); \
    GEMM_MFMA8(F1) \
    __builtin_amdgcn_sched_barrier(0); }
#define GEMM_KSTEP(BUF, RLOAD, LSRC, KT, RSTORE) { \
    GEMM_READF(F1, BUF, 1) \
    GEMM_LOADX(RLOAD, LSRC, KT) \
    __builtin_amdgcn_sched_barrier(0); \
    GEMM_MFMA8(F0) \
    __builtin_amdgcn_sched_barrier(0); \
    GEMM_STORE(RSTORE, (BUF) ^ 1) \
    __syncthreads(); \
    GEMM_READF(F0, (BUF) ^ 1, 0) \
    __builtin_amdgcn_sched_barrier(0); \
    GEMM_MFMA8(F1) \
    __builtin_amdgcn_sched_barrier(0); }
#define GEMM_LOADX(R, L, KT) { const int k0_ = min((KT), L.nk - 1) * 64; \
    const int soa_ = __builtin_amdgcn_readfirstlane((int)(((long)(k0_ >> L.akshift) * L.akstride + (k0_ & L.akmask)) * 2)); \
    const int sob_ = __builtin_amdgcn_readfirstlane((int)(((long)(k0_ >> L.kshift) * L.kstride + (k0_ & L.kmask)) * 2)); \
    const __amdgpu_buffer_rsrc_t rsA_ = make_rsrc(L.baseA); const __amdgpu_buffer_rsrc_t rsB_ = make_rsrc(L.baseB); \
    R.a0 = bufld(rsA_, L.va0, soa_); R.a1 = bufld(rsA_, L.va1, soa_); R.a2 = bufld(rsA_, L.va2, soa_); R.a3 = bufld(rsA_, L.va3, soa_); \
    R.b0 = bufld(rsB_, L.vb0, sob_); R.b1 = bufld(rsB_, L.vb1, sob_); }
#define GEMM_STORE(R, BUF) { u16* ad_ = As + (BUF) * 256 * 72 + sto; u16* bd_ = Bs + (BUF) * 128 * 72 + sto; \
    *(uint4*)(ad_) = R.a0; *(uint4*)(ad_ + 64 * 72) = R.a1; *(uint4*)(ad_ + 128 * 72) = R.a2; *(uint4*)(ad_ + 192 * 72) = R.a3; \
    *(uint4*)(bd_) = R.b0; *(uint4*)(bd_ + 64 * 72) = R.b1; }

typedef __attribute__((ext_vector_type(4))) unsigned u32x4;
__device__ __forceinline__ __amdgpu_buffer_rsrc_t make_rsrc(const u16* q) {
  unsigned long long v = (unsigned long long)q;
  unsigned lo = __builtin_amdgcn_readfirstlane((unsigned)v), hi = __builtin_amdgcn_readfirstlane((unsigned)(v >> 32));
  void* up = (void*)(((unsigned long long)hi << 32) | lo);
  return __builtin_amdgcn_make_buffer_rsrc(up, (short)0, 0x7ffffff0, 0x00020000);
}
__device__ __forceinline__ uint4 bufld(__amdgpu_buffer_rsrc_t rs, unsigned voff, int soff) {
  u32x4 v = __builtin_amdgcn_raw_buffer_load_b128(rs, (int)voff, soff, 0);
  return make_uint4(v[0], v[1], v[2], v[3]);
}

struct LdSt { const u16* baseA; const u16* baseB; unsigned va0, va1, va2, va3, vb0, vb1; int nk, kshift, kmask; long kstride; int akshift, akmask; long akstride; };
__device__ __forceinline__ void ld_setup(LdSt& L, const GD& g, const int lr, const int lc) {
  L.baseA = g.A; L.baseB = g.B + (long)(g.n0 >> 8) * g.b_rs_hi;
  const unsigned nl = (unsigned)(g.n0 & 255) + (unsigned)lr;
  L.vb0 = (nl * (unsigned)g.b_rs_lo + (unsigned)lc) * 2u;
  L.vb1 = ((nl + 64u) * (unsigned)g.b_rs_lo + (unsigned)lc) * 2u;
  const int t0 = g.m0 + lr;
  const unsigned ulda = (unsigned)g.lda;
  L.va0 = ((unsigned)((t0) & g.a_rowmask) * ulda + (unsigned)lc) * 2u;
  L.va1 = ((unsigned)((t0 + 64) & g.a_rowmask) * ulda + (unsigned)lc) * 2u;
  L.va2 = ((unsigned)((t0 + 128) & g.a_rowmask) * ulda + (unsigned)lc) * 2u;
  L.va3 = ((unsigned)((t0 + 192) & g.a_rowmask) * ulda + (unsigned)lc) * 2u;
  L.nk = g.K >> 6; L.kshift = g.b_kshift; L.kmask = (1 << g.b_kshift) - 1; L.kstride = g.b_kstride;
  L.akshift = g.a_kshift; L.akmask = (1 << g.a_kshift) - 1; L.akstride = g.a_kstride;
  if (g.b_perm == 1) {
    const unsigned n_0 = (unsigned)g.n0 + (unsigned)lr, n_1 = n_0 + 64u;
    const unsigned tk0 = (n_0 & ~4095u) | ((n_0 & 63u) << 6) | ((n_0 >> 6) & 63u);
    const unsigned tk1 = (n_1 & ~4095u) | ((n_1 & 63u) << 6) | ((n_1 >> 6) & 63u);
    L.baseB = g.B;
    L.vb0 = (tk0 * 1024u + (unsigned)lc) * 2u; L.vb1 = (tk1 * 1024u + (unsigned)lc) * 2u;
  } else if (g.b_perm == 2) {
    const unsigned n_0 = (unsigned)g.n0 + (unsigned)lr, n_1 = n_0 + 64u;
    const unsigned r0 = (((n_0 & 1023u) * 8u + (n_0 >> 16)) * 64u + ((n_0 >> 10) & 63u));
    const unsigned r1 = (((n_1 & 1023u) * 8u + (n_1 >> 16)) * 64u + ((n_1 >> 10) & 63u));
    L.baseB = g.B;
    L.vb0 = (r0 * 128u + (unsigned)lc) * 2u; L.vb1 = (r1 * 128u + (unsigned)lc) * 2u;
  }
}
__device__ __forceinline__ void ld_select(LdSt& o, const bool c, const LdSt& a, const LdSt& b) {
  o.baseA = c ? a.baseA : b.baseA; o.baseB = c ? a.baseB : b.baseB;
  o.va0 = c ? a.va0 : b.va0; o.va1 = c ? a.va1 : b.va1; o.va2 = c ? a.va2 : b.va2; o.va3 = c ? a.va3 : b.va3;
  o.vb0 = c ? a.vb0 : b.vb0; o.vb1 = c ? a.vb1 : b.vb1;
  o.nk = c ? a.nk : b.nk; o.kshift = c ? a.kshift : b.kshift; o.kmask = c ? a.kmask : b.kmask; o.kstride = c ? a.kstride : b.kstride;
  o.akshift = c ? a.akshift : b.akshift; o.akmask = c ? a.akmask : b.akmask; o.akstride = c ? a.akstride : b.akstride;
}

__device__ __forceinline__ void gemm_epilogue(const Ctx& p, const GD& g, f32x16 (&acc)[2][2], const int tid);

__device__ __forceinline__ void gemm_tile_mix(const Ctx& p, char* smem, const GD& g, const int tid) {
  u16* As = (u16*)smem;
  u16* Bs = As + 2 * 256 * 72;
  const int lane = tid & 63, w = tid >> 6, wm = w >> 1, wn = w & 1;
  const int lr = tid >> 3, lc = (tid & 7) * 8;
  f32x16 acc[2][2];
#pragma unroll
  for (int i = 0; i < 2; ++i)
#pragma unroll
    for (int j = 0; j < 2; ++j)
#pragma unroll
      for (int r = 0; r < 16; ++r) acc[i][j][r] = 0.f;
  Stg R0, R1;
  LdSt L; ld_setup(L, g, lr, lc);
  const int nk = L.nk;
  const int t0 = g.m0 + lr;
  const int sto = lr * 72 + lc;
  {
    float4 mu0, mu1;
    int nbm = 0;
    const uint4 z4 = make_uint4(0, 0, 0, 0);
    int nq0[4], nq1[4], nq2[4], nq3[4];
#pragma unroll
    for (int q4 = 0; q4 < 4; ++q4) {
      nq0[q4] = mix_nb(t0, q4 * 256); nq1[q4] = mix_nb(t0 + 64, q4 * 256); nq2[q4] = mix_nb(t0 + 128, q4 * 256); nq3[q4] = mix_nb(t0 + 192, q4 * 256);
    }
    for (int kt = -1; kt < nk; ++kt) {
      const int cur = kt & 1;
      if (kt + 1 < nk) {
        const int k0 = (kt + 1) * 64;
        const int k = k0 + lc;
        GEMM_LOADX(R0, L, kt + 1)
        const __amdgpu_buffer_rsrc_t rsA = make_rsrc(L.baseA);
        mu0 = *(const float4*)(g.mu + k); mu1 = *(const float4*)(g.mu + k + 4);
        const int soa = __builtin_amdgcn_readfirstlane(k0 * 2);
        const int qq = __builtin_amdgcn_readfirstlane(k0 >> 8);
        const int nb0 = (qq == 0) ? nq0[0] : (qq == 1) ? nq0[1] : (qq == 2) ? nq0[2] : nq0[3];
        const int nb1 = (qq == 0) ? nq1[0] : (qq == 1) ? nq1[1] : (qq == 2) ? nq1[2] : nq1[3];
        const int nb2 = (qq == 0) ? nq2[0] : (qq == 1) ? nq2[1] : (qq == 2) ? nq2[2] : nq2[3];
        const int nb3 = (qq == 0) ? nq3[0] : (qq == 1) ? nq3[1] : (qq == 2) ? nq3[2] : nq3[3];
        nbm = (nb0 >= 0 ? 1 : 0) | (nb1 >= 0 ? 2 : 0) | (nb2 >= 0 ? 4 : 0) | (nb3 >= 0 ? 8 : 0);
        R1.a0 = bufld(rsA, nb0 >= 0 ? ((unsigned)nb0 * 1024u + (unsigned)lc) * 2u : 0x80000000u, soa);
        R1.a1 = bufld(rsA, nb1 >= 0 ? ((unsigned)nb1 * 1024u + (unsigned)lc) * 2u : 0x80000000u, soa);
        R1.a2 = bufld(rsA, nb2 >= 0 ? ((unsigned)nb2 * 1024u + (unsigned)lc) * 2u : 0x80000000u, soa);
        R1.a3 = bufld(rsA, nb3 >= 0 ? ((unsigned)nb3 * 1024u + (unsigned)lc) * 2u : 0x80000000u, soa);
      }
      if (kt >= 0) GEMM_COMPUTE(cur)
      if (kt + 1 < nk) {
        R0.a0 = mix4(R0.a0, R1.a0, mu0, mu1); R0.a1 = mix4(R0.a1, R1.a1, mu0, mu1);
        R0.a2 = mix4(R0.a2, R1.a2, mu0, mu1); R0.a3 = mix4(R0.a3, R1.a3, mu0, mu1);
        GEMM_STORE(R0, cur ^ 1)
      }
      __syncthreads();
    }
  }
  gemm_epilogue(p, g, acc, tid);
}

__device__ __forceinline__ void gemm_epilogue(const Ctx& p, const GD& g, f32x16 (&acc)[2][2], const int tid) {
  int te = tid;
  asm volatile("" : "+v"(te));
  const int le = te & 63, we = te >> 6;
  const int lrow0 = 64 * (we >> 1) + 4 * (le >> 5), lcol0 = 64 * (we & 1) + (le & 31);
  const int ldo = (int)g.ldo;
  switch (g.ep) {
    case 0: { u16* ob = g.out + (size_t)(g.m0 + lrow0) * g.ldo + g.n0 + lcol0; EPI_LOOP(ldo, { ob[off] = f2bf(v); }) } break;
    case 1: { u16* ob = g.out + (size_t)(g.m0 + lrow0) * g.ldo + g.n0 + lcol0; EPI_LOOP(ldo, { ob[off] = f2bf(tanhf(v)); }) } break;
    case 2: { u16* ob = g.out + (size_t)(g.m0 + lrow0) * g.ldo + g.n0 + lcol0; EPI_LOOP(ldo, { ob[off] = f2bf(sigmoidf_(v)); }) } break;
    case 3: { u16* ob = g.out + (size_t)(g.m0 + lrow0) * g.ldo + g.n0 + lcol0; EPI_LOOP(ldo, { float rr = fmaxf(v, 0.f); ob[off] = f2bf(rr * rr); }) } break;
    case 4: { u16* ob = g.out + (size_t)(g.m0 + lrow0) * 64 + g.n0 + lcol0; if (g.n0 + lcol0 < 32) { EPI_LOOP(64, { ob[off] = f2bf(v); }) } } break;
    case 5: {
      const int jb = (g.m0 < TL) ? (g.m0 >> 12) : 8;
      const float* gp = g.e0 + jb * 6144 + g.n0 + lcol0;
      const float g0 = gp[0], g1 = gp[32];
      u16* ob = g.out + (size_t)(g.m0 + lrow0) * 1024 + g.n0 + lcol0;
      EPI_LOOP(1024, { ob[off] = f2bf((j ? g1 : g0) * v); })
    } break;
    case 6: { u16* ob = g.out + (size_t)(g.m0 + lrow0) * g.ldo + g.n0 + lcol0; const float* bp = g.e0 + g.n0 + lcol0; const float c0 = bp[0], c1 = bp[32];
      EPI_LOOP(ldo, { ob[off] = f2bf(sigmoidf_((j ? c1 : c0) + v)); }) } break;
    case 7: {
      u16* ob = g.out + (size_t)(g.m0 + lrow0) * 1024 + g.n0 + lcol0; const u16* gs = g.gsrc + (size_t)(g.m0 + lrow0) * 1024 + g.n0 + lcol0;
      EPI_LOOP(1024, { float vf = bf2f(ob[off]); float gt = bf2f(gs[off]); ob[off] = f2bf(v + (vf - v) * gt); })
    } break;
    case 8: {
      u16* ob; int ld;
      if (g.n0 < TL) { ld = TL; ob = g.out + (size_t)(g.m0 + lrow0) * TL + g.n0 + lcol0; } else { ld = TC; ob = g.out2 + (size_t)(g.m0 + lrow0) * TC + (g.n0 - TL) + lcol0; }
      EPI_LOOP(ld, { ob[off] = f2bf(v); })
    } break;
    case 9: {
      const int gq = g.m0 >> 17, rloc = g.m0 & 131071;
      const int mmq = rloc >> 9, b = ((rloc & 511) >> 6) + (we >> 1);
      const int k1 = 32 * (we & 1) + (le & 31);
      const float2* tw = (const float2*)g.e0 + k1 * 64;
      u16* zb = g.out + ((size_t)(((gq * 256 + mmq) * 8 + b) * 64 + k1) * 2) * 64;
#pragma unroll
      for (int i = 0; i < 2; ++i) {
#pragma unroll
        for (int rq = 0; rq < 4; ++rq) {
          const int l20 = 32 * i + 8 * rq + 4 * (le >> 5);
          float zr[4], zi[4];
#pragma unroll
          for (int e = 0; e < 4; ++e) {
            const float2 t = tw[l20 + e];
            const float re = acc[i][0][rq * 4 + e], im = acc[i][1][rq * 4 + e];
            zr[e] = re * t.x + im * t.y; zi[e] = im * t.x - re * t.y;
          }
          *(uint2*)(zb + l20) = make_uint2(pack2(zr[0], zr[1]), pack2(zr[2], zr[3]));
          *(uint2*)(zb + 64 + l20) = make_uint2(pack2(zi[0], zi[1]), pack2(zi[2], zi[3]));
        }
        asm volatile("" ::: "memory");
      }
    } break;
    case 10: {
      if ((we >> 1) == 0) {
        const int b = g.n0 >> 16, k1 = (g.n0 >> 10) & 63, gm0 = (g.n0 & 1023) + lcol0;
        u16* ob = g.out + ((size_t)(b * 4096 + k1 + 64 * (4 * (le >> 5)))) * 1024 + gm0;
        EPI_LOOP(65536, { ob[off] = f2bf(v); })
      }
    } break;
    default: break;
  }
}

enum { G_RB = 0, G_RC, G_RC2, G_WO_R, G_FB, G_F1, G_F2, G_WO_F, G_MLP1, G_MLP2 };

__device__ __forceinline__ int gemm_total(int kind, int layer) {
  const int idx = layer >> 1;
  const bool ctx_in = layer <= 2, ctx_out = layer < 2;
  const int mt_out = (ctx_out ? T : TL) >> 8;
  switch (kind) {
    case G_RB: return 136 * ((idx == 0) ? 27 : 20);
    case G_RC: return 136 * ((idx == 0) ? 8 : 16);
    case G_RC2: return 136 * 8;
    case G_WO_R: return mt_out * 8;
    case G_FB: return 8 * (ctx_in ? 272 : 256);
    case G_F1: return 2048;
    case G_F2: return 4096 + (ctx_in ? 64 : 0);
    case G_WO_F: return mt_out * 8;
    case G_MLP1: return mt_out * 32;
    default: return mt_out * 8;
  }
}

__device__ __forceinline__ void make_gd(const Ctx& p, int kind, int layer, int tile, GD& g) {
  const int idx = layer >> 1;
  const u16* H = (const u16*)p.ws;
  const u16* wm = (const u16*)(p.ws + OFF_WMIX);
  const float* mu = p.in[10] + (size_t)idx * 6 * 1024;
  const float* mod = (const float*)(p.ws + OFF_MOD) + (size_t)layer * 9 * 6144;
  g.out = nullptr; g.out2 = nullptr; g.e0 = nullptr; g.gsrc = nullptr; g.ldo = 1024; g.ep = 0; g.K = 1024;
  switch (kind) {
    case G_RB: {
      const int CT = (idx == 0) ? 27 : 20;
      int tm = tile / CT, ct = tile % CT;
      g.m0 = tm * 256;
      int nv = (idx == 0) ? 8 : 0;
      if (ct < 8) { gd_mixA(g, H, mu + 0 * 1024); gd_plainB(g, wm + 0 * M1, 1024); g.n0 = ct * 128; g.out = (u16*)(p.ws + 1 * SLOT); }
      else if (ct < 16) { gd_mixA(g, H, mu + 2 * 1024); gd_plainB(g, wm + 1 * M1, 1024); g.n0 = (ct - 8) * 128; g.out = (u16*)(p.ws + 2 * SLOT); }
      else if (ct < 16 + nv) { gd_mixA(g, H, mu + 3 * 1024); gd_plainB(g, wm + 2 * M1, 1024); g.n0 = (ct - 16) * 128; g.out = (u16*)(p.ws + 5 * SLOT); }
      else {
        int q = ct - 16 - nv; g.n0 = 0;
        if (q == 0) { gd_mixA(g, H, mu + 1 * 1024); gd_plainB(g, wm + 4 * M1, 1024); g.ep = 1; g.out = (u16*)(p.ws + OFF_HW); g.ldo = 128; }
        else if (q == 1) { gd_mixA(g, H, mu + 4 * 1024); gd_plainB(g, wm + 4 * M1 + 131072, 1024); g.ep = 0; g.out = (u16*)(p.ws + OFF_HA); g.ldo = 128; }
        else if (q == 2) { gd_mixA(g, H, mu + 5 * 1024); gd_plainB(g, wm + 4 * M1 + 2 * 131072, 1024); g.ep = 2; g.out = (u16*)(p.ws + OFF_HG); g.ldo = 128; }
        else { gd_mixA(g, H, mu + 3 * 1024); gd_plainB(g, wm + 4 * M1 + 3 * 131072, 1024); g.ep = 0; g.out = (u16*)(p.ws + OFF_HV); g.ldo = 128; }
      }
    } break;
    case G_RC: {
      const int CT = (idx == 0) ? 8 : 16;
      int tm = tile / CT, ct = tile % CT;
      g.m0 = tm * 256;
      if (ct < 8) { gd_plainA(g, (const u16*)(p.ws + OFF_HG), 128); gd_plainB(g, wm + 4 * M1 + 4 * 131072, 128); g.K = 128; g.n0 = ct * 128; g.out = (u16*)(p.ws + 4 * SLOT); }
      else { gd_plainA(g, (const u16*)(p.ws + OFF_HV), 128); gd_plainB(g, wm + 4 * M1 + 5 * 131072, 128); g.K = 128; g.n0 = (ct - 8) * 128; g.ep = 6; g.e0 = p.in[21]; g.out = (u16*)(p.ws + 3 * SLOT); }
    } break;
    case G_RC2: {
      int tm = tile >> 3, ct = tile & 7;
      g.m0 = tm * 256; g.n0 = ct * 128;
      gd_mixA(g, H, mu + 3 * 1024); gd_plainB(g, wm + 2 * M1, 1024);
      g.ep = 7; g.out = (u16*)(p.ws + 5 * SLOT); g.gsrc = (const u16*)(p.ws + 3 * SLOT);
    } break;
    case G_WO_R: {
      int tm = tile >> 3, ct = tile & 7;
      g.m0 = tm * 256; g.n0 = ct * 128;
      gd_plainA(g, H, 1024); gd_plainB(g, wm + 3 * M1, 1024);
      g.ep = 5; g.e0 = mod + 2048; g.out = (u16*)(p.ws + 1 * SLOT);
    } break;
    case G_FB: {
      int tn = tile >> 3, tm = tile & 7;
      g.K = 256; g.m0 = tm * 256; g.n0 = tn * 128;
      gd_plainA(g, wm + M1, 256); g.a_rowmask = 511;
      gd_plainB(g, H + 256 * (tm >> 1), 1024);
      if (g.n0 < TL) g.b_perm = 1;
      g.ep = 8; g.out = (u16*)(p.ws + 1 * SLOT); g.out2 = g.out + (size_t)2048 * TL;
    } break;
    case G_F1: {
      const u16* YT = (const u16*)(p.ws + 1 * SLOT);
      const int gq = tile >> 9;
      g.K = 128; g.m0 = tile * 256; g.n0 = 0;
      gd_plainA(g, YT + (size_t)gq * 512 * TL - (size_t)gq * 131072 * 64, 64);
      g.a_kshift = 6; g.a_kstride = (long)256 * TL;
      gd_plainB(g, wm + M1 + 131072, 128);
      g.ep = 9; g.out = (u16*)(p.ws + 3 * SLOT); g.e0 = (const float*)(wm + M1 + 131072 + 16384 + 8192 + 131072);
    } break;
    case G_F2: {
      u16* fo = (u16*)(p.ws + 1 * SLOT);
      if (tile < 4096) {
        g.K = 128; g.m0 = 0; g.n0 = tile * 128;
        gd_plainA(g, wm + M1 + 131072 + 16384, 128); g.a_rowmask = 63;
        gd_plainB(g, (const u16*)(p.ws + 3 * SLOT), 128); g.b_perm = 2;
        g.ep = 10; g.out = fo;
      } else {
        const u16* dftC = wm + M1 + 131072 + 16384 + 8192;
        const u16* YTc = (const u16*)(p.ws + 1 * SLOT) + (size_t)2048 * TL;
        int t2 = tile - 4096; int b = t2 >> 3, ct = t2 & 7;
        g.K = 512; g.m0 = 0; g.n0 = ct * 128;
        gd_plainA(g, dftC, 512);
        g.B = YTc + (size_t)b * 256; g.b_rs_hi = (long)512 * TC; g.b_rs_lo = TC; g.b_kshift = 8; g.b_kstride = (long)256 * TC; g.b_perm = 0;
        g.out = fo + (size_t)(TL + b * 256) * 1024;
      }
    } break;
    case G_WO_F: {
      int tm = tile >> 3, ct = tile & 7;
      g.m0 = tm * 256; g.n0 = ct * 128;
      gd_plainA(g, (const u16*)(p.ws + 1 * SLOT), 1024); gd_plainB(g, wm, 1024);
      g.ep = 5; g.e0 = mod + 2048; g.out = (u16*)(p.ws + 2 * SLOT);
    } break;
    case G_MLP1: {
      const int grp = tile >> 7, ii = tile & 127;
      int tm = grp * 4 + ((ii & 31) >> 3), ct = (ii >> 5) * 8 + (ii & 7);
      g.m0 = tm * 256; g.n0 = ct * 128;
      gd_plainA(g, H, 1024); gd_plainB(g, (const u16*)(p.ws + OFF_WMLP), 1024);
      g.ep = 3; g.out = (u16*)(p.ws + 1 * SLOT); g.ldo = 4096;
    } break;
    default: {
      int tm = tile >> 3, ct = tile & 7;
      g.K = 4096; g.m0 = tm * 256; g.n0 = ct * 128;
      gd_plainA(g, (const u16*)(p.ws + 1 * SLOT), 4096); gd_plainB(g, (const u16*)(p.ws + OFF_WMLP) + 4 * M1, 4096);
      g.ep = 5; g.e0 = mod + 5 * 1024; g.out = (u16*)(p.ws);
    } break;
  }
}

#define SCAN_SA_TEXT \
      "v_mul_f32_dpp %0, %2, %3 row_newbcast:0 row_mask:0xf bank_mask:0xf\n\t" \
      "v_mul_f32_dpp %1, %2, %4 row_newbcast:1 row_mask:0xf bank_mask:0xf\n\t" \
      "v_fmac_f32_dpp %0, %2, %5 row_newbcast:2 row_mask:0xf bank_mask:0xf\n\t" \
      "v_fmac_f32_dpp %1, %2, %6 row_newbcast:3 row_mask:0xf bank_mask:0xf\n\t" \
      "v_fmac_f32_dpp %0, %2, %7 row_newbcast:4 row_mask:0xf bank_mask:0xf\n\t" \
      "v_fmac_f32_dpp %1, %2, %8 row_newbcast:5 row_mask:0xf bank_mask:0xf\n\t" \
      "v_fmac_f32_dpp %0, %2, %9 row_newbcast:6 row_mask:0xf bank_mask:0xf\n\t" \
      "v_fmac_f32_dpp %1, %2, %10 row_newbcast:7 row_mask:0xf bank_mask:0xf\n\t" \
      "v_fmac_f32_dpp %0, %2, %11 row_newbcast:8 row_mask:0xf bank_mask:0xf\n\t" \
      "v_fmac_f32_dpp %1, %2, %12 row_newbcast:9 row_mask:0xf bank_mask:0xf\n\t" \
      "v_fmac_f32_dpp %0, %2, %13 row_newbcast:10 row_mask:0xf bank_mask:0xf\n\t" \
      "v_fmac_f32_dpp %1, %2, %14 row_newbcast:11 row_mask:0xf bank_mask:0xf\n\t" \
      "v_fmac_f32_dpp %0, %2, %15 row_newbcast:12 row_mask:0xf bank_mask:0xf\n\t" \
      "v_fmac_f32_dpp %1, %2, %16 row_newbcast:13 row_mask:0xf bank_mask:0xf\n\t" \
      "v_fmac_f32_dpp %0, %2, %17 row_newbcast:14 row_mask:0xf bank_mask:0xf\n\t" \
      "v_fmac_f32_dpp %1, %2, %18 row_newbcast:15 row_mask:0xf bank_mask:0xf\n\t"
#define SCAN_SA(sa0, sa1, A) asm( \
      SCAN_SA_TEXT \
      : "=&v"(sa0), "=&v"(sa1) : "v"(A), "v"(S[0]), "v"(S[1]), "v"(S[2]), "v"(S[3]), "v"(S[4]), "v"(S[5]), "v"(S[6]), "v"(S[7]), \
        "v"(S[8]), "v"(S[9]), "v"(S[10]), "v"(S[11]), "v"(S[12]), "v"(S[13]), "v"(S[14]), "v"(S[15]))
#define SCAN_UP(B0, W, Bv, KD, sa, VV) asm( \
      "v_mul_f32_dpp %0, %16, %8 row_newbcast:0 row_mask:0xf bank_mask:0xf\n\t" \
      "v_mul_f32_dpp %1, %16, %9 row_newbcast:1 row_mask:0xf bank_mask:0xf\n\t" \
      "v_mul_f32_dpp %2, %16, %10 row_newbcast:2 row_mask:0xf bank_mask:0xf\n\t" \
      "v_mul_f32_dpp %3, %16, %11 row_newbcast:3 row_mask:0xf bank_mask:0xf\n\t" \
      "v_mul_f32_dpp %4, %16, %12 row_newbcast:4 row_mask:0xf bank_mask:0xf\n\t" \
      "v_mul_f32_dpp %5, %16, %13 row_newbcast:5 row_mask:0xf bank_mask:0xf\n\t" \
      "v_mul_f32_dpp %6, %16, %14 row_newbcast:6 row_mask:0xf bank_mask:0xf\n\t" \
      "v_mul_f32_dpp %7, %16, %15 row_newbcast:7 row_mask:0xf bank_mask:0xf\n\t" \
      "v_fmac_f32_dpp %0, %17, %19 row_newbcast:0 row_mask:0xf bank_mask:0xf\n\t" \
      "v_fmac_f32_dpp %1, %17, %19 row_newbcast:1 row_mask:0xf bank_mask:0xf\n\t" \
      "v_fmac_f32_dpp %2, %17, %19 row_newbcast:2 row_mask:0xf bank_mask:0xf\n\t" \
      "v_fmac_f32_dpp %3, %17, %19 row_newbcast:3 row_mask:0xf bank_mask:0xf\n\t" \
      "v_fmac_f32_dpp %4, %17, %19 row_newbcast:4 row_mask:0xf bank_mask:0xf\n\t" \
      "v_fmac_f32_dpp %5, %17, %19 row_newbcast:5 row_mask:0xf bank_mask:0xf\n\t" \
      "v_fmac_f32_dpp %6, %17, %19 row_newbcast:6 row_mask:0xf bank_mask:0xf\n\t" \
      "v_fmac_f32_dpp %7, %17, %19 row_newbcast:7 row_mask:0xf bank_mask:0xf\n\t" \
      "v_fmac_f32_dpp %0, %18, %20 row_newbcast:0 row_mask:0xf bank_mask:0xf\n\t" \
      "v_fmac_f32_dpp %1, %18, %20 row_newbcast:1 row_mask:0xf bank_mask:0xf\n\t" \
      "v_fmac_f32_dpp %2, %18, %20 row_newbcast:2 row_mask:0xf bank_mask:0xf\n\t" \
      "v_fmac_f32_dpp %3, %18, %20 row_newbcast:3 row_mask:0xf bank_mask:0xf\n\t" \
      "v_fmac_f32_dpp %4, %18, %20 row_newbcast:4 row_mask:0xf bank_mask:0xf\n\t" \
      "v_fmac_f32_dpp %5, %18, %20 row_newbcast:5 row_mask:0xf bank_mask:0xf\n\t" \
      "v_fmac_f32_dpp %6, %18, %20 row_newbcast:6 row_mask:0xf bank_mask:0xf\n\t" \
      "v_fmac_f32_dpp %7, %18, %20 row_newbcast:7 row_mask:0xf bank_mask:0xf\n\t" \
      : "=&v"(N[B0 + 0]), "=&v"(N[B0 + 1]), "=&v"(N[B0 + 2]), "=&v"(N[B0 + 3]), "=&v"(N[B0 + 4]), "=&v"(N[B0 + 5]), "=&v"(N[B0 + 6]), "=&v"(N[B0 + 7]) \
      : "v"(S[B0 + 0]), "v"(S[B0 + 1]), "v"(S[B0 + 2]), "v"(S[B0 + 3]), "v"(S[B0 + 4]), "v"(S[B0 + 5]), "v"(S[B0 + 6]), "v"(S[B0 + 7]), \
        "v"(W), "v"(Bv), "v"(KD), "v"(sa), "v"(VV))
#define SCAN_UP8(B0, W, Bv, KD, sa, VV) asm( \
      "v_mul_f32_dpp %0, %16, %8 row_newbcast:8 row_mask:0xf bank_mask:0xf\n\t" \
      "v_mul_f32_dpp %1, %16, %9 row_newbcast:9 row_mask:0xf bank_mask:0xf\n\t" \
      "v_mul_f32_dpp %2, %16, %10 row_newbcast:10 row_mask:0xf bank_mask:0xf\n\t" \
      "v_mul_f32_dpp %3, %16, %11 row_newbcast:11 row_mask:0xf bank_mask:0xf\n\t" \
      "v_mul_f32_dpp %4, %16, %12 row_newbcast:12 row_mask:0xf bank_mask:0xf\n\t" \
      "v_mul_f32_dpp %5, %16, %13 row_newbcast:13 row_mask:0xf bank_mask:0xf\n\t" \
      "v_mul_f32_dpp %6, %16, %14 row_newbcast:14 row_mask:0xf bank_mask:0xf\n\t" \
      "v_mul_f32_dpp %7, %16, %15 row_newbcast:15 row_mask:0xf bank_mask:0xf\n\t" \
      "v_fmac_f32_dpp %0, %17, %19 row_newbcast:8 row_mask:0xf bank_mask:0xf\n\t" \
      "v_fmac_f32_dpp %1, %17, %19 row_newbcast:9 row_mask:0xf bank_mask:0xf\n\t" \
      "v_fmac_f32_dpp %2, %17, %19 row_newbcast:10 row_mask:0xf bank_mask:0xf\n\t" \
      "v_fmac_f32_dpp %3, %17, %19 row_newbcast:11 row_mask:0xf bank_mask:0xf\n\t" \
      "v_fmac_f32_dpp %4, %17, %19 row_newbcast:12 row_mask:0xf bank_mask:0xf\n\t" \
      "v_fmac_f32_dpp %5, %17, %19 row_newbcast:13 row_mask:0xf bank_mask:0xf\n\t" \
      "v_fmac_f32_dpp %6, %17, %19 row_newbcast:14 row_mask:0xf bank_mask:0xf\n\t" \
      "v_fmac_f32_dpp %7, %17, %19 row_newbcast:15 row_mask:0xf bank_mask:0xf\n\t" \
      "v_fmac_f32_dpp %0, %18, %20 row_newbcast:8 row_mask:0xf bank_mask:0xf\n\t" \
      "v_fmac_f32_dpp %1, %18, %20 row_newbcast:9 row_mask:0xf bank_mask:0xf\n\t" \
      "v_fmac_f32_dpp %2, %18, %20 row_newbcast:10 row_mask:0xf bank_mask:0xf\n\t" \
      "v_fmac_f32_dpp %3, %18, %20 row_newbcast:11 row_mask:0xf bank_mask:0xf\n\t" \
      "v_fmac_f32_dpp %4, %18, %20 row_newbcast:12 row_mask:0xf bank_mask:0xf\n\t" \
      "v_fmac_f32_dpp %5, %18, %20 row_newbcast:13 row_mask:0xf bank_mask:0xf\n\t" \
      "v_fmac_f32_dpp %6, %18, %20 row_newbcast:14 row_mask:0xf bank_mask:0xf\n\t" \
      "v_fmac_f32_dpp %7, %18, %20 row_newbcast:15 row_mask:0xf bank_mask:0xf\n\t" \
      : "=&v"(N[B0 + 0]), "=&v"(N[B0 + 1]), "=&v"(N[B0 + 2]), "=&v"(N[B0 + 3]), "=&v"(N[B0 + 4]), "=&v"(N[B0 + 5]), "=&v"(N[B0 + 6]), "=&v"(N[B0 + 7]) \
      : "v"(S[B0 + 0]), "v"(S[B0 + 1]), "v"(S[B0 + 2]), "v"(S[B0 + 3]), "v"(S[B0 + 4]), "v"(S[B0 + 5]), "v"(S[B0 + 6]), "v"(S[B0 + 7]), \
        "v"(W), "v"(Bv), "v"(KD), "v"(sa), "v"(VV))
#define SCAN_Y(sa0, sa1, A) asm( \
      SCAN_SA_TEXT \
      : "=&v"(sa0), "=&v"(sa1) : "v"(A), "v"(N[0]), "v"(N[1]), "v"(N[2]), "v"(N[3]), "v"(N[4]), "v"(N[5]), "v"(N[6]), "v"(N[7]), \
        "v"(N[8]), "v"(N[9]), "v"(N[10]), "v"(N[11]), "v"(N[12]), "v"(N[13]), "v"(N[14]), "v"(N[15]))
#define SCAN_STEP(W, A, Bv, KD, R, VV, YP, PREFETCH) { \
      float sa0, sa1, y0, y1; float N[16]; \
      asm volatile("s_nop 1" : "+v"(A), "+v"(W), "+v"(Bv), "+v"(KD), "+v"(R)); \
      SCAN_SA(sa0, sa1, A); \
      PREFETCH \
      const float sa = xrow_sum(sa0 + sa1); \
      SCAN_UP(0, W, Bv, KD, sa, VV); \
      SCAN_UP8(8, W, Bv, KD, sa, VV); \
      SCAN_Y(y0, y1, R); \
      YP = y0 + y1; \
      _Pragma("unroll") for (int j_ = 0; j_ < 16; ++j_) S[j_] = N[j_]; }
#define SCAN_LOAD(W, A, Bv, KD, R, VV, SIDX) { const float* np_ = bp + (SIDX) * 384; \
      W = np_[lane]; A = np_[64 + lane]; Bv = np_[128 + lane]; KD = np_[192 + lane]; R = np_[256 + lane]; VV = np_[vo]; }

__device__ __forceinline__ int scan_row(int gstep, int b, int d) {
  if (gstep < 256) { int pp = d ? 255 - gstep : gstep; return TL + b * 256 + pp; }
  int l = gstep - 256; if (d) l = 4095 - l;
  return b * 4096 + l;
}

__device__ __forceinline__ void phase_scan(const Ctx& p, char* smem, int idx, bool ctx_y, const int tid) {
  if (blockIdx.x >= 256) return;
  const int item = blockIdx.x;
  const int d = item & 1, h = (item >> 1) & 15, b = item >> 5;
  float* buf = (float*)smem;
  float* ybuf = buf + 2 * 32 * 384;
  const int lane = tid & 63, w = tid >> 6;
  const u16* rbuf = (const u16*)(p.ws + 1 * SLOT);
  const u16* kbuf = (const u16*)(p.ws + 2 * SLOT);
  const u16* vbuf = (const u16*)(p.ws + 5 * SLOT);
  u16* ybase = (u16*)(p.ws + (d == 0 ? 0 : 3 * SLOT));
  const u16* hw = (const u16*)(p.ws + OFF_HW);
  const u16* ha = (const u16*)(p.ws + OFF_HA);
  float* bsum = (float*)(p.ws + OFF_BSUM);
  const int ch = h * 64;

  uint4* Bl = (uint4*)(ybuf + 2 * 2048);
  float w0v[4], a0v[4];
  float kkw = 0.f, kaw = 0.f, rkw = 0.f;
#pragma unroll
  for (int cb = 0; cb < 4; ++cb) { w0v[cb] = 0.f; a0v[cb] = 0.f; }
  if (w >= 4) {
    const float* w2 = p.in[17] + (size_t)(idx * 2 + d) * 64 * 1024;
    const float* a2 = p.in[20] + (size_t)(idx * 2 + d) * 64 * 1024;
#pragma unroll
    for (int cb = 0; cb < 4; ++cb) {
      int col = ch + 16 * cb + (lane & 15);
      w0v[cb] = p.in[15][(idx * 2 + d) * 1024 + col];
      a0v[cb] = p.in[18][(idx * 2 + d) * 1024 + col];
    }
    {
      const int cb = w - 4;
      const int col = ch + 16 * cb + (lane & 15);
#pragma unroll
      for (int i = 0; i < 2; ++i) {
        const int k0 = 32 * i + 8 * (lane >> 4);
        float fw[8], fa[8];
#pragma unroll
        for (int q = 0; q < 8; ++q) { fw[q] = w2[(size_t)(k0 + q) * 1024 + col]; fa[q] = a2[(size_t)(k0 + q) * 1024 + col]; }
        Bl[((0 * 4 + cb) * 2 + i) * 64 + lane] = make_uint4(pack2(fw[0], fw[1]), pack2(fw[2], fw[3]), pack2(fw[4], fw[5]), pack2(fw[6], fw[7]));
        Bl[((1 * 4 + cb) * 2 + i) * 64 + lane] = make_uint4(pack2(fa[0], fa[1]), pack2(fa[2], fa[3]), pack2(fa[4], fa[5]), pack2(fa[6], fa[7]));
      }
    }
    kkw = p.in[26][idx * 1024 + ch + lane];
    kaw = p.in[27][idx * 1024 + ch + lane];
    rkw = p.in[28][idx * 1024 + ch + lane];
  }
  __syncthreads();
  float S[16];
#pragma unroll
  for (int j = 0; j < 16; ++j) S[j] = 0.f;

  for (int it = 0; it <= 137; ++it) {
    if (w >= 4) {
      const int jw = w - 4;
      if (it >= 2) {
        int cy = it - 2;
        const float* yb = ybuf + (cy & 1) * 2048;
        if (cy >= 8 || ctx_y) {
          const int yrow0 = scan_row(cy * 32 + jw * 8, b, d);
#pragma unroll
          for (int s8 = 0; s8 < 8; ++s8) {
            int s = jw * 8 + s8;
            int row = yrow0 + (d ? -s8 : s8);
            ybase[(unsigned)row * 1024u + (unsigned)(ch + lane)] = f2bf(yb[s * 64 + lane]);
          }
        }
      }
      if (it < 136) {
        float* bp = buf + (it & 1) * 12288;
        const int s0 = jw * 8;
        const int prow0 = scan_row(it * 32 + s0, b, d);
        int rowm = prow0 + (d ? -(lane & 7) : (lane & 7));
        bf16x8 Aw0 = *(const bf16x8*)(hw + ((unsigned)rowm * 128u + (unsigned)(d * 64 + 8 * (lane >> 4))));
        bf16x8 Aw1 = *(const bf16x8*)(hw + ((unsigned)rowm * 128u + (unsigned)(d * 64 + 32 + 8 * (lane >> 4))));
        bf16x8 Aa0 = *(const bf16x8*)(ha + ((unsigned)rowm * 128u + (unsigned)(d * 64 + 8 * (lane >> 4))));
        bf16x8 Aa1 = *(const bf16x8*)(ha + ((unsigned)rowm * 128u + (unsigned)(d * 64 + 32 + 8 * (lane >> 4))));
        float kx[8], rx[8], vx[8];
#pragma unroll
        for (int s8 = 0; s8 < 8; ++s8) {
          int row = prow0 + (d ? -s8 : s8);
          const unsigned o = (unsigned)row * 1024u + (unsigned)(ch + lane);
          kx[s8] = bf2f(kbuf[o]); rx[s8] = bf2f(rbuf[o]); vx[s8] = bf2f(vbuf[o]);
        }
        const bool hiL = lane >= 32;
#pragma unroll
        for (int cbp = 0; cbp < 2; ++cbp) {
          f32x4 cwl = {0.f, 0.f, 0.f, 0.f}, cal = {0.f, 0.f, 0.f, 0.f}, cwh = {0.f, 0.f, 0.f, 0.f}, cah = {0.f, 0.f, 0.f, 0.f};
          {
            const int cb = cbp;
            const bf16x8 bw0 = __builtin_bit_cast(bf16x8, Bl[((0 * 4 + cb) * 2 + 0) * 64 + lane]);
            const bf16x8 bw1 = __builtin_bit_cast(bf16x8, Bl[((0 * 4 + cb) * 2 + 1) * 64 + lane]);
            const bf16x8 ba0 = __builtin_bit_cast(bf16x8, Bl[((1 * 4 + cb) * 2 + 0) * 64 + lane]);
            const bf16x8 ba1 = __builtin_bit_cast(bf16x8, Bl[((1 * 4 + cb) * 2 + 1) * 64 + lane]);
            cwl = __builtin_amdgcn_mfma_f32_16x16x32_bf16(Aw0, bw0, cwl, 0, 0, 0);
            cwl = __builtin_amdgcn_mfma_f32_16x16x32_bf16(Aw1, bw1, cwl, 0, 0, 0);
            cal = __builtin_amdgcn_mfma_f32_16x16x32_bf16(Aa0, ba0, cal, 0, 0, 0);
            cal = __builtin_amdgcn_mfma_f32_16x16x32_bf16(Aa1, ba1, cal, 0, 0, 0);
          }
          {
            const int cb = cbp + 2;
            const bf16x8 bw0 = __builtin_bit_cast(bf16x8, Bl[((0 * 4 + cb) * 2 + 0) * 64 + lane]);
            const bf16x8 bw1 = __builtin_bit_cast(bf16x8, Bl[((0 * 4 + cb) * 2 + 1) * 64 + lane]);
            const bf16x8 ba0 = __builtin_bit_cast(bf16x8, Bl[((1 * 4 + cb) * 2 + 0) * 64 + lane]);
            const bf16x8 ba1 = __builtin_bit_cast(bf16x8, Bl[((1 * 4 + cb) * 2 + 1) * 64 + lane]);
            cwh = __builtin_amdgcn_mfma_f32_16x16x32_bf16(Aw0, bw0, cwh, 0, 0, 0);
            cwh = __builtin_amdgcn_mfma_f32_16x16x32_bf16(Aw1, bw1, cwh, 0, 0, 0);
            cah = __builtin_amdgcn_mfma_f32_16x16x32_bf16(Aa0, ba0, cah, 0, 0, 0);
            cah = __builtin_amdgcn_mfma_f32_16x16x32_bf16(Aa1, ba1, cah, 0, 0, 0);
          }
          const float w0s = hiL ? w0v[cbp + 2] : w0v[cbp];
          const float a0s = hiL ? a0v[cbp + 2] : a0v[cbp];
          const int colb = 16 * (cbp + (hiL ? 2 : 0)) + (lane & 15);
#pragma unroll
          for (int r = 0; r < 4; ++r) {
            const int m = 4 * ((lane >> 4) & 1) + r;
            const float xw = (hiL ? cwh[r] : cwl[r]) + w0s;
            const float xa = (hiL ? cah[r] : cal[r]) + a0s;
            const float dec = __expf(-0.60653066f * sigmoidf_(xw));
            const float ic = sigmoidf_(xa);
            bp[(s0 + m) * 384 + 0 * 64 + colb] = dec;
            bp[(s0 + m) * 384 + 1 * 64 + colb] = ic;
          }
        }
        float icv[8], kkr[8], kdv[8], X[16];
#pragma unroll
        for (int s8 = 0; s8 < 8; ++s8) {
          icv[s8] = bp[(s0 + s8) * 384 + 64 + lane];
          kkr[s8] = kx[s8] * kkw;
          kdv[s8] = kx[s8] * (1.f + (icv[s8] - 1.f) * kaw);
          X[2 * s8] = kkr[s8] * kkr[s8];
          X[2 * s8 + 1] = rx[s8] * kdv[s8] * rkw;
        }
        float Yv[8], Zv[4];
#pragma unroll
        for (int m = 0; m < 8; ++m) {
          auto pp = __builtin_amdgcn_permlane32_swap(__float_as_uint(X[2 * m]), __float_as_uint(X[2 * m + 1]), false, false);
          Yv[m] = __uint_as_float(pp[0]) + __uint_as_float(pp[1]);
        }
#pragma unroll
        for (int n = 0; n < 4; ++n) {
          auto pq = __builtin_amdgcn_permlane16_swap(__float_as_uint(Yv[2 * n]), __float_as_uint(Yv[2 * n + 1]), false, false);
          float z = __uint_as_float(pq[0]) + __uint_as_float(pq[1]);
          DPP_ROR_ADD(z, 8); DPP_ROR_ADD(z, 4); DPP_ROR_ADD(z, 2); DPP_ROR_ADD(z, 1);
          Zv[n] = z;
        }
        float bsv = 0.f;
#pragma unroll
        for (int s8 = 0; s8 < 8; ++s8) {
          const int s = s0 + s8;
          const int zi = __float_as_int(Zv[s8 >> 1]);
          const float ss = __int_as_float(__builtin_amdgcn_readlane(zi, (s8 & 1) * 16));
          const float bs = __int_as_float(__builtin_amdgcn_readlane(zi, 32 + (s8 & 1) * 16));
          const float ic = icv[s8];
          const float kk = kkr[s8] * rsqrtf(fmaxf(ss, 1e-24f));
          bsv = (lane == s8) ? bs : bsv;
          bp[s * 384 + 64 + lane] = -kk;
          bp[s * 384 + 128 + lane] = kk * ic;
          bp[s * 384 + 192 + lane] = kdv[s8];
          bp[s * 384 + 256 + lane] = rx[s8];
          bp[s * 384 + 320 + lane] = vx[s8];
        }
        if (lane < 8) bsum[(unsigned)(prow0 + (d ? -lane : lane)) * 32u + (unsigned)(h * 2 + d)] = bsv;
      }
    } else {
      if (it >= 1 && it <= 136) {
        const float* bp = buf + ((it - 1) & 1) * 12288;
        float* yb = ybuf + ((it - 1) & 1) * 2048;
        const int vo = 320 + 16 * w + (lane & 15);
        float W0, A0, B0, K0, R0, V0, W1, A1, B1, K1, R1, V1;
        SCAN_LOAD(W0, A0, B0, K0, R0, V0, 0)
#pragma unroll 1
        for (int s = 0; s < 32; s += 4) {
          float yp0, yp1, yp2, yp3;
          SCAN_STEP(W0, A0, B0, K0, R0, V0, yp0, SCAN_LOAD(W1, A1, B1, K1, R1, V1, s + 1))
          SCAN_STEP(W1, A1, B1, K1, R1, V1, yp1, SCAN_LOAD(W0, A0, B0, K0, R0, V0, s + 2))
          SCAN_STEP(W0, A0, B0, K0, R0, V0, yp2, SCAN_LOAD(W1, A1, B1, K1, R1, V1, s + 3))
          const int s4 = (s + 4 < 32) ? s + 4 : 31;
          SCAN_STEP(W1, A1, B1, K1, R1, V1, yp3, SCAN_LOAD(W0, A0, B0, K0, R0, V0, s4))
          {
            auto p01 = __builtin_amdgcn_permlane32_swap(__float_as_uint(yp0), __float_as_uint(yp1), false, false);
            auto p23 = __builtin_amdgcn_permlane32_swap(__float_as_uint(yp2), __float_as_uint(yp3), false, false);
            const float u01 = __uint_as_float(p01[0]) + __uint_as_float(p01[1]);
            const float u23 = __uint_as_float(p23[0]) + __uint_as_float(p23[1]);
            auto pz = __builtin_amdgcn_permlane16_swap(__float_as_uint(u01), __float_as_uint(u23), false, false);
            const float z = __uint_as_float(pz[0]) + __uint_as_float(pz[1]);
            const int rho = lane >> 4;
            const int smap = ((rho & 1) << 1) | (rho >> 1);
            yb[(s + smap) * 64 + 16 * w + (lane & 15)] = z;
          }
        }
      }
    }
    __syncthreads();
  }
}

__device__ __forceinline__ void phase_readout(const Ctx& p, int idx, int nrows, const int tid) {
  u16* y0 = (u16*)(p.ws);
  const u16* y1 = (const u16*)(p.ws + 3 * SLOT);
  const u16* vb = (const u16*)(p.ws + 5 * SLOT);
  const u16* gb = (const u16*)(p.ws + 4 * SLOT);
  const float* bsum = (const float*)(p.ws + OFF_BSUM);
  const float* lw = p.in[29] + idx * 1024;
  const float* lb = p.in[30] + idx * 1024;
  int lane = tid & 63, wv = tid >> 6;
  const int stride = gridDim.x * 8;
  for (int row0 = blockIdx.x * 8 + wv; row0 < nrows; row0 += 2 * stride) {
    const bool v1 = (row0 + stride) < nrows;
    uint4 ld[2][8];
    float bs0[2], bs1[2];
#pragma unroll
    for (int u = 0; u < 2; ++u) {
      const int row = row0 + u * stride;
      if (u == 0 || v1) {
        const size_t o = (size_t)row * 1024 + lane * 16;
        ld[u][0] = *(const uint4*)(y0 + o); ld[u][1] = *(const uint4*)(y0 + o + 8);
        ld[u][2] = *(const uint4*)(y1 + o); ld[u][3] = *(const uint4*)(y1 + o + 8);
        ld[u][4] = *(const uint4*)(vb + o); ld[u][5] = *(const uint4*)(vb + o + 8);
        ld[u][6] = *(const uint4*)(gb + o); ld[u][7] = *(const uint4*)(gb + o + 8);
        const int hh = lane >> 2;
        bs0[u] = bsum[(size_t)row * 32 + hh * 2]; bs1[u] = bsum[(size_t)row * 32 + hh * 2 + 1];
      }
    }
#pragma unroll
    for (int u = 0; u < 2; ++u) {
      const int row = row0 + u * stride;
      if (u == 0 || v1) {
        const size_t o = (size_t)row * 1024 + lane * 16;
        const uint4 a0 = ld[u][0], a1 = ld[u][1], b0 = ld[u][2], b1 = ld[u][3], v0 = ld[u][4], v1q = ld[u][5], g0 = ld[u][6], g1 = ld[u][7];
        unsigned ya[8] = {a0.x, a0.y, a0.z, a0.w, a1.x, a1.y, a1.z, a1.w};
        unsigned yb[8] = {b0.x, b0.y, b0.z, b0.w, b1.x, b1.y, b1.z, b1.w};
        unsigned vv[8] = {v0.x, v0.y, v0.z, v0.w, v1q.x, v1q.y, v1q.z, v1q.w};
        unsigned gg[8] = {g0.x, g0.y, g0.z, g0.w, g1.x, g1.y, g1.z, g1.w};
        float y[16];
        float sum = 0.f;
#pragma unroll
        for (int q = 0; q < 8; ++q) {
          y[2 * q] = bflo(ya[q]) + bflo(yb[q]);
          y[2 * q + 1] = bfhi(ya[q]) + bfhi(yb[q]);
          sum += y[2 * q] + y[2 * q + 1];
        }
        sum += __shfl_xor(sum, 1); sum += __shfl_xor(sum, 2);
        float mean = sum * (1.f / 64.f);
        float var = 0.f;
#pragma unroll
        for (int q = 0; q < 16; ++q) { float dd = y[q] - mean; var += dd * dd; }
        var += __shfl_xor(var, 1); var += __shfl_xor(var, 2);
        float rstd = rsqrtf(var * (1.f / 64.f) + 64e-5f);
        float bon = bs0[u] + bs1[u];
        unsigned ov[8];
#pragma unroll
        for (int q = 0; q < 8; ++q) {
          int c = lane * 16 + 2 * q;
          float o0 = ((y[2 * q] - mean) * rstd * lw[c] + lb[c] + bon * bflo(vv[q])) * bflo(gg[q]);
          float o1 = ((y[2 * q + 1] - mean) * rstd * lw[c + 1] + lb[c + 1] + bon * bfhi(vv[q])) * bfhi(gg[q]);
          ov[q] = pack2(o0, o1);
        }
        *(uint4*)(y0 + o) = make_uint4(ov[0], ov[1], ov[2], ov[3]);
        *(uint4*)(y0 + o + 8) = make_uint4(ov[4], ov[5], ov[6], ov[7]);
      }
    }
  }
}

__device__ __forceinline__ void phase_final(const Ctx& p, const int tid) {
  const float* gam = p.in[32];
  int lane = tid & 63, wv = tid >> 6;
  for (int row = blockIdx.x * 8 + wv; row < TL; row += gridDim.x * 8) {
    float* src = p.out + (size_t)row * 1024;
    float4 x[4];
    float ss = 0.f;
#pragma unroll
    for (int q = 0; q < 4; ++q) {
      x[q] = *(const float4*)(src + q * 256 + lane * 4);
      {
        uint2 dv = *(const uint2*)((const u16*)p.ws + (size_t)row * 1024 + q * 256 + lane * 4);
        x[q].x += bflo(dv.x); x[q].y += bfhi(dv.x); x[q].z += bflo(dv.y); x[q].w += bfhi(dv.y);
      }
      ss += x[q].x * x[q].x + x[q].y * x[q].y + x[q].z * x[q].z + x[q].w * x[q].w;
    }
    ss = wave_sum(ss);
    float rstd = rsqrtf(ss * (1.f / 1024.f) + 1e-6f);
#pragma unroll
    for (int q = 0; q < 4; ++q) {
      int col = q * 256 + lane * 4;
      float4 g = *(const float4*)(gam + col);
      float4 o = make_float4(x[q].x * rstd * g.x, x[q].y * rstd * g.y, x[q].z * rstd * g.z, x[q].w * rstd * g.w);
#if PROBE_STEPS
      { long long tt = *(const long long*)(p.ws + OFF_PROBE); int n2 = (int)(tt / 100); if (n2 > 30000) n2 = 30000;
        if (q == 0 && lane == 0 && row < n2) o.x += 0.125f; }
#endif
      *(float4*)(src + col) = o;
    }
  }
}

__device__ __forceinline__ void gemm_run_plain(const Ctx& p, char* smem, const int kind, const int layer, const int total, const int vbid, int tid) {
  u16* As = (u16*)smem;
  u16* Bs = As + 2 * 256 * 72;
  int ntile = vbid;
  bool first = true;
  GD g; LdSt Lc;
  Stg R0, R1;
  Frg F0, F1;
  for (;;) {
    const bool has_next = ntile < total;
    asm volatile("" : "+v"(tid));
    const int lane = tid & 63, w = tid >> 6, wm = w >> 1, wn = w & 1;
    const int lr = tid >> 3, lc = (tid & 7) * 8;
    const int sto = lr * 72 + lc;
    GD gn; make_gd(p, kind, layer, has_next ? ntile : total - 1, gn);
    LdSt Ln; ld_setup(Ln, gn, lr, lc);
    __builtin_amdgcn_s_waitcnt(0xC07F);
    if (first) {
      if (!has_next) break;
      g = gn; Lc = Ln;
      GEMM_LOADX(R0, Lc, 0)
      GEMM_LOADX(R1, Lc, 1)
      GEMM_STORE(R0, 0)
      __syncthreads();
      GEMM_READF(F0, 0, 0)
      first = false; ntile += gridDim.x;
      continue;
    }
    f32x16 acc[2][2];
#pragma unroll
    for (int i = 0; i < 2; ++i)
#pragma unroll
      for (int j = 0; j < 2; ++j)
#pragma unroll
        for (int r = 0; r < 16; ++r) acc[i][j][r] = 0.f;
    const int nk = Lc.nk;
    if (nk > 2) {
      GEMM_KSTEP(0, R0, Lc, 2, R1)
      GEMM_KSTEP(1, R1, Lc, 3, R0)
    }
    __builtin_amdgcn_s_waitcnt(0x0070);
    for (int kt = 2; kt + 2 < nk; kt += 2) {
      GEMM_KSTEP(0, R0, Lc, kt + 2, R1)
      GEMM_KSTEP(1, R1, Lc, kt + 3, R0)
    }
    GEMM_KSTEP(0, R0, Ln, 0, R1)
    GEMM_KSTEP_LAST(1, R1, Ln, 1, R0)
    gemm_epilogue(p, g, acc, tid);
    if (!has_next) break;
    GEMM_READF(F0, 0, 0)
    g = gn; Lc = Ln; ntile += gridDim.x;
  }
  __syncthreads();
}

__global__ void __launch_bounds__(512) fwd_megakernel(Params p0) {
  Ctx p; p.in = p0.in; p.out = p0.out; p.ws = p0.ws;
  extern __shared__ __attribute__((aligned(16))) char smem[];
  cg::grid_group grid = cg::this_grid();

  int tid0 = threadIdx.x;
  asm volatile("" : "+v"(tid0));
  phase_mod(p, smem, tid0);
  grid.sync();
  for (int ph = 0; ph < 40; ++ph) {
    const int layer = ph / 10, step = ph % 10;
    const int idx = layer >> 1;
    const bool rw = (layer & 1) == 0;
    const bool ctx_in = layer <= 2, ctx_out = layer < 2;
    const int rows_in = ctx_in ? T : TL, rows_out = ctx_out ? T : TL;
    int gk = -1;
    int tid = threadIdx.x;
    Ctx q; q.in = p0.in;
    {
      unsigned long long w_ = (unsigned long long)p0.ws, o_ = (unsigned long long)p0.out;
      unsigned wl = __builtin_amdgcn_readfirstlane((unsigned)w_), wh = __builtin_amdgcn_readfirstlane((unsigned)(w_ >> 32));
      unsigned ol = __builtin_amdgcn_readfirstlane((unsigned)o_), oh = __builtin_amdgcn_readfirstlane((unsigned)(o_ >> 32));
      asm volatile("" : "+s"(wl), "+s"(wh), "+s"(ol), "+s"(oh));
      q.ws = (char*)(((unsigned long long)wh << 32) | wl);
      q.out = (float*)(((unsigned long long)oh << 32) | ol);
    }
#if PROBE_STEPS
    if (blockIdx.x == 0 && tid == 0) ((long long*)(q.ws + OFF_PROBE))[1] = wall_clock64();
#endif
#define OPAQUE_TID() asm volatile("" : "+v"(tid))
    if (step == 0 || step == 7) {
      OPAQUE_TID();
      {
        const u16* dl = (step == 7) ? (const u16*)(q.ws + (rw ? 1 : 2) * SLOT) : ((ph == 0) ? (const u16*)nullptr : (const u16*)q.ws);
        const int drows = (step == 7) ? rows_out : ((layer - 1) < 2 ? T : TL);
        prep_rows(q, layer, step == 0 ? 0 : 1, step == 0 ? rows_in : rows_out, ph == 0, dl, drows, tid);
      }
      if (step == 0) {
        OPAQUE_TID();
        convert_weights(q, smem, layer, tid);
        if (!rw) { OPAQUE_TID(); fourier_tables(q, ctx_in, tid); }
      }
    } else if (step == 1) gk = rw ? G_RB : G_FB;
    else if (step == 2) gk = rw ? G_RC : G_F1;
    else if (step == 3) { if (rw && idx != 1) continue; gk = rw ? G_RC2 : G_F2; }
    else if (step == 4) { if (!rw) continue; OPAQUE_TID(); phase_scan(q, smem, idx, ctx_out, tid); }
    else if (step == 5) { if (!rw) continue; OPAQUE_TID(); phase_readout(q, idx, rows_out, tid); }
    else if (step == 6) gk = rw ? G_WO_R : G_WO_F;
    else if (step == 8) gk = G_MLP1;
    else gk = G_MLP2;
    if (gk >= 0) {
      const int total = gemm_total(gk, layer);
      const int vbid = (int)(blockIdx.x & 7) * (int)(gridDim.x >> 3) + (int)(blockIdx.x >> 3);
      if (gk == G_RB || gk == G_RC2) {
        for (int tile = vbid; tile < total; tile += gridDim.x) {
          GD g;
          make_gd(q, gk, layer, tile, g);
          OPAQUE_TID();
          gemm_tile_mix(q, smem, g, tid);
        }
      } else {
        gemm_run_plain(q, smem, gk, layer, total, vbid, tid);
      }
    }
    grid.sync();
#if PROBE_STEPS
    if (blockIdx.x == 0 && threadIdx.x == 0) {
      long long* pr = (long long*)(p.ws + OFF_PROBE);
      if (ph == 0) pr[0] = 0;
      if (((PROBE_STEPS >> step) & 1) && ((PROBE_LAYERS >> layer) & 1)) pr[0] += wall_clock64() - pr[1];
    }
#endif
  }
#if PROBE_STEPS
  grid.sync();
#endif
  int tid1 = threadIdx.x;
  asm volatile("" : "+v"(tid1));
  phase_final(p, tid1);
}

extern "C" void kernel_launch(void* const* d_in, const int* in_sizes, int n_in,
                              void* d_out, int out_size, void* d_ws, size_t ws_size,
                              hipStream_t stream) {
  static int grid_blocks = 0;
  if (!grid_blocks) {
    int dev = 0, cus = 0, per_cu = 0;
    (void)hipGetDevice(&dev);
    (void)hipDeviceGetAttribute(&cus, hipDeviceAttributeMultiprocessorCount, dev);
    if (hipFuncSetAttribute((const void*)fwd_megakernel, hipFuncAttributeMaxDynamicSharedMemorySize, LDS_BYTES) != hipSuccess)
      fprintf(stderr, "hipFuncSetAttribute failed\n");
    (void)hipOccupancyMaxActiveBlocksPerMultiprocessor(&per_cu, (const void*)fwd_megakernel, 512, LDS_BYTES);
    if (per_cu < 1) { fprintf(stderr, "occupancy query returned %d\n", per_cu); per_cu = 1; }
    (void)hipGetLastError();
    grid_blocks = cus;
    if (ws_size < WS_END) fprintf(stderr, "workspace too small: %zu < %zu\n", ws_size, (size_t)WS_END);
  }
  Params p{};
  for (int i = 0; i < 33; ++i) p.in[i] = (const float*)d_in[i];
  p.out = (float*)d_out;
  p.ws = (char*)d_ws;
  void* args[] = {&p};
  hipError_t e = hipLaunchCooperativeKernel((const void*)fwd_megakernel, dim3(grid_blocks), dim3(512), args, LDS_BYTES, stream);
  if (e != hipSuccess) fprintf(stderr, "cooperative launch failed: %s (grid %d)\n", hipGetErrorString(e), grid_blocks);
}
```

```cpp
#include <hip/hip_runtime.h>
#include <hip/hip_cooperative_groups.h>
#include <cstdio>
namespace cg = cooperative_groups;

typedef unsigned short u16;
typedef __attribute__((ext_vector_type(8))) short bf16x8;
typedef __attribute__((ext_vector_type(16))) float f32x16;
typedef __attribute__((ext_vector_type(4))) float f32x4;
typedef __attribute__((ext_vector_type(2))) float f32x2;
typedef __attribute__((ext_vector_type(2))) __bf16 bf16x2v;

constexpr int TL = 8 * 4096, TC = 8 * 256, T = TL + TC;
constexpr size_t SLOT = (size_t)T * 1024 * 2;
constexpr size_t OFF_CTXRES = 6 * SLOT;
constexpr size_t OFF_MOD = OFF_CTXRES + (size_t)TC * 1024 * 4;
constexpr size_t OFF_HW = OFF_MOD + 4 * 9 * 6144 * 4;
constexpr size_t OFF_HA = OFF_HW + (size_t)T * 128 * 2;
constexpr size_t OFF_HG = OFF_HA + (size_t)T * 128 * 2;
constexpr size_t OFF_HV = OFF_HG + (size_t)T * 128 * 2;
constexpr size_t OFF_BSUM = OFF_HV + (size_t)T * 128 * 2;
constexpr size_t OFF_WMIX = OFF_BSUM + (size_t)T * 32 * 4;
constexpr size_t M1 = 1048576;
constexpr size_t WMIX_ELEMS = 4 * M1 + 6 * 131072;
constexpr size_t OFF_WMLP = OFF_WMIX + WMIX_ELEMS * 2;
constexpr size_t WS_END = OFF_WMLP + 2 * 4 * M1 * 2;
constexpr int LDS_BYTES = 131072;
#ifndef PROBE_STEPS
#define PROBE_STEPS 0
#endif
#ifndef PROBE_LAYERS
#define PROBE_LAYERS 15
#endif
constexpr size_t OFF_PROBE = WS_END;

struct Params {
  const float* in[33];
  float* out;
  char* ws;
};
struct Ctx { const float* const* in; float* out; char* ws; };

__device__ __forceinline__ unsigned pack2(float a, float b) {
  f32x2 v = {a, b};
  bf16x2v r = __builtin_convertvector(v, bf16x2v);
  return __builtin_bit_cast(unsigned, r);
}
__device__ __forceinline__ u16 f2bf(float a) { return (u16)(pack2(a, 0.f) & 0xffffu); }
__device__ __forceinline__ float bflo(unsigned u) { return __uint_as_float(u << 16); }
__device__ __forceinline__ float bfhi(unsigned u) { return __uint_as_float(u & 0xffff0000u); }
__device__ __forceinline__ float bf2f(u16 h) { return __uint_as_float(((unsigned)h) << 16); }
typedef __attribute__((ext_vector_type(4))) float nf4;
typedef __attribute__((ext_vector_type(2))) unsigned nu2;
__device__ __forceinline__ float4 ntload4(const float* ptr) { nf4 v = __builtin_nontemporal_load((const nf4*)ptr); return make_float4(v[0], v[1], v[2], v[3]); }
__device__ __forceinline__ uint2 ntload2(const u16* ptr) { nu2 v = __builtin_nontemporal_load((const nu2*)ptr); return make_uint2(v[0], v[1]); }
__device__ __forceinline__ void ntstore4(float* ptr, float4 x) { nf4 v = {x.x, x.y, x.z, x.w}; __builtin_nontemporal_store(v, (nf4*)ptr); }
__device__ __forceinline__ float wave_sum(float v) {
#pragma unroll
  for (int o = 32; o > 0; o >>= 1) v += __shfl_xor(v, o);
  return v;
}
#define DPP_ROR_ADD(x, n) x += __builtin_bit_cast(float, __builtin_amdgcn_update_dpp(0, __builtin_bit_cast(int, x), 0x120 + (n), 0xf, 0xf, true))
__device__ __forceinline__ float sigmoidf_(float x) { return __builtin_amdgcn_rcpf(1.f + __expf(-x)); }
__device__ __forceinline__ float xrow_sum(float x) {
  unsigned u = __float_as_uint(x);
  auto r = __builtin_amdgcn_permlane32_swap(u, u, false, false);
  float s = __uint_as_float(r[0]) + __uint_as_float(r[1]);
  u = __float_as_uint(s);
  auto r2 = __builtin_amdgcn_permlane16_swap(u, u, false, false);
  return __uint_as_float(r2[0]) + __uint_as_float(r2[1]);
}

__device__ __forceinline__ float wave_sum_fast(float x) {
  DPP_ROR_ADD(x, 8); DPP_ROR_ADD(x, 4); DPP_ROR_ADD(x, 2); DPP_ROR_ADD(x, 1);
  return xrow_sum(x);
}

__device__ __forceinline__ void phase_mod(const Ctx& p, char* smem, const int tid) {
  float* sv = (float*)smem;
  float* red = sv + 9 * 1024;
  const float* c = p.in[1];
  const float* cc = p.in[3];
  const float* mod_w = p.in[6];
  const float* mod_b = p.in[7];
  float* mod = (float*)(p.ws + OFF_MOD);
  for (int e = tid; e < 9 * 1024; e += 512) {
    int j = e >> 10, k = e & 1023;
    float v = (j < 8) ? c[j * 1024 + k] : cc[k];
    sv[e] = v / (1.f + expf(-v));
  }
  __syncthreads();
  for (int item = blockIdx.x; item < 384; item += gridDim.x) {
    int layer = item / 96, c0 = (item % 96) * 64;
    int kq = tid >> 6, col = tid & 63;
    const float* w = mod_w + (size_t)layer * 1024 * 6144 + c0 + col;
    float acc[9];
#pragma unroll
    for (int j = 0; j < 9; ++j) acc[j] = 0.f;
#pragma unroll 8
    for (int k = kq * 128; k < kq * 128 + 128; ++k) {
      float wv = w[(size_t)k * 6144];
#pragma unroll
      for (int j = 0; j < 9; ++j) acc[j] += sv[j * 1024 + k] * wv;
    }
#pragma unroll
    for (int j = 0; j < 9; ++j) red[(kq * 9 + j) * 64 + col] = acc[j];
    __syncthreads();
    for (int e = tid; e < 9 * 64; e += 512) {
      int j = e >> 6, cx = e & 63;
      float s = 0.f;
#pragma unroll
      for (int q = 0; q < 8; ++q) s += red[(q * 9 + j) * 64 + cx];
      s += mod_b[layer * 6144 + c0 + cx];
      mod[(layer * 9 + j) * 6144 + c0 + cx] = s;
    }
    __syncthreads();
  }
}

__device__ __forceinline__ void prep_rows(const Ctx& p, int layer, int which, int nrows, bool from_input, const u16* delta, int drows, const int tid) {
  const float* gam = (which == 0 ? p.in[4] : p.in[5]) + layer * 1024;
  const float* mod = (const float*)(p.ws + OFF_MOD);
  float* ctxres = (float*)(p.ws + OFF_CTXRES);
  u16* H = (u16*)(p.ws);
  int lane = tid & 63, wv = tid >> 6;
  const int stride = gridDim.x * 8;
  for (int row0 = blockIdx.x * 8 + wv; row0 < nrows; row0 += 2 * stride) {
    float4 x[2][4];
    uint2 dv[2][4];
    const bool v1 = (row0 + stride) < nrows;
#pragma unroll
    for (int u = 0; u < 2; ++u) {
      const int row = row0 + u * stride;
      if (u == 0 || v1) {
        const float* src = (row < TL) ? ((from_input ? p.in[0] : p.out) + (size_t)row * 1024) : ((from_input ? p.in[2] : ctxres) + (size_t)(row - TL) * 1024);
        const bool upd = (delta != nullptr) && (row < drows);
#pragma unroll
        for (int q = 0; q < 4; ++q) {
          x[u][q] = ntload4(src + q * 256 + lane * 4);
          dv[u][q] = make_uint2(0, 0);
          if (upd) dv[u][q] = ntload2(delta + (size_t)row * 1024 + q * 256 + lane * 4);
        }
      }
    }
#pragma unroll
    for (int u = 0; u < 2; ++u) {
      const int row = row0 + u * stride;
      if (u == 0 || v1) {
        float* dst = (row < TL) ? (p.out + (size_t)row * 1024) : (ctxres + (size_t)(row - TL) * 1024);
        const bool upd = (delta != nullptr) && (row < drows);
        float ss = 0.f;
#pragma unroll
        for (int q = 0; q < 4; ++q) {
          x[u][q].x += bflo(dv[u][q].x); x[u][q].y += bfhi(dv[u][q].x); x[u][q].z += bflo(dv[u][q].y); x[u][q].w += bfhi(dv[u][q].y);
          ss += x[u][q].x * x[u][q].x + x[u][q].y * x[u][q].y + x[u][q].z * x[u][q].z + x[u][q].w * x[u][q].w;
        }
        ss = wave_sum(ss);
        float rstd = rsqrtf(ss * (1.f / 1024.f) + 1e-6f);
        int j = (row < TL) ? (row >> 12) : 8;
        const float* mp = mod + (size_t)(layer * 9 + j) * 6144 + which * 3072;
#pragma unroll
        for (int q = 0; q < 4; ++q) {
          int col = q * 256 + lane * 4;
          if (from_input || upd) ntstore4(dst + col, x[u][q]);
          float4 g = *(const float4*)(gam + col);
          float4 sh = *(const float4*)(mp + col);
          float4 sc = *(const float4*)(mp + 1024 + col);
          float h0 = x[u][q].x * rstd * g.x * (1.f + sc.x) + sh.x;
          float h1 = x[u][q].y * rstd * g.y * (1.f + sc.y) + sh.y;
          float h2 = x[u][q].z * rstd * g.z * (1.f + sc.z) + sh.z;
          float h3 = x[u][q].w * rstd * g.w * (1.f + sc.w) + sh.w;
          uint2 o; o.x = pack2(h0, h1); o.y = pack2(h2, h3);
          *(uint2*)(H + (size_t)row * 1024 + col) = o;
        }
      }
    }
  }
}

struct CJ { const float* src; int K, N, ld; u16* dst; int ldd, Kp, Np; };
__device__ __forceinline__ void get_cj(const Ctx& p, int layer, int j, CJ& c) {
  const int idx = layer >> 1;
  u16* wm = (u16*)(p.ws + OFF_WMIX);
  u16* wl = (u16*)(p.ws + OFF_WMLP);
  c.K = 1024; c.N = 1024; c.ld = 1024; c.ldd = 1024; c.Kp = 1024; c.Np = 1024; c.src = nullptr; c.dst = nullptr;
  if (j == 0) { c.src = p.in[8] + (size_t)layer * 4 * M1; c.N = 4096; c.ld = 4096; c.dst = wl; c.Np = 4096; }
  else if (j == 1) { c.src = p.in[9] + (size_t)layer * 4 * M1; c.K = 4096; c.dst = wl + 4 * M1; c.ldd = 4096; c.Kp = 4096; }
  else if (layer & 1) { c.src = p.in[31] + (size_t)idx * M1; c.dst = wm; }
  else if (j < 6) { c.src = p.in[11 + (j - 2)] + (size_t)idx * M1; c.dst = wm + (size_t)(j - 2) * M1; }
  else if (j < 10) {
    int d = j & 1; bool isa = j >= 8;
    c.src = p.in[isa ? 19 : 16] + (size_t)(idx * 2 + d) * 65536; c.N = 64; c.ld = 64; c.Np = 64;
    c.dst = wm + 4 * M1 + (isa ? 131072 : 0) + d * 65536;
  }
  else if (j == 10) { c.src = p.in[24] + (size_t)idx * 131072; c.N = 128; c.ld = 128; c.Np = 128; c.dst = wm + 4 * M1 + 2 * 131072; }
  else if (j == 11) { c.src = p.in[25] + (size_t)idx * 131072; c.K = 128; c.Kp = 128; c.ldd = 128; c.dst = wm + 4 * M1 + 4 * 131072; }
  else if (j == 12) { c.src = p.in[22]; c.N = 32; c.ld = 32; c.Np = 128; c.dst = wm + 4 * M1 + 3 * 131072; }
  else { c.src = p.in[23]; c.K = 32; c.Kp = 128; c.ldd = 128; c.dst = wm + 4 * M1 + 5 * 131072; }
}

__device__ __forceinline__ void convert_weights(const Ctx& p, char* smem, int layer, const int tid) {
  float* tile = (float*)smem;
  const int nj = (layer & 1) ? 3 : ((layer >> 1) == 1 ? 14 : 12);
  int rot = 0;
  for (int j = 0; j < nj; ++j) {
    CJ c; get_cj(p, layer, j, c);
    const int nnt = c.Np >> 6, ntiles = (c.Kp >> 6) * nnt;
    int start = (int)blockIdx.x - rot; if (start < 0) start += gridDim.x;
    for (int t = start; t < ntiles; t += gridDim.x) {
      int k0 = (t / nnt) << 6, n0 = (t % nnt) << 6;
      int r = tid >> 4, c4 = (tid & 15) * 4;
#pragma unroll
      for (int hh = 0; hh < 2; ++hh) {
        int rr = r + hh * 32;
        float4 v = make_float4(0.f, 0.f, 0.f, 0.f);
        if (k0 + rr < c.K && n0 + c4 < c.N) v = *(const float4*)(c.src + (size_t)(k0 + rr) * c.ld + n0 + c4);
        tile[(c4 + 0) * 65 + rr] = v.x; tile[(c4 + 1) * 65 + rr] = v.y; tile[(c4 + 2) * 65 + rr] = v.z; tile[(c4 + 3) * 65 + rr] = v.w;
      }
      __syncthreads();
      int n = tid >> 3, kc = (tid & 7) * 8;
      const float* tp = tile + n * 65 + kc;
      uint4 o;
      o.x = pack2(tp[0], tp[1]); o.y = pack2(tp[2], tp[3]); o.z = pack2(tp[4], tp[5]); o.w = pack2(tp[6], tp[7]);
      *(uint4*)(c.dst + (size_t)(n0 + n) * c.ldd + k0 + kc) = o;
      __syncthreads();
    }
    rot = (rot + ntiles) % (int)gridDim.x;
  }
}

__device__ __forceinline__ void fourier_tables(const Ctx& p, bool with_ctx, const int tid) {
  u16* wm = (u16*)(p.ws + OFF_WMIX);
  u16* dftT = wm + M1;
  u16* m1t = dftT + 131072;
  u16* m2t = m1t + 16384;
  u16* dftC = m2t + 8192;
  float2* tw = (float2*)(dftC + 131072);
  size_t gtid = (size_t)blockIdx.x * 512 + tid, gsz = (size_t)gridDim.x * 512;
  for (size_t e = gtid; e < 512 * 256 / 8; e += gsz) {
    int r = (int)(e >> 5), c0 = (int)(e & 31) * 8;
    int ri = r >> 8, m = r & 255;
    float v[8];
#pragma unroll
    for (int q = 0; q < 8; ++q) {
      int ph = (m * (c0 + q)) & 255;
      float s, c; sincospif((float)ph * (1.f / 128.f), &s, &c);
      v[q] = (ri ? s : c) * (1.f / 16.f);
    }
    uint4 o; o.x = pack2(v[0], v[1]); o.y = pack2(v[2], v[3]); o.z = pack2(v[4], v[5]); o.w = pack2(v[6], v[7]);
    *(uint4*)(dftT + (size_t)r * 256 + c0) = o;
  }
  for (size_t e = gtid; e < 128 * 128; e += gsz) {
    int rho = (int)(e >> 7), kap = (int)(e & 127);
    int qq = rho >> 5, part = qq & 1, k1 = (qq >> 1) * 32 + (rho & 31);
    int ri = kap >> 6, l1 = kap & 63;
    int ph = (k1 * l1) & 63;
    float s, c; sincospif((float)ph * (1.f / 32.f), &s, &c);
    float v = (part == 0) ? (ri == 0 ? c : -s) : (ri == 0 ? -s : -c);
    m1t[e] = f2bf(v);
  }
  for (size_t e = gtid; e < 64 * 128; e += gsz) {
    int k2 = (int)(e >> 7), kap = (int)(e & 127);
    int ri = kap >> 6, l2 = kap & 63;
    int ph = (k2 * l2) & 63;
    float s, c; sincospif((float)ph * (1.f / 32.f), &s, &c);
    m2t[e] = f2bf((ri == 0 ? c : s) * (1.f / 64.f));
  }
  for (size_t e = gtid; e < 64 * 64; e += gsz) {
    int k1 = (int)(e >> 6), l2 = (int)(e & 63);
    float s, c; sincospif((float)(k1 * l2) * (1.f / 2048.f), &s, &c);
    tw[e] = make_float2(c, s);
  }
  if (with_ctx) {
    for (size_t e = gtid; e < 256 * 512 / 8; e += gsz) {
      int k = (int)(e >> 6), kap = (int)(e & 63) * 8;
      int ri = kap >> 8, l0 = kap & 255;
      float v[8];
#pragma unroll
      for (int q = 0; q < 8; ++q) {
        int ph = (k * (l0 + q)) & 255;
        float s, c; sincospif((float)ph * (1.f / 128.f), &s, &c);
        v[q] = (ri ? -s : c) * (1.f / 16.f);
      }
      uint4 o; o.x = pack2(v[0], v[1]); o.y = pack2(v[2], v[3]); o.z = pack2(v[4], v[5]); o.w = pack2(v[6], v[7]);
      *(uint4*)(dftC + (size_t)k * 512 + kap) = o;
    }
  }
}

struct GD {
  const u16* A; long lda; int a_rowmask; int a_mode; const float* mu;
  const u16* B; long b_rs_hi, b_rs_lo; int b_kshift; long b_kstride; int b_perm; int a_kshift; long a_kstride;
  int K, m0, n0;
  int ep; u16* out; long ldo; u16* out2; const float* e0; const u16* gsrc;
};
__device__ __forceinline__ void gd_plainA(GD& g, const u16* A, long lda) { g.A = A; g.lda = lda; g.a_rowmask = 0x7fffffff; g.a_mode = 0; g.mu = nullptr; g.a_kshift = 30; g.a_kstride = 0; }
__device__ __forceinline__ void gd_mixA(GD& g, const u16* H, const float* mu) { g.A = H; g.lda = 1024; g.a_rowmask = 0x7fffffff; g.a_mode = 1; g.mu = mu; g.a_kshift = 30; g.a_kstride = 0; }
__device__ __forceinline__ void gd_plainB(GD& g, const u16* B, long ldb) { g.B = B; g.b_rs_hi = 256 * ldb; g.b_rs_lo = ldb; g.b_kshift = 30; g.b_kstride = 0; g.b_perm = 0; }

__device__ __forceinline__ unsigned mix2(unsigned h, unsigned s, float m0, float m1) {
  float h0 = bflo(h), h1 = bfhi(h), s0 = bflo(s), s1 = bfhi(s);
  return pack2(h0 + (s0 - h0) * m0, h1 + (s1 - h1) * m1);
}

#define EPI_LOOP(LD, BODY) \
  _Pragma("unroll") for (int i = 0; i < 2; ++i) { _Pragma("unroll") for (int j = 0; j < 2; ++j) { \
    _Pragma("unroll") for (int r = 0; r < 16; ++r) { \
      const int off = (32 * i + (r & 3) + 8 * (r >> 2)) * (LD) + 32 * j; \
      const float v = acc[i][j][r]; BODY } \
    asm volatile("" ::: "memory"); } }

struct Stg { uint4 a0, a1, a2, a3, b0, b1; };

__device__ __forceinline__ int mix_nb(int t, int k) {
  int nb = -1;
  if (t < TL) {
    int l = t & 4095, c = l & 63, r = l >> 6, qq = k >> 8;
    if (qq == 0) nb = (c > 0) ? t - 1 : -1;
    else if (qq == 1) nb = (c < 63) ? t + 1 : -1;
    else if (qq == 2) nb = (r > 0) ? t - 64 : -1;
    else nb = (r < 63) ? t + 64 : -1;
  } else {
    int pp = (t - TL) & 255;
    if (k < 512) nb = (pp > 0) ? t - 1 : -1; else nb = (pp < 255) ? t + 1 : -1;
  }
  return nb;
}
__device__ __forceinline__ uint4 ld16(const u16* ptr) { return *(const uint4*)ptr; }
__device__ __forceinline__ uint4 mix4(uint4 h, uint4 s, float4 m0, float4 m1) {
  uint4 o;
  o.x = mix2(h.x, s.x, m0.x, m0.y); o.y = mix2(h.y, s.y, m0.z, m0.w);
  o.z = mix2(h.z, s.z, m1.x, m1.y); o.w = mix2(h.w, s.w, m1.z, m1.w);
  return o;
}

#define GEMM_HALF(KH) { \
    bf16x8 fa0[2], fa1[2], fb0[2], fb1[2]; \
    _Pragma("unroll") for (int kk = 0; kk < 2; ++kk) { \
      fa0[kk] = *(const bf16x8*)(ab + ((KH) * 2 + kk) * 16); \
      fb0[kk] = *(const bf16x8*)(bb + ((KH) * 2 + kk) * 16); \
      fa1[kk] = *(const bf16x8*)(ab + 32 * 72 + ((KH) * 2 + kk) * 16); \
      fb1[kk] = *(const bf16x8*)(bb + 32 * 72 + ((KH) * 2 + kk) * 16); } \
    __builtin_amdgcn_sched_barrier(0); \
    _Pragma("unroll") for (int kk = 0; kk < 2; ++kk) { \
      acc[0][0] = __builtin_amdgcn_mfma_f32_32x32x16_bf16(fa0[kk], fb0[kk], acc[0][0], 0, 0, 0); \
      acc[0][1] = __builtin_amdgcn_mfma_f32_32x32x16_bf16(fa0[kk], fb1[kk], acc[0][1], 0, 0, 0); \
      acc[1][0] = __builtin_amdgcn_mfma_f32_32x32x16_bf16(fa1[kk], fb0[kk], acc[1][0], 0, 0, 0); \
      acc[1][1] = __builtin_amdgcn_mfma_f32_32x32x16_bf16(fa1[kk], fb1[kk], acc[1][1], 0, 0, 0); \
    } \
    __builtin_amdgcn_sched_barrier(0); }
#define GEMM_COMPUTE(BUF) { \
    const u16* ab = As + (BUF) * 256 * 72 + (64 * wm + (lane & 31)) * 72 + 8 * (lane >> 5); \
    const u16* bb = Bs + (BUF) * 128 * 72 + (64 * wn + (lane & 31)) * 72 + 8 * (lane >> 5); \
    __builtin_amdgcn_sched_barrier(0); \
    GEMM_HALF(0) GEMM_HALF(1) }
struct Frg { bf16x8 a00, a01, a10, a11, b00, b01, b10, b11; };
#define GEMM_READF(F, BUF, KH) { \
    const u16* ab_ = As + (BUF) * 256 * 72 + (64 * wm + (lane & 31)) * 72 + 8 * (lane >> 5) + (KH) * 32; \
    const u16* bb_ = Bs + (BUF) * 128 * 72 + (64 * wn + (lane & 31)) * 72 + 8 * (lane >> 5) + (KH) * 32; \
    F.a00 = *(const bf16x8*)(ab_);           F.a01 = *(const bf16x8*)(ab_ + 16); \
    F.b00 = *(const bf16x8*)(bb_);           F.b01 = *(const bf16x8*)(bb_ + 16); \
    F.a10 = *(const bf16x8*)(ab_ + 32 * 72); F.a11 = *(const bf16x8*)(ab_ + 32 * 72 + 16); \
    F.b10 = *(const bf16x8*)(bb_ + 32 * 72); F.b11 = *(const bf16x8*)(bb_ + 32 * 72 + 16); }
#define GEMM_MFMA8(F) { \
    acc[0][0] = __builtin_amdgcn_mfma_f32_32x32x16_bf16(F.a00, F.b00, acc[0][0], 0, 0, 0); \
    acc[0][1] = __builtin_amdgcn_mfma_f32_32x32x16_bf16(F.a00, F.b10, acc[0][1], 0, 0, 0); \
    acc[1][0] = __builtin_amdgcn_mfma_f32_32x32x16_bf16(F.a10, F.b00, acc[1][0], 0, 0, 0); \
    acc[1][1] = __builtin_amdgcn_mfma_f32_32x32x16_bf16(F.a10, F.b10, acc[1][1], 0, 0, 0); \
    acc[0][0] = __builtin_amdgcn_mfma_f32_32x32x16_bf16(F.a01, F.b01, acc[0][0], 0, 0, 0); \
    acc[0][1] = __builtin_amdgcn_mfma_f32_32x32x16_bf16(F.a01, F.b11, acc[0][1], 0, 0, 0); \
    acc[1][0] = __builtin_amdgcn_mfma_f32_32x32x16_bf16(F.a11, F.b01, acc[1][0], 0, 0, 0); \
    acc[1][1] = __builtin_amdgcn_mfma_f32_32x32x16_bf16(F.a11, F.b11, acc[1][1], 0, 0, 0); }
#define GEMM_KSTEP_LAST(BUF, RLOAD, LSRC, KT, RSTORE) { \
    GEMM_READF(F1, BUF, 1) \
    GEMM_LOADX(RLOAD, LSRC, KT) \
    __builtin_amdgcn_sched_barrier(0); \
    GEMM_MFMA8(F0) \
    __builtin_amdgcn_sched_barrier(0); \
    GEMM_STORE(RSTORE, (BUF) ^ 1) \
    __syncthreads(); \
    GEMM_MFMA8(F1) \
    __builtin_amdgcn_sched_barrier(0); }
#define GEMM_KSTEP(BUF, RLOAD, LSRC, KT, RSTORE) { \
    GEMM_READF(F1, BUF, 1) \
    GEMM_LOADX(RLOAD, LSRC, KT) \
    __builtin_amdgcn_sched_barrier(0); \
    GEMM_MFMA8(F0) \
    __builtin_amdgcn_sched_barrier(0); \
    GEMM_STORE(RSTORE, (BUF) ^ 1) \
    __syncthreads(); \
    GEMM_READF(F0, (BUF) ^ 1, 0) \
    __builtin_amdgcn_sched_barrier(0); \
    GEMM_MFMA8(F1) \
    __builtin_amdgcn_sched_barrier(0); }
#define GEMM_LOADX(R, L, KT) { const int k0_ = min((KT), L.nk - 1) * 64; \
    const int soa_ = __builtin_amdgcn_readfirstlane((int)(((long)(k0_ >> L.akshift) * L.akstride + (k0_ & L.akmask)) * 2)); \
    const int sob_ = __builtin_amdgcn_readfirstlane((int)(((long)(k0_ >> L.kshift) * L.kstride + (k0_ & L.kmask)) * 2)); \
    const __amdgpu_buffer_rsrc_t rsA_ = make_rsrc(L.baseA); const __amdgpu_buffer_rsrc_t rsB_ = make_rsrc(L.baseB); \
    R.a0 = bufld(rsA_, L.va0, soa_); R.a1 = bufld(rsA_, L.va1, soa_); R.a2 = bufld(rsA_, L.va2, soa_); R.a3 = bufld(rsA_, L.va3, soa_); \
    R.b0 = bufld(rsB_, L.vb0, sob_); R.b1 = bufld(rsB_, L.vb1, sob_); }
#define GEMM_STORE(R, BUF) { u16* ad_ = As + (BUF) * 256 * 72 + sto; u16* bd_ = Bs + (BUF) * 128 * 72 + sto; \
    *(uint4*)(ad_) = R.a0; *(uint4*)(ad_ + 64 * 72) = R.a1; *(uint4*)(ad_ + 128 * 72) = R.a2; *(uint4*)(ad_ + 192 * 72) = R.a3; \
    *(uint4*)(bd_) = R.b0; *(uint4*)(bd_ + 64 * 72) = R.b1; }

typedef __attribute__((ext_vector_type(4))) unsigned u32x4;
__device__ __forceinline__ __amdgpu_buffer_rsrc_t make_rsrc(const u16* q) {
  unsigned long long v = (unsigned long long)q;
  unsigned lo = __builtin_amdgcn_readfirstlane((unsigned)v), hi = __builtin_amdgcn_readfirstlane((unsigned)(v >> 32));
  void* up = (void*)(((unsigned long long)hi << 32) | lo);
  return __builtin_amdgcn_make_buffer_rsrc(up, (short)0, 0x7ffffff0, 0x00020000);
}
__device__ __forceinline__ uint4 bufld(__amdgpu_buffer_rsrc_t rs, unsigned voff, int soff) {
  u32x4 v = __builtin_amdgcn_raw_buffer_load_b128(rs, (int)voff, soff, 0);
  return make_uint4(v[0], v[1], v[2], v[3]);
}

struct LdSt { const u16* baseA; const u16* baseB; unsigned va0, va1, va2, va3, vb0, vb1; int nk, kshift, kmask; long kstride; int akshift, akmask; long akstride; };
__device__ __forceinline__ void ld_setup(LdSt& L, const GD& g, const int lr, const int lc) {
  L.baseA = g.A; L.baseB = g.B + (long)(g.n0 >> 8) * g.b_rs_hi;
  const unsigned nl = (unsigned)(g.n0 & 255) + (unsigned)lr;
  L.vb0 = (nl * (unsigned)g.b_rs_lo + (unsigned)lc) * 2u;
  L.vb1 = ((nl + 64u) * (unsigned)g.b_rs_lo + (unsigned)lc) * 2u;
  const int t0 = g.m0 + lr;
  const unsigned ulda = (unsigned)g.lda;
  L.va0 = ((unsigned)((t0) & g.a_rowmask) * ulda + (unsigned)lc) * 2u;
  L.va1 = ((unsigned)((t0 + 64) & g.a_rowmask) * ulda + (unsigned)lc) * 2u;
  L.va2 = ((unsigned)((t0 + 128) & g.a_rowmask) * ulda + (unsigned)lc) * 2u;
  L.va3 = ((unsigned)((t0 + 192) & g.a_rowmask) * ulda + (unsigned)lc) * 2u;
  L.nk = g.K >> 6; L.kshift = g.b_kshift; L.kmask = (1 << g.b_kshift) - 1; L.kstride = g.b_kstride;
  L.akshift = g.a_kshift; L.akmask = (1 << g.a_kshift) - 1; L.akstride = g.a_kstride;
  if (g.b_perm == 1) {
    const unsigned n_0 = (unsigned)g.n0 + (unsigned)lr, n_1 = n_0 + 64u;
    const unsigned tk0 = (n_0 & ~4095u) | ((n_0 & 63u) << 6) | ((n_0 >> 6) & 63u);
    const unsigned tk1 = (n_1 & ~4095u) | ((n_1 & 63u) << 6) | ((n_1 >> 6) & 63u);
    L.baseB = g.B;
    L.vb0 = (tk0 * 1024u + (unsigned)lc) * 2u; L.vb1 = (tk1 * 1024u + (unsigned)lc) * 2u;
  } else if (g.b_perm == 2) {
    const unsigned n_0 = (unsigned)g.n0 + (unsigned)lr, n_1 = n_0 + 64u;
    const unsigned r0 = (((n_0 & 1023u) * 8u + (n_0 >> 16)) * 64u + ((n_0 >> 10) & 63u));
    const unsigned r1 = (((n_1 & 1023u) * 8u + (n_1 >> 16)) * 64u + ((n_1 >> 10) & 63u));
    L.baseB = g.B;
    L.vb0 = (r0 * 128u + (unsigned)lc) * 2u; L.vb1 = (r1 * 128u + (unsigned)lc) * 2u;
  }
}
__device__ __forceinline__ void ld_select(LdSt& o, const bool c, const LdSt& a, const LdSt& b) {
  o.baseA = c ? a.baseA : b.baseA; o.baseB = c ? a.baseB : b.baseB;
  o.va0 = c ? a.va0 : b.va0; o.va1 = c ? a.va1 : b.va1; o.va2 = c ? a.va2 : b.va2; o.va3 = c ? a.va3 : b.va3;
  o.vb0 = c ? a.vb0 : b.vb0; o.vb1 = c ? a.vb1 : b.vb1;
  o.nk = c ? a.nk : b.nk; o.kshift = c ? a.kshift : b.kshift; o.kmask = c ? a.kmask : b.kmask; o.kstride = c ? a.kstride : b.kstride;
  o.akshift = c ? a.akshift : b.akshift; o.akmask = c ? a.akmask : b.akmask; o.akstride = c ? a.akstride : b.akstride;
}

__device__ __forceinline__ void gemm_epilogue(const Ctx& p, const GD& g, f32x16 (&acc)[2][2], const int tid);

__device__ __forceinline__ void gemm_tile_mix(const Ctx& p, char* smem, const GD& g, const int tid) {
  u16* As = (u16*)smem;
  u16* Bs = As + 2 * 256 * 72;
  const int lane = tid & 63, w = tid >> 6, wm = w >> 1, wn = w & 1;
  const int lr = tid >> 3, lc = (tid & 7) * 8;
  f32x16 acc[2][2];
#pragma unroll
  for (int i = 0; i < 2; ++i)
#pragma unroll
    for (int j = 0; j < 2; ++j)
#pragma unroll
      for (int r = 0; r < 16; ++r) acc[i][j][r] = 0.f;
  Stg R0, R1;
  LdSt L; ld_setup(L, g, lr, lc);
  const int nk = L.nk;
  const int t0 = g.m0 + lr;
  const int sto = lr * 72 + lc;
  {
    float4 mu0, mu1;
    int nbm = 0;
    const uint4 z4 = make_uint4(0, 0, 0, 0);
    int nq0[4], nq1[4], nq2[4], nq3[4];
#pragma unroll
    for (int q4 = 0; q4 < 4; ++q4) {
      nq0[q4] = mix_nb(t0, q4 * 256); nq1[q4] = mix_nb(t0 + 64, q4 * 256); nq2[q4] = mix_nb(t0 + 128, q4 * 256); nq3[q4] = mix_nb(t0 + 192, q4 * 256);
    }
    for (int kt = -1; kt < nk; ++kt) {
      const int cur = kt & 1;
      if (kt + 1 < nk) {
        const int k0 = (kt + 1) * 64;
        const int k = k0 + lc;
        GEMM_LOADX(R0, L, kt + 1)
        const __amdgpu_buffer_rsrc_t rsA = make_rsrc(L.baseA);
        mu0 = *(const float4*)(g.mu + k); mu1 = *(const float4*)(g.mu + k + 4);
        const int soa = __builtin_amdgcn_readfirstlane(k0 * 2);
        const int qq = __builtin_amdgcn_readfirstlane(k0 >> 8);
        const int nb0 = (qq == 0) ? nq0[0] : (qq == 1) ? nq0[1] : (qq == 2) ? nq0[2] : nq0[3];
        const int nb1 = (qq == 0) ? nq1[0] : (qq == 1) ? nq1[1] : (qq == 2) ? nq1[2] : nq1[3];
        const int nb2 = (qq == 0) ? nq2[0] : (qq == 1) ? nq2[1] : (qq == 2) ? nq2[2] : nq2[3];
        const int nb3 = (qq == 0) ? nq3[0] : (qq == 1) ? nq3[1] : (qq == 2) ? nq3[2] : nq3[3];
        nbm = (nb0 >= 0 ? 1 : 0) | (nb1 >= 0 ? 2 : 0) | (nb2 >= 0 ? 4 : 0) | (nb3 >= 0 ? 8 : 0);
        R1.a0 = bufld(rsA, nb0 >= 0 ? ((unsigned)nb0 * 1024u + (unsigned)lc) * 2u : 0x80000000u, soa);
        R1.a1 = bufld(rsA, nb1 >= 0 ? ((unsigned)nb1 * 1024u + (unsigned)lc) * 2u : 0x80000000u, soa);
        R1.a2 = bufld(rsA, nb2 >= 0 ? ((unsigned)nb2 * 1024u + (unsigned)lc) * 2u : 0x80000000u, soa);
        R1.a3 = bufld(rsA, nb3 >= 0 ? ((unsigned)nb3 * 1024u + (unsigned)lc) * 2u : 0x80000000u, soa);
      }
      if (kt >= 0) GEMM_COMPUTE(cur)
      if (kt + 1 < nk) {
        R0.a0 = mix4(R0.a0, R1.a0, mu0, mu1); R0.a1 = mix4(R0.a1, R1.a1, mu0, mu1);
        R0.a2 = mix4(R0.a2, R1.a2, mu0, mu1); R0.a3 = mix4(R0.a3, R1.a3, mu0, mu1);
        GEMM_STORE(R0, cur ^ 1)
      }
      __syncthreads();
    }
  }
  gemm_epilogue(p, g, acc, tid);
}

__device__ __forceinline__ void gemm_epilogue(const Ctx& p, const GD& g, f32x16 (&acc)[2][2], const int tid) {
  int te = tid;
  asm volatile("" : "+v"(te));
  const int le = te & 63, we = te >> 6;
  const int lrow0 = 64 * (we >> 1) + 4 * (le >> 5), lcol0 = 64 * (we & 1) + (le & 31);
  const int ldo = (int)g.ldo;
  switch (g.ep) {
    case 0: { u16* ob = g.out + (size_t)(g.m0 + lrow0) * g.ldo + g.n0 + lcol0; EPI_LOOP(ldo, { ob[off] = f2bf(v); }) } break;
    case 1: { u16* ob = g.out + (size_t)(g.m0 + lrow0) * g.ldo + g.n0 + lcol0; EPI_LOOP(ldo, { ob[off] = f2bf(tanhf(v)); }) } break;
    case 2: { u16* ob = g.out + (size_t)(g.m0 + lrow0) * g.ldo + g.n0 + lcol0; EPI_LOOP(ldo, { ob[off] = f2bf(sigmoidf_(v)); }) } break;
    case 3: { u16* ob = g.out + (size_t)(g.m0 + lrow0) * g.ldo + g.n0 + lcol0; EPI_LOOP(ldo, { float rr = fmaxf(v, 0.f); ob[off] = f2bf(rr * rr); }) } break;
    case 4: { u16* ob = g.out + (size_t)(g.m0 + lrow0) * 64 + g.n0 + lcol0; if (g.n0 + lcol0 < 32) { EPI_LOOP(64, { ob[off] = f2bf(v); }) } } break;
    case 5: {
      const int jb = (g.m0 < TL) ? (g.m0 >> 12) : 8;
      const float* gp = g.e0 + jb * 6144 + g.n0 + lcol0;
      const float g0 = gp[0], g1 = gp[32];
      u16* ob = g.out + (size_t)(g.m0 + lrow0) * 1024 + g.n0 + lcol0;
      EPI_LOOP(1024, { ob[off] = f2bf((j ? g1 : g0) * v); })
    } break;
    case 6: { u16* ob = g.out + (size_t)(g.m0 + lrow0) * g.ldo + g.n0 + lcol0; const float* bp = g.e0 + g.n0 + lcol0; const float c0 = bp[0], c1 = bp[32];
      EPI_LOOP(ldo, { ob[off] = f2bf(sigmoidf_((j ? c1 : c0) + v)); }) } break;
    case 7: {
      u16* ob = g.out + (size_t)(g.m0 + lrow0) * 1024 + g.n0 + lcol0; const u16* gs = g.gsrc + (size_t)(g.m0 + lrow0) * 1024 + g.n0 + lcol0;
      EPI_LOOP(1024, { float vf = bf2f(ob[off]); float gt = bf2f(gs[off]); ob[off] = f2bf(v + (vf - v) * gt); })
    } break;
    case 8: {
      u16* ob; int ld;
      if (g.n0 < TL) { ld = TL; ob = g.out + (size_t)(g.m0 + lrow0) * TL + g.n0 + lcol0; } else { ld = TC; ob = g.out2 + (size_t)(g.m0 + lrow0) * TC + (g.n0 - TL) + lcol0; }
      EPI_LOOP(ld, { ob[off] = f2bf(v); })
    } break;
    case 9: {
      const int gq = g.m0 >> 17, rloc = g.m0 & 131071;
      const int mmq = rloc >> 9, b = ((rloc & 511) >> 6) + (we >> 1);
      const int k1 = 32 * (we & 1) + (le & 31);
      const float2* tw = (const float2*)g.e0 + k1 * 64;
      u16* zb = g.out + ((size_t)(((gq * 256 + mmq) * 8 + b) * 64 + k1) * 2) * 64;
#pragma unroll
      for (int i = 0; i < 2; ++i) {
#pragma unroll
        for (int rq = 0; rq < 4; ++rq) {
          const int l20 = 32 * i + 8 * rq + 4 * (le >> 5);
          float zr[4], zi[4];
#pragma unroll
          for (int e = 0; e < 4; ++e) {
            const float2 t = tw[l20 + e];
            const float re = acc[i][0][rq * 4 + e], im = acc[i][1][rq * 4 + e];
            zr[e] = re * t.x + im * t.y; zi[e] = im * t.x - re * t.y;
          }
          *(uint2*)(zb + l20) = make_uint2(pack2(zr[0], zr[1]), pack2(zr[2], zr[3]));
          *(uint2*)(zb + 64 + l20) = make_uint2(pack2(zi[0], zi[1]), pack2(zi[2], zi[3]));
        }
        asm volatile("" ::: "memory");
      }
    } break;
    case 10: {
      if ((we >> 1) == 0) {
        const int b = g.n0 >> 16, k1 = (g.n0 >> 10) & 63, gm0 = (g.n0 & 1023) + lcol0;
        u16* ob = g.out + ((size_t)(b * 4096 + k1 + 64 * (4 * (le >> 5)))) * 1024 + gm0;
        EPI_LOOP(65536, { ob[off] = f2bf(v); })
      }
    } break;
    default: break;
  }
}

enum { G_RB = 0, G_RC, G_RC2, G_WO_R, G_FB, G_F1, G_F2, G_WO_F, G_MLP1, G_MLP2 };

__device__ __forceinline__ int gemm_total(int kind, int layer) {
  const int idx = layer >> 1;
  const bool ctx_in = layer <= 2, ctx_out = layer < 2;
  const int mt_out = (ctx_out ? T : TL) >> 8;
  switch (kind) {
    case G_RB: return 136 * ((idx == 0) ? 27 : 20);
    case G_RC: return 136 * ((idx == 0) ? 8 : 16);
    case G_RC2: return 136 * 8;
    case G_WO_R: return mt_out * 8;
    case G_FB: return 8 * (ctx_in ? 272 : 256);
    case G_F1: return 2048;
    case G_F2: return 4096 + (ctx_in ? 64 : 0);
    case G_WO_F: return mt_out * 8;
    case G_MLP1: return mt_out * 32;
    default: return mt_out * 8;
  }
}

__device__ __forceinline__ void make_gd(const Ctx& p, int kind, int layer, int tile, GD& g) {
  const int idx = layer >> 1;
  const u16* H = (const u16*)p.ws;
  const u16* wm = (const u16*)(p.ws + OFF_WMIX);
  const float* mu = p.in[10] + (size_t)idx * 6 * 1024;
  const float* mod = (const float*)(p.ws + OFF_MOD) + (size_t)layer * 9 * 6144;
  g.out = nullptr; g.out2 = nullptr; g.e0 = nullptr; g.gsrc = nullptr; g.ldo = 1024; g.ep = 0; g.K = 1024;
  switch (kind) {
    case G_RB: {
      const int CT = (idx == 0) ? 27 : 20;
      int tm = tile / CT, ct = tile % CT;
      g.m0 = tm * 256;
      int nv = (idx == 0) ? 8 : 0;
      if (ct < 8) { gd_mixA(g, H, mu + 0 * 1024); gd_plainB(g, wm + 0 * M1, 1024); g.n0 = ct * 128; g.out = (u16*)(p.ws + 1 * SLOT); }
      else if (ct < 16) { gd_mixA(g, H, mu + 2 * 1024); gd_plainB(g, wm + 1 * M1, 1024); g.n0 = (ct - 8) * 128; g.out = (u16*)(p.ws + 2 * SLOT); }
      else if (ct < 16 + nv) { gd_mixA(g, H, mu + 3 * 1024); gd_plainB(g, wm + 2 * M1, 1024); g.n0 = (ct - 16) * 128; g.out = (u16*)(p.ws + 5 * SLOT); }
      else {
        int q = ct - 16 - nv; g.n0 = 0;
        if (q == 0) { gd_mixA(g, H, mu + 1 * 1024); gd_plainB(g, wm + 4 * M1, 1024); g.ep = 1; g.out = (u16*)(p.ws + OFF_HW); g.ldo = 128; }
        else if (q == 1) { gd_mixA(g, H, mu + 4 * 1024); gd_plainB(g, wm + 4 * M1 + 131072, 1024); g.ep = 0; g.out = (u16*)(p.ws + OFF_HA); g.ldo = 128; }
        else if (q == 2) { gd_mixA(g, H, mu + 5 * 1024); gd_plainB(g, wm + 4 * M1 + 2 * 131072, 1024); g.ep = 2; g.out = (u16*)(p.ws + OFF_HG); g.ldo = 128; }
        else { gd_mixA(g, H, mu + 3 * 1024); gd_plainB(g, wm + 4 * M1 + 3 * 131072, 1024); g.ep = 0; g.out = (u16*)(p.ws + OFF_HV); g.ldo = 128; }
      }
    } break;
    case G_RC: {
      const int CT = (idx == 0) ? 8 : 16;
      int tm = tile / CT, ct = tile % CT;
      g.m0 = tm * 256;
      if (ct < 8) { gd_plainA(g, (const u16*)(p.ws + OFF_HG), 128); gd_plainB(g, wm + 4 * M1 + 4 * 131072, 128); g.K = 128; g.n0 = ct * 128; g.out = (u16*)(p.ws + 4 * SLOT); }
      else { gd_plainA(g, (const u16*)(p.ws + OFF_HV), 128); gd_plainB(g, wm + 4 * M1 + 5 * 131072, 128); g.K = 128; g.n0 = (ct - 8) * 128; g.ep = 6; g.e0 = p.in[21]; g.out = (u16*)(p.ws + 3 * SLOT); }
    } break;
    case G_RC2: {
      int tm = tile >> 3, ct = tile & 7;
      g.m0 = tm * 256; g.n0 = ct * 128;
      gd_mixA(g, H, mu + 3 * 1024); gd_plainB(g, wm + 2 * M1, 1024);
      g.ep = 7; g.out = (u16*)(p.ws + 5 * SLOT); g.gsrc = (const u16*)(p.ws + 3 * SLOT);
    } break;
    case G_WO_R: {
      int tm = tile >> 3, ct = tile & 7;
      g.m0 = tm * 256; g.n0 = ct * 128;
      gd_plainA(g, H, 1024); gd_plainB(g, wm + 3 * M1, 1024);
      g.ep = 5; g.e0 = mod + 2048; g.out = (u16*)(p.ws + 1 * SLOT);
    } break;
    case G_FB: {
      int tn = tile >> 3, tm = tile & 7;
      g.K = 256; g.m0 = tm * 256; g.n0 = tn * 128;
      gd_plainA(g, wm + M1, 256); g.a_rowmask = 511;
      gd_plainB(g, H + 256 * (tm >> 1), 1024);
      if (g.n0 < TL) g.b_perm = 1;
      g.ep = 8; g.out = (u16*)(p.ws + 1 * SLOT); g.out2 = g.out + (size_t)2048 * TL;
    } break;
    case G_F1: {
      const u16* YT = (const u16*)(p.ws + 1 * SLOT);
      const int gq = tile >> 9;
      g.K = 128; g.m0 = tile * 256; g.n0 = 0;
      gd_plainA(g, YT + (size_t)gq * 512 * TL - (size_t)gq * 131072 * 64, 64);
      g.a_kshift = 6; g.a_kstride = (long)256 * TL;
      gd_plainB(g, wm + M1 + 131072, 128);
      g.ep = 9; g.out = (u16*)(p.ws + 3 * SLOT); g.e0 = (const float*)(wm + M1 + 131072 + 16384 + 8192 + 131072);
    } break;
    case G_F2: {
      u16* fo = (u16*)(p.ws + 1 * SLOT);
      if (tile < 4096) {
        g.K = 128; g.m0 = 0; g.n0 = tile * 128;
        gd_plainA(g, wm + M1 + 131072 + 16384, 128); g.a_rowmask = 63;
        gd_plainB(g, (const u16*)(p.ws + 3 * SLOT), 128); g.b_perm = 2;
        g.ep = 10; g.out = fo;
      } else {
        const u16* dftC = wm + M1 + 131072 + 16384 + 8192;
        const u16* YTc = (const u16*)(p.ws + 1 * SLOT) + (size_t)2048 * TL;
        int t2 = tile - 4096; int b = t2 >> 3, ct = t2 & 7;
        g.K = 512; g.m0 = 0; g.n0 = ct * 128;
        gd_plainA(g, dftC, 512);
        g.B = YTc + (size_t)b * 256; g.b_rs_hi = (long)512 * TC; g.b_rs_lo = TC; g.b_kshift = 8; g.b_kstride = (long)256 * TC; g.b_perm = 0;
        g.out = fo + (size_t)(TL + b * 256) * 1024;
      }
    } break;
    case G_WO_F: {
      int tm = tile >> 3, ct = tile & 7;
      g.m0 = tm * 256; g.n0 = ct * 128;
      gd_plainA(g, (const u16*)(p.ws + 1 * SLOT), 1024); gd_plainB(g, wm, 1024);
      g.ep = 5; g.e0 = mod + 2048; g.out = (u16*)(p.ws + 2 * SLOT);
    } break;
    case G_MLP1: {
      const int grp = tile >> 7, ii = tile & 127;
      int tm = grp * 4 + ((ii & 31) >> 3), ct = (ii >> 5) * 8 + (ii & 7);
      g.m0 = tm * 256; g.n0 = ct * 128;
      gd_plainA(g, H, 1024); gd_plainB(g, (const u16*)(p.ws + OFF_WMLP), 1024);
      g.ep = 3; g.out = (u16*)(p.ws + 1 * SLOT); g.ldo = 4096;
    } break;
    default: {
      int tm = tile >> 3, ct = tile & 7;
      g.K = 4096; g.m0 = tm * 256; g.n0 = ct * 128;
      gd_plainA(g, (const u16*)(p.ws + 1 * SLOT), 4096); gd_plainB(g, (const u16*)(p.ws + OFF_WMLP) + 4 * M1, 4096);
      g.ep = 5; g.e0 = mod + 5 * 1024; g.out = (u16*)(p.ws);
    } break;
  }
}

#define SCAN_SA_TEXT \
      "v_mul_f32_dpp %0, %2, %3 row_newbcast:0 row_mask:0xf bank_mask:0xf\n\t" \
      "v_mul_f32_dpp %1, %2, %4 row_newbcast:1 row_mask:0xf bank_mask:0xf\n\t" \
      "v_fmac_f32_dpp %0, %2, %5 row_newbcast:2 row_mask:0xf bank_mask:0xf\n\t" \
      "v_fmac_f32_dpp %1, %2, %6 row_newbcast:3 row_mask:0xf bank_mask:0xf\n\t" \
      "v_fmac_f32_dpp %0, %2, %7 row_newbcast:4 row_mask:0xf bank_mask:0xf\n\t" \
      "v_fmac_f32_dpp %1, %2, %8 row_newbcast:5 row_mask:0xf bank_mask:0xf\n\t" \
      "v_fmac_f32_dpp %0, %2, %9 row_newbcast:6 row_mask:0xf bank_mask:0xf\n\t" \
      "v_fmac_f32_dpp %1, %2, %10 row_newbcast:7 row_mask:0xf bank_mask:0xf\n\t" \
      "v_fmac_f32_dpp %0, %2, %11 row_newbcast:8 row_mask:0xf bank_mask:0xf\n\t" \
      "v_fmac_f32_dpp %1, %2, %12 row_newbcast:9 row_mask:0xf bank_mask:0xf\n\t" \
      "v_fmac_f32_dpp %0, %2, %13 row_newbcast:10 row_mask:0xf bank_mask:0xf\n\t" \
      "v_fmac_f32_dpp %1, %2, %14 row_newbcast:11 row_mask:0xf bank_mask:0xf\n\t" \
      "v_fmac_f32_dpp %0, %2, %15 row_newbcast:12 row_mask:0xf bank_mask:0xf\n\t" \
      "v_fmac_f32_dpp %1, %2, %16 row_newbcast:13 row_mask:0xf bank_mask:0xf\n\t" \
      "v_fmac_f32_dpp %0, %2, %17 row_newbcast:14 row_mask:0xf bank_mask:0xf\n\t" \
      "v_fmac_f32_dpp %1, %2, %18 row_newbcast:15 row_mask:0xf bank_mask:0xf\n\t"
#define SCAN_SA(sa0, sa1, A) asm( \
      SCAN_SA_TEXT \
      : "=&v"(sa0), "=&v"(sa1) : "v"(A), "v"(S[0]), "v"(S[1]), "v"(S[2]), "v"(S[3]), "v"(S[4]), "v"(S[5]), "v"(S[6]), "v"(S[7]), \
        "v"(S[8]), "v"(S[9]), "v"(S[10]), "v"(S[11]), "v"(S[12]), "v"(S[13]), "v"(S[14]), "v"(S[15]))
#define SCAN_UP(B0, W, Bv, KD, sa, VV) asm( \
      "v_mul_f32_dpp %0, %16, %8 row_newbcast:0 row_mask:0xf bank_mask:0xf\n\t" \
      "v_mul_f32_dpp %1, %16, %9 row_newbcast:1 row_mask:0xf bank_mask:0xf\n\t" \
      "v_mul_f32_dpp %2, %16, %10 row_newbcast:2 row_mask:0xf bank_mask:0xf\n\t" \
      "v_mul_f32_dpp %3, %16, %11 row_newbcast:3 row_mask:0xf bank_mask:0xf\n\t" \
      "v_mul_f32_dpp %4, %16, %12 row_newbcast:4 row_mask:0xf bank_mask:0xf\n\t" \
      "v_mul_f32_dpp %5, %16, %13 row_newbcast:5 row_mask:0xf bank_mask:0xf\n\t" \
      "v_mul_f32_dpp %6, %16, %14 row_newbcast:6 row_mask:0xf bank_mask:0xf\n\t" \
      "v_mul_f32_dpp %7, %16, %15 row_newbcast:7 row_mask:0xf bank_mask:0xf\n\t" \
      "v_fmac_f32_dpp %0, %17, %19 row_newbcast:0 row_mask:0xf bank_mask:0xf\n\t" \
      "v_fmac_f32_dpp %1, %17, %19 row_newbcast:1 row_mask:0xf bank_mask:0xf\n\t" \
      "v_fmac_f32_dpp %2, %17, %19 row_newbcast:2 row_mask:0xf bank_mask:0xf\n\t" \
      "v_fmac_f32_dpp %3, %17, %19 row_newbcast:3 row_mask:0xf bank_mask:0xf\n\t" \
      "v_fmac_f32_dpp %4, %17, %19 row_newbcast:4 row_mask:0xf bank_mask:0xf\n\t" \
      "v_fmac_f32_dpp %5, %17, %19 row_newbcast:5 row_mask:0xf bank_mask:0xf\n\t" \
      "v_fmac_f32_dpp %6, %17, %19 row_newbcast:6 row_mask:0xf bank_mask:0xf\n\t" \
      "v_fmac_f32_dpp %7, %17, %19 row_newbcast:7 row_mask:0xf bank_mask:0xf\n\t" \
      "v_fmac_f32_dpp %0, %18, %20 row_newbcast:0 row_mask:0xf bank_mask:0xf\n\t" \
      "v_fmac_f32_dpp %1, %18, %20 row_newbcast:1 row_mask:0xf bank_mask:0xf\n\t" \
      "v_fmac_f32_dpp %2, %18, %20 row_newbcast:2 row_mask:0xf bank_mask:0xf\n\t" \
      "v_fmac_f32_dpp %3, %18, %20 row_newbcast:3 row_mask:0xf bank_mask:0xf\n\t" \
      "v_fmac_f32_dpp %4, %18, %20 row_newbcast:4 row_mask:0xf bank_mask:0xf\n\t" \
      "v_fmac_f32_dpp %5, %18, %20 row_newbcast:5 row_mask:0xf bank_mask:0xf\n\t" \
      "v_fmac_f32_dpp %6, %18, %20 row_newbcast:6 row_mask:0xf bank_mask:0xf\n\t" \
      "v_fmac_f32_dpp %7, %18, %20 row_newbcast:7 row_mask:0xf bank_mask:0xf\n\t" \
      : "=&v"(N[B0 + 0]), "=&v"(N[B0 + 1]), "=&v"(N[B0 + 2]), "=&v"(N[B0 + 3]), "=&v"(N[B0 + 4]), "=&v"(N[B0 + 5]), "=&v"(N[B0 + 6]), "=&v"(N[B0 + 7]) \
      : "v"(S[B0 + 0]), "v"(S[B0 + 1]), "v"(S[B0 + 2]), "v"(S[B0 + 3]), "v"(S[B0 + 4]), "v"(S[B0 + 5]), "v"(S[B0 + 6]), "v"(S[B0 + 7]), \
        "v"(W), "v"(Bv), "v"(KD), "v"(sa), "v"(VV))
#define SCAN_UP8(B0, W, Bv, KD, sa, VV) asm( \
      "v_mul_f32_dpp %0, %16, %8 row_newbcast:8 row_mask:0xf bank_mask:0xf\n\t" \
      "v_mul_f32_dpp %1, %16, %9 row_newbcast:9 row_mask:0xf bank_mask:0xf\n\t" \
      "v_mul_f32_dpp %2, %16, %10 row_newbcast:10 row_mask:0xf bank_mask:0xf\n\t" \
      "v_mul_f32_dpp %3, %16, %11 row_newbcast:11 row_mask:0xf bank_mask:0xf\n\t" \
      "v_mul_f32_dpp %4, %16, %12 row_newbcast:12 row_mask:0xf bank_mask:0xf\n\t" \
      "v_mul_f32_dpp %5, %16, %13 row_newbcast:13 row_mask:0xf bank_mask:0xf\n\t" \
      "v_mul_f32_dpp %6, %16, %14 row_newbcast:14 row_mask:0xf bank_mask:0xf\n\t" \
      "v_mul_f32_dpp %7, %16, %15 row_newbcast:15 row_mask:0xf bank_mask:0xf\n\t" \
      "v_fmac_f32_dpp %0, %17, %19 row_newbcast:8 row_mask:0xf bank_mask:0xf\n\t" \
      "v_fmac_f32_dpp %1, %17, %19 row_newbcast:9 row_mask:0xf bank_mask:0xf\n\t" \
      "v_fmac_f32_dpp %2, %17, %19 row_newbcast:10 row_mask:0xf bank_mask:0xf\n\t" \
      "v_fmac_f32_dpp %3, %17, %19 row_newbcast:11 row_mask:0xf bank_mask:0xf\n\t" \
      "v_fmac_f32_dpp %4, %17, %19 row_newbcast:12 row_mask:0xf bank_mask:0xf\n\t" \
      "v_fmac_f32_dpp %5, %17, %19 row_newbcast:13 row_mask:0xf bank_mask:0xf\n\t" \
      "v_fmac_f32_dpp %6, %17, %19 row_newbcast:14 row_mask:0xf bank_mask:0xf\n\t" \
      "v_fmac_f32_dpp %7, %17, %19 row_newbcast:15 row_mask:0xf bank_mask:0xf\n\t" \
      "v_fmac_f32_dpp %0, %18, %20 row_newbcast:8 row_mask:0xf bank_mask:0xf\n\t" \
      "v_fmac_f32_dpp %1, %18, %20 row_newbcast:9 row_mask:0xf bank_mask:0xf\n\t" \
      "v_fmac_f32_dpp %2, %18, %20 row_newbcast:10 row_mask:0xf bank_mask:0xf\n\t" \
      "v_fmac_f32_dpp %3, %18, %20 row_newbcast:11 row_mask:0xf bank_mask:0xf\n\t" \
      "v_fmac_f32_dpp %4, %18, %20 row_newbcast:12 row_mask:0xf bank_mask:0xf\n\t" \
      "v_fmac_f32_dpp %5, %18, %20 row_newbcast:13 row_mask:0xf bank_mask:0xf\n\t" \
      "v_fmac_f32_dpp %6, %18, %20 row_newbcast:14 row_mask:0xf bank_mask:0xf\n\t" \
      "v_fmac_f32_dpp %7, %18, %20 row_newbcast:15 row_mask:0xf bank_mask:0xf\n\t" \
      : "=&v"(N[B0 + 0]), "=&v"(N[B0 + 1]), "=&v"(N[B0 + 2]), "=&v"(N[B0 + 3]), "=&v"(N[B0 + 4]), "=&v"(N[B0 + 5]), "=&v"(N[B0 + 6]), "=&v"(N[B0 + 7]) \
      : "v"(S[B0 + 0]), "v"(S[B0 + 1]), "v"(S[B0 + 2]), "v"(S[B0 + 3]), "v"(S[B0 + 4]), "v"(S[B0 + 5]), "v"(S[B0 + 6]), "v"(S[B0 + 7]), \
        "v"(W), "v"(Bv), "v"(KD), "v"(sa), "v"(VV))
#define SCAN_Y(sa0, sa1, A) asm( \
      SCAN_SA_TEXT \
      : "=&v"(sa0), "=&v"(sa1) : "v"(A), "v"(N[0]), "v"(N[1]), "v"(N[2]), "v"(N[3]), "v"(N[4]), "v"(N[5]), "v"(N[6]), "v"(N[7]), \
        "v"(N[8]), "v"(N[9]), "v"(N[10]), "v"(N[11]), "v"(N[12]), "v"(N[13]), "v"(N[14]), "v"(N[15]))
#define SCAN_STEP(W, A, Bv, KD, R, VV, YP, PREFETCH) { \
      float sa0, sa1, y0, y1; float N[16]; \
      asm volatile("s_nop 1" : "+v"(A), "+v"(W), "+v"(Bv), "+v"(KD), "+v"(R)); \
      SCAN_SA(sa0, sa1, A); \
      PREFETCH \
      const float sa = xrow_sum(sa0 + sa1); \
      SCAN_UP(0, W, Bv, KD, sa, VV); \
      SCAN_UP8(8, W, Bv, KD, sa, VV); \
      SCAN_Y(y0, y1, R); \
      YP = y0 + y1; \
      _Pragma("unroll") for (int j_ = 0; j_ < 16; ++j_) S[j_] = N[j_]; }
#define SCAN_LOAD(W, A, Bv, KD, R, VV, SIDX) { const float* np_ = bp + (SIDX) * 384; \
      W = np_[lane]; A = np_[64 + lane]; Bv = np_[128 + lane]; KD = np_[192 + lane]; R = np_[256 + lane]; VV = np_[vo]; }

__device__ __forceinline__ int scan_row(int gstep, int b, int d) {
  if (gstep < 256) { int pp = d ? 255 - gstep : gstep; return TL + b * 256 + pp; }
  int l = gstep - 256; if (d) l = 4095 - l;
  return b * 4096 + l;
}

__device__ __forceinline__ void phase_scan(const Ctx& p, char* smem, int idx, bool ctx_y, const int tid) {
  if (blockIdx.x >= 256) return;
  const int item = blockIdx.x;
  const int d = item & 1, h = (item >> 1) & 15, b = item >> 5;
  float* buf = (float*)smem;
  float* ybuf = buf + 2 * 32 * 384;
  const int lane = tid & 63, w = tid >> 6;
  const u16* rbuf = (const u16*)(p.ws + 1 * SLOT);
  const u16* kbuf = (const u16*)(p.ws + 2 * SLOT);
  const u16* vbuf = (const u16*)(p.ws + 5 * SLOT);
  u16* ybase = (u16*)(p.ws + (d == 0 ? 0 : 3 * SLOT));
  const u16* hw = (const u16*)(p.ws + OFF_HW);
  const u16* ha = (const u16*)(p.ws + OFF_HA);
  float* bsum = (float*)(p.ws + OFF_BSUM);
  const int ch = h * 64;

  uint4* Bl = (uint4*)(ybuf + 2 * 2048);
  float w0v[4], a0v[4];
  float kkw = 0.f, kaw = 0.f, rkw = 0.f;
#pragma unroll
  for (int cb = 0; cb < 4; ++cb) { w0v[cb] = 0.f; a0v[cb] = 0.f; }
  if (w >= 4) {
    const float* w2 = p.in[17] + (size_t)(idx * 2 + d) * 64 * 1024;
    const float* a2 = p.in[20] + (size_t)(idx * 2 + d) * 64 * 1024;
#pragma unroll
    for (int cb = 0; cb < 4; ++cb) {
      int col = ch + 16 * cb + (lane & 15);
      w0v[cb] = p.in[15][(idx * 2 + d) * 1024 + col];
      a0v[cb] = p.in[18][(idx * 2 + d) * 1024 + col];
    }
    {
      const int cb = w - 4;
      const int col = ch + 16 * cb + (lane & 15);
#pragma unroll
      for (int i = 0; i < 2; ++i) {
        const int k0 = 32 * i + 8 * (lane >> 4);
        float fw[8], fa[8];
#pragma unroll
        for (int q = 0; q < 8; ++q) { fw[q] = w2[(size_t)(k0 + q) * 1024 + col]; fa[q] = a2[(size_t)(k0 + q) * 1024 + col]; }
        Bl[((0 * 4 + cb) * 2 + i) * 64 + lane] = make_uint4(pack2(fw[0], fw[1]), pack2(fw[2], fw[3]), pack2(fw[4], fw[5]), pack2(fw[6], fw[7]));
        Bl[((1 * 4 + cb) * 2 + i) * 64 + lane] = make_uint4(pack2(fa[0], fa[1]), pack2(fa[2], fa[3]), pack2(fa[4], fa[5]), pack2(fa[6], fa[7]));
      }
    }
    kkw = p.in[26][idx * 1024 + ch + lane];
    kaw = p.in[27][idx * 1024 + ch + lane];
    rkw = p.in[28][idx * 1024 + ch + lane];
  }
  __syncthreads();
  float S[16];
#pragma unroll
  for (int j = 0; j < 16; ++j) S[j] = 0.f;

  for (int it = 0; it <= 137; ++it) {
    if (w >= 4) {
      const int jw = w - 4;
      if (it >= 2) {
        int cy = it - 2;
        const float* yb = ybuf + (cy & 1) * 2048;
        if (cy >= 8 || ctx_y) {
          const int yrow0 = scan_row(cy * 32 + jw * 8, b, d);
#pragma unroll
          for (int s8 = 0; s8 < 8; ++s8) {
            int s = jw * 8 + s8;
            int row = yrow0 + (d ? -s8 : s8);
            ybase[(unsigned)row * 1024u + (unsigned)(ch + lane)] = f2bf(yb[s * 64 + lane]);
          }
        }
      }
      if (it < 136) {
        float* bp = buf + (it & 1) * 12288;
        const int s0 = jw * 8;
        const int prow0 = scan_row(it * 32 + s0, b, d);
        int rowm = prow0 + (d ? -(lane & 7) : (lane & 7));
        bf16x8 Aw0 = *(const bf16x8*)(hw + ((unsigned)rowm * 128u + (unsigned)(d * 64 + 8 * (lane >> 4))));
        bf16x8 Aw1 = *(const bf16x8*)(hw + ((unsigned)rowm * 128u + (unsigned)(d * 64 + 32 + 8 * (lane >> 4))));
        bf16x8 Aa0 = *(const bf16x8*)(ha + ((unsigned)rowm * 128u + (unsigned)(d * 64 + 8 * (lane >> 4))));
        bf16x8 Aa1 = *(const bf16x8*)(ha + ((unsigned)rowm * 128u + (unsigned)(d * 64 + 32 + 8 * (lane >> 4))));
        float kx[8], rx[8], vx[8];
#pragma unroll
        for (int s8 = 0; s8 < 8; ++s8) {
          int row = prow0 + (d ? -s8 : s8);
          const unsigned o = (unsigned)row * 1024u + (unsigned)(ch + lane);
          kx[s8] = bf2f(kbuf[o]); rx[s8] = bf2f(rbuf[o]); vx[s8] = bf2f(vbuf[o]);
        }
        const bool hiL = lane >= 32;
#pragma unroll
        for (int cbp = 0; cbp < 2; ++cbp) {
          f32x4 cwl = {0.f, 0.f, 0.f, 0.f}, cal = {0.f, 0.f, 0.f, 0.f}, cwh = {0.f, 0.f, 0.f, 0.f}, cah = {0.f, 0.f, 0.f, 0.f};
          {
            const int cb = cbp;
            const bf16x8 bw0 = __builtin_bit_cast(bf16x8, Bl[((0 * 4 + cb) * 2 + 0) * 64 + lane]);
            const bf16x8 bw1 = __builtin_bit_cast(bf16x8, Bl[((0 * 4 + cb) * 2 + 1) * 64 + lane]);
            const bf16x8 ba0 = __builtin_bit_cast(bf16x8, Bl[((1 * 4 + cb) * 2 + 0) * 64 + lane]);
            const bf16x8 ba1 = __builtin_bit_cast(bf16x8, Bl[((1 * 4 + cb) * 2 + 1) * 64 + lane]);
            cwl = __builtin_amdgcn_mfma_f32_16x16x32_bf16(Aw0, bw0, cwl, 0, 0, 0);
            cwl = __builtin_amdgcn_mfma_f32_16x16x32_bf16(Aw1, bw1, cwl, 0, 0, 0);
            cal = __builtin_amdgcn_mfma_f32_16x16x32_bf16(Aa0, ba0, cal, 0, 0, 0);
            cal = __builtin_amdgcn_mfma_f32_16x16x32_bf16(Aa1, ba1, cal, 0, 0, 0);
          }
          {
            const int cb = cbp + 2;
            const bf16x8 bw0 = __builtin_bit_cast(bf16x8, Bl[((0 * 4 + cb) * 2 + 0) * 64 + lane]);
            const bf16x8 bw1 = __builtin_bit_cast(bf16x8, Bl[((0 * 4 + cb) * 2 + 1) * 64 + lane]);
            const bf16x8 ba0 = __builtin_bit_cast(bf16x8, Bl[((1 * 4 + cb) * 2 + 0) * 64 + lane]);
            const bf16x8 ba1 = __builtin_bit_cast(bf16x8, Bl[((1 * 4 + cb) * 2 + 1) * 64 + lane]);
            cwh = __builtin_amdgcn_mfma_f32_16x16x32_bf16(Aw0, bw0, cwh, 0, 0, 0);
            cwh = __builtin_amdgcn_mfma_f32_16x16x32_bf16(Aw1, bw1, cwh, 0, 0, 0);
            cah = __builtin_amdgcn_mfma_f32_16x16x32_bf16(Aa0, ba0, cah, 0, 0, 0);
            cah = __builtin_amdgcn_mfma_f32_16x16x32_bf16(Aa1, ba1, cah, 0, 0, 0);
          }
          const float w0s = hiL ? w0v[cbp + 2] : w0v[cbp];
          const float a0s = hiL ? a0v[cbp + 2] : a0v[cbp];
          const int colb = 16 * (cbp + (hiL ? 2 : 0)) + (lane & 15);
#pragma unroll
          for (int r = 0; r < 4; ++r) {
            const int m = 4 * ((lane >> 4) & 1) + r;
            const float xw = (hiL ? cwh[r] : cwl[r]) + w0s;
            const float xa = (hiL ? cah[r] : cal[r]) + a0s;
            const float dec = __expf(-0.60653066f * sigmoidf_(xw));
            const float ic = sigmoidf_(xa);
            bp[(s0 + m) * 384 + 0 * 64 + colb] = dec;
            bp[(s0 + m) * 384 + 1 * 64 + colb] = ic;
          }
        }
        float icv[8], kkr[8], kdv[8], X[16];
#pragma unroll
        for (int s8 = 0; s8 < 8; ++s8) {
          icv[s8] = bp[(s0 + s8) * 384 + 64 + lane];
          kkr[s8] = kx[s8] * kkw;
          kdv[s8] = kx[s8] * (1.f + (icv[s8] - 1.f) * kaw);
          X[2 * s8] = kkr[s8] * kkr[s8];
          X[2 * s8 + 1] = rx[s8] * kdv[s8] * rkw;
        }
        float Yv[8], Zv[4];
#pragma unroll
        for (int m = 0; m < 8; ++m) {
          auto pp = __builtin_amdgcn_permlane32_swap(__float_as_uint(X[2 * m]), __float_as_uint(X[2 * m + 1]), false, false);
          Yv[m] = __uint_as_float(pp[0]) + __uint_as_float(pp[1]);
        }
#pragma unroll
        for (int n = 0; n < 4; ++n) {
          auto pq = __builtin_amdgcn_permlane16_swap(__float_as_uint(Yv[2 * n]), __float_as_uint(Yv[2 * n + 1]), false, false);
          float z = __uint_as_float(pq[0]) + __uint_as_float(pq[1]);
          DPP_ROR_ADD(z, 8); DPP_ROR_ADD(z, 4); DPP_ROR_ADD(z, 2); DPP_ROR_ADD(z, 1);
          Zv[n] = z;
        }
        float bsv = 0.f;
#pragma unroll
        for (int s8 = 0; s8 < 8; ++s8) {
          const int s = s0 + s8;
          const int zi = __float_as_int(Zv[s8 >> 1]);
          const float ss = __int_as_float(__builtin_amdgcn_readlane(zi, (s8 & 1) * 16));
          const float bs = __int_as_float(__builtin_amdgcn_readlane(zi, 32 + (s8 & 1) * 16));
          const float ic = icv[s8];
          const float kk = kkr[s8] * rsqrtf(fmaxf(ss, 1e-24f));
          bsv = (lane == s8) ? bs : bsv;
          bp[s * 384 + 64 + lane] = -kk;
          bp[s * 384 + 128 + lane] = kk * ic;
          bp[s * 384 + 192 + lane] = kdv[s8];
          bp[s * 384 + 256 + lane] = rx[s8];
          bp[s * 384 + 320 + lane] = vx[s8];
        }
        if (lane < 8) bsum[(unsigned)(prow0 + (d ? -lane : lane)) * 32u + (unsigned)(h * 2 + d)] = bsv;
      }
    } else {
      if (it >= 1 && it <= 136) {
        const float* bp = buf + ((it - 1) & 1) * 12288;
        float* yb = ybuf + ((it - 1) & 1) * 2048;
        const int vo = 320 + 16 * w + (lane & 15);
        float W0, A0, B0, K0, R0, V0, W1, A1, B1, K1, R1, V1;
        SCAN_LOAD(W0, A0, B0, K0, R0, V0, 0)
#pragma unroll 1
        for (int s = 0; s < 32; s += 4) {
          float yp0, yp1, yp2, yp3;
          SCAN_STEP(W0, A0, B0, K0, R0, V0, yp0, SCAN_LOAD(W1, A1, B1, K1, R1, V1, s + 1))
          SCAN_STEP(W1, A1, B1, K1, R1, V1, yp1, SCAN_LOAD(W0, A0, B0, K0, R0, V0, s + 2))
          SCAN_STEP(W0, A0, B0, K0, R0, V0, yp2, SCAN_LOAD(W1, A1, B1, K1, R1, V1, s + 3))
          const int s4 = (s + 4 < 32) ? s + 4 : 31;
          SCAN_STEP(W1, A1, B1, K1, R1, V1, yp3, SCAN_LOAD(W0, A0, B0, K0, R0, V0, s4))
          {
            auto p01 = __builtin_amdgcn_permlane32_swap(__float_as_uint(yp0), __float_as_uint(yp1), false, false);
            auto p23 = __builtin_amdgcn_permlane32_swap(__float_as_uint(yp2), __float_as_uint(yp3), false, false);
            const float u01 = __uint_as_float(p01[0]) + __uint_as_float(p01[1]);
            const float u23 = __uint_as_float(p23[0]) + __uint_as_float(p23[1]);
            auto pz = __builtin_amdgcn_permlane16_swap(__float_as_uint(u01), __float_as_uint(u23), false, false);
            const float z = __uint_as_float(pz[0]) + __uint_as_float(pz[1]);
            const int rho = lane >> 4;
            const int smap = ((rho & 1) << 1) | (rho >> 1);
            yb[(s + smap) * 64 + 16 * w + (lane & 15)] = z;
          }
        }
      }
    }
    __syncthreads();
  }
}

__device__ __forceinline__ void phase_readout(const Ctx& p, int idx, int nrows, const int tid) {
  u16* y0 = (u16*)(p.ws);
  const u16* y1 = (const u16*)(p.ws + 3 * SLOT);
  const u16* vb = (const u16*)(p.ws + 5 * SLOT);
  const u16* gb = (const u16*)(p.ws + 4 * SLOT);
  const float* bsum = (const float*)(p.ws + OFF_BSUM);
  const float* lw = p.in[29] + idx * 1024;
  const float* lb = p.in[30] + idx * 1024;
  int lane = tid & 63, wv = tid >> 6;
  const int stride = gridDim.x * 8;
  for (int row0 = blockIdx.x * 8 + wv; row0 < nrows; row0 += 2 * stride) {
    const bool v1 = (row0 + stride) < nrows;
    uint4 ld[2][8];
    float bs0[2], bs1[2];
#pragma unroll
    for (int u = 0; u < 2; ++u) {
      const int row = row0 + u * stride;
      if (u == 0 || v1) {
        const size_t o = (size_t)row * 1024 + lane * 16;
        ld[u][0] = *(const uint4*)(y0 + o); ld[u][1] = *(const uint4*)(y0 + o + 8);
        ld[u][2] = *(const uint4*)(y1 + o); ld[u][3] = *(const uint4*)(y1 + o + 8);
        ld[u][4] = *(const uint4*)(vb + o); ld[u][5] = *(const uint4*)(vb + o + 8);
        ld[u][6] = *(const uint4*)(gb + o); ld[u][7] = *(const uint4*)(gb + o + 8);
        const int hh = lane >> 2;
        bs0[u] = bsum[(size_t)row * 32 + hh * 2]; bs1[u] = bsum[(size_t)row * 32 + hh * 2 + 1];
      }
    }
#pragma unroll
    for (int u = 0; u < 2; ++u) {
      const int row = row0 + u * stride;
      if (u == 0 || v1) {
        const size_t o = (size_t)row * 1024 + lane * 16;
        const uint4 a0 = ld[u][0], a1 = ld[u][1], b0 = ld[u][2], b1 = ld[u][3], v0 = ld[u][4], v1q = ld[u][5], g0 = ld[u][6], g1 = ld[u][7];
        unsigned ya[8] = {a0.x, a0.y, a0.z, a0.w, a1.x, a1.y, a1.z, a1.w};
        unsigned yb[8] = {b0.x, b0.y, b0.z, b0.w, b1.x, b1.y, b1.z, b1.w};
        unsigned vv[8] = {v0.x, v0.y, v0.z, v0.w, v1q.x, v1q.y, v1q.z, v1q.w};
        unsigned gg[8] = {g0.x, g0.y, g0.z, g0.w, g1.x, g1.y, g1.z, g1.w};
        float y[16];
        float sum = 0.f;
#pragma unroll
        for (int q = 0; q < 8; ++q) {
          y[2 * q] = bflo(ya[q]) + bflo(yb[q]);
          y[2 * q + 1] = bfhi(ya[q]) + bfhi(yb[q]);
          sum += y[2 * q] + y[2 * q + 1];
        }
        sum += __shfl_xor(sum, 1); sum += __shfl_xor(sum, 2);
        float mean = sum * (1.f / 64.f);
        float var = 0.f;
#pragma unroll
        for (int q = 0; q < 16; ++q) { float dd = y[q] - mean; var += dd * dd; }
        var += __shfl_xor(var, 1); var += __shfl_xor(var, 2);
        float rstd = rsqrtf(var * (1.f / 64.f) + 64e-5f);
        float bon = bs0[u] + bs1[u];
        unsigned ov[8];
#pragma unroll
        for (int q = 0; q < 8; ++q) {
          int c = lane * 16 + 2 * q;
          float o0 = ((y[2 * q] - mean) * rstd * lw[c] + lb[c] + bon * bflo(vv[q])) * bflo(gg[q]);
          float o1 = ((y[2 * q + 1] - mean) * rstd * lw[c + 1] + lb[c + 1] + bon * bfhi(vv[q])) * bfhi(gg[q]);
          ov[q] = pack2(o0, o1);
        }
        *(uint4*)(y0 + o) = make_uint4(ov[0], ov[1], ov[2], ov[3]);
        *(uint4*)(y0 + o + 8) = make_uint4(ov[4], ov[5], ov[6], ov[7]);
      }
    }
  }
}

__device__ __forceinline__ void phase_final(const Ctx& p, const int tid) {
  const float* gam = p.in[32];
  int lane = tid & 63, wv = tid >> 6;
  for (int row = blockIdx.x * 8 + wv; row < TL; row += gridDim.x * 8) {
    float* src = p.out + (size_t)row * 1024;
    float4 x[4];
    float ss = 0.f;
#pragma unroll
    for (int q = 0; q < 4; ++q) {
      x[q] = *(const float4*)(src + q * 256 + lane * 4);
      {
        uint2 dv = *(const uint2*)((const u16*)p.ws + (size_t)row * 1024 + q * 256 + lane * 4);
        x[q].x += bflo(dv.x); x[q].y += bfhi(dv.x); x[q].z += bflo(dv.y); x[q].w += bfhi(dv.y);
      }
      ss += x[q].x * x[q].x + x[q].y * x[q].y + x[q].z * x[q].z + x[q].w * x[q].w;
    }
    ss = wave_sum(ss);
    float rstd = rsqrtf(ss * (1.f / 1024.f) + 1e-6f);
#pragma unroll
    for (int q = 0; q < 4; ++q) {
      int col = q * 256 + lane * 4;
      float4 g = *(const float4*)(gam + col);
      float4 o = make_float4(x[q].x * rstd * g.x, x[q].y * rstd * g.y, x[q].z * rstd * g.z, x[q].w * rstd * g.w);
#if PROBE_STEPS
      { long long tt = *(const long long*)(p.ws + OFF_PROBE); int n2 = (int)(tt / 100); if (n2 > 30000) n2 = 30000;
        if (q == 0 && lane == 0 && row < n2) o.x += 0.125f; }
#endif
      *(float4*)(src + col) = o;
    }
  }
}

__device__ __forceinline__ void gemm_run_plain(const Ctx& p, char* smem, const int kind, const int layer, const int total, const int vbid, int tid) {
  u16* As = (u16*)smem;
  u16* Bs = As + 2 * 256 * 72;
  int ntile = vbid;
  bool first = true;
  GD g; LdSt Lc;
  Stg R0, R1;
  Frg F0, F1;
  for (;;) {
    const bool has_next = ntile < total;
    asm volatile("" : "+v"(tid));
    const int lane = tid & 63, w = tid >> 6, wm = w >> 1, wn = w & 1;
    const int lr = tid >> 3, lc = (tid & 7) * 8;
    const int sto = lr * 72 + lc;
    GD gn; make_gd(p, kind, layer, has_next ? ntile : total - 1, gn);
    LdSt Ln; ld_setup(Ln, gn, lr, lc);
    __builtin_amdgcn_s_waitcnt(0xC07F);
    if (first) {
      if (!has_next) break;
      g = gn; Lc = Ln;
      GEMM_LOADX(R0, Lc, 0)
      GEMM_LOADX(R1, Lc, 1)
      GEMM_STORE(R0, 0)
      __syncthreads();
      GEMM_READF(F0, 0, 0)
      first = false; ntile += gridDim.x;
      continue;
    }
    f32x16 acc[2][2];
#pragma unroll
    for (int i = 0; i < 2; ++i)
#pragma unroll
      for (int j = 0; j < 2; ++j)
#pragma unroll
        for (int r = 0; r < 16; ++r) acc[i][j][r] = 0.f;
    const int nk = Lc.nk;
    if (nk > 2) {
      GEMM_KSTEP(0, R0, Lc, 2, R1)
      GEMM_KSTEP(1, R1, Lc, 3, R0)
    }
    __builtin_amdgcn_s_waitcnt(0x0070);
    for (int kt = 2; kt + 2 < nk; kt += 2) {
      GEMM_KSTEP(0, R0, Lc, kt + 2, R1)
      GEMM_KSTEP(1, R1, Lc, kt + 3, R0)
    }
    GEMM_KSTEP(0, R0, Ln, 0, R1)
    GEMM_KSTEP_LAST(1, R1, Ln, 1, R0)
    gemm_epilogue(p, g, acc, tid);
    if (!has_next) break;
    GEMM_READF(F0, 0, 0)
    g = gn; Lc = Ln; ntile += gridDim.x;
  }
  __syncthreads();
}

__global__ void __launch_bounds__(512) fwd_megakernel(Params p0) {
  Ctx p; p.in = p0.in; p.out = p0.out; p.ws = p0.ws;
  extern __shared__ __attribute__((aligned(16))) char smem[];
  cg::grid_group grid = cg::this_grid();

  int tid0 = threadIdx.x;
  asm volatile("" : "+v"(tid0));
  phase_mod(p, smem, tid0);
  asm volatile("" : "+v"(tid0));
  convert_weights(p, smem, 0, tid0);
  grid.sync();
  for (int ph = 0; ph < 40; ++ph) {
    const int layer = ph / 10, step = ph % 10;
    const int idx = layer >> 1;
    const bool rw = (layer & 1) == 0;
    const bool ctx_in = layer <= 2, ctx_out = layer < 2;
    const int rows_in = ctx_in ? T : TL, rows_out = ctx_out ? T : TL;
    int gk = -1;
    int tid = threadIdx.x;
    Ctx q; q.in = p0.in;
    {
      unsigned long long w_ = (unsigned long long)p0.ws, o_ = (unsigned long long)p0.out;
      unsigned wl = __builtin_amdgcn_readfirstlane((unsigned)w_), wh = __builtin_amdgcn_readfirstlane((unsigned)(w_ >> 32));
      unsigned ol = __builtin_amdgcn_readfirstlane((unsigned)o_), oh = __builtin_amdgcn_readfirstlane((unsigned)(o_ >> 32));
      asm volatile("" : "+s"(wl), "+s"(wh), "+s"(ol), "+s"(oh));
      q.ws = (char*)(((unsigned long long)wh << 32) | wl);
      q.out = (float*)(((unsigned long long)oh << 32) | ol);
    }
#if PROBE_STEPS
    if (blockIdx.x == 0 && tid == 0) ((long long*)(q.ws + OFF_PROBE))[1] = wall_clock64();
#endif
#define OPAQUE_TID() asm volatile("" : "+v"(tid))
    if (step == 0 || step == 7) {
      OPAQUE_TID();
      {
        const u16* dl = (step == 7) ? (const u16*)(q.ws + (rw ? 1 : 2) * SLOT) : ((ph == 0) ? (const u16*)nullptr : (const u16*)q.ws);
        const int drows = (step == 7) ? rows_out : ((layer - 1) < 2 ? T : TL);
        prep_rows(q, layer, step == 0 ? 0 : 1, step == 0 ? rows_in : rows_out, ph == 0, dl, drows, tid);
      }
      if (step == 0) {
        OPAQUE_TID();
        if (layer > 0) convert_weights(q, smem, layer, tid);
        if (!rw) { OPAQUE_TID(); fourier_tables(q, ctx_in, tid); }
      }
    } else if (step == 1) gk = rw ? G_RB : G_FB;
    else if (step == 2) gk = rw ? G_RC : G_F1;
    else if (step == 3) { if (rw && idx != 1) continue; gk = rw ? G_RC2 : G_F2; }
    else if (step == 4) { if (!rw) continue; OPAQUE_TID(); phase_scan(q, smem, idx, ctx_out, tid); }
    else if (step == 5) { if (!rw) continue; OPAQUE_TID(); phase_readout(q, idx, rows_out, tid); }
    else if (step == 6) gk = rw ? G_WO_R : G_WO_F;
    else if (step == 8) gk = G_MLP1;
    else gk = G_MLP2;
    if (gk >= 0) {
      const int total = gemm_total(gk, layer);
      const int vbid = (int)(blockIdx.x & 7) * (int)(gridDim.x >> 3) + (int)(blockIdx.x >> 3);
      if (gk == G_RB || gk == G_RC2) {
        for (int tile = vbid; tile < total; tile += gridDim.x) {
          GD g;
          make_gd(q, gk, layer, tile, g);
          OPAQUE_TID();
          gemm_tile_mix(q, smem, g, tid);
        }
      } else {
        gemm_run_plain(q, smem, gk, layer, total, vbid, tid);
      }
    }
    grid.sync();
#if PROBE_STEPS
    if (blockIdx.x == 0 && threadIdx.x == 0) {
      long long* pr = (long long*)(p.ws + OFF_PROBE);
      if (ph == 0) pr[0] = 0;
      if (((PROBE_STEPS >> step) & 1) && ((PROBE_LAYERS >> layer) & 1)) pr[0] += wall_clock64() - pr[1];
    }
#endif
  }
#if PROBE_STEPS
  grid.sync();
#endif
  int tid1 = threadIdx.x;
  asm volatile("" : "+v"(tid1));
  phase_final(p, tid1);
}

extern "C" void kernel_launch(void* const* d_in, const int* in_sizes, int n_in,
                              void* d_out, int out_size, void* d_ws, size_t ws_size,
                              hipStream_t stream) {
  static int grid_blocks = 0;
  if (!grid_blocks) {
    int dev = 0, cus = 0, per_cu = 0;
    (void)hipGetDevice(&dev);
    (void)hipDeviceGetAttribute(&cus, hipDeviceAttributeMultiprocessorCount, dev);
    if (hipFuncSetAttribute((const void*)fwd_megakernel, hipFuncAttributeMaxDynamicSharedMemorySize, LDS_BYTES) != hipSuccess)
      fprintf(stderr, "hipFuncSetAttribute failed\n");
    (void)hipOccupancyMaxActiveBlocksPerMultiprocessor(&per_cu, (const void*)fwd_megakernel, 512, LDS_BYTES);
    if (per_cu < 1) { fprintf(stderr, "occupancy query returned %d\n", per_cu); per_cu = 1; }
    (void)hipGetLastError();
    grid_blocks = cus;
    if (ws_size < WS_END) fprintf(stderr, "workspace too small: %zu < %zu\n", ws_size, (size_t)WS_END);
  }
  Params p{};
  for (int i = 0; i < 33; ++i) p.in[i] = (const float*)d_in[i];
  p.out = (float*)d_out;
  p.ws = (char*)d_ws;
  void* args[] = {&p};
  hipError_t e = hipLaunchCooperativeKernel((const void*)fwd_megakernel, dim3(grid_blocks), dim3(512), args, LDS_BYTES, stream);
  if (e != hipSuccess) fprintf(stderr, "cooperative launch failed: %s (grid %d)\n", hipGetErrorString(e), grid_blocks);
}
```

```cpp
#include <hip/hip_runtime.h>
#include <hip/hip_cooperative_groups.h>
#include <cstdio>
namespace cg = cooperative_groups;

typedef unsigned short u16;
typedef __attribute__((ext_vector_type(8))) short bf16x8;
typedef __attribute__((ext_vector_type(16))) float f32x16;
typedef __attribute__((ext_vector_type(4))) float f32x4;
typedef __attribute__((ext_vector_type(2))) float f32x2;
typedef __attribute__((ext_vector_type(2))) __bf16 bf16x2v;

constexpr int TL = 8 * 4096, TC = 8 * 256, T = TL + TC;
constexpr size_t SLOT = (size_t)T * 1024 * 2;
constexpr size_t OFF_CTXRES = 6 * SLOT;
constexpr size_t OFF_MOD = OFF_CTXRES + (size_t)TC * 1024 * 4;
constexpr size_t OFF_HW = OFF_MOD + 4 * 9 * 6144 * 4;
constexpr size_t OFF_HA = OFF_HW + (size_t)T * 128 * 2;
constexpr size_t OFF_HG = OFF_HA + (size_t)T * 128 * 2;
constexpr size_t OFF_HV = OFF_HG + (size_t)T * 128 * 2;
constexpr size_t OFF_BSUM = OFF_HV + (size_t)T * 128 * 2;
constexpr size_t OFF_WMIX = OFF_BSUM + (size_t)T * 32 * 4;
constexpr size_t M1 = 1048576;
constexpr size_t WMIX_ELEMS = 4 * M1 + 6 * 131072;
constexpr size_t OFF_WMLP = OFF_WMIX + WMIX_ELEMS * 2;
constexpr size_t WS_END = OFF_WMLP + 2 * 4 * M1 * 2;
constexpr int LDS_BYTES = 131072;
#ifndef PROBE_STEPS
#define PROBE_STEPS 0
#endif
#ifndef PROBE_LAYERS
#define PROBE_LAYERS 15
#endif
constexpr size_t OFF_PROBE = WS_END;

struct Params {
  const float* in[33];
  float* out;
  char* ws;
};
struct Ctx { const float* const* in; float* out; char* ws; };

__device__ __forceinline__ unsigned pack2(float a, float b) {
  f32x2 v = {a, b};
  bf16x2v r = __builtin_convertvector(v, bf16x2v);
  return __builtin_bit_cast(unsigned, r);
}
__device__ __forceinline__ u16 f2bf(float a) { return (u16)(pack2(a, 0.f) & 0xffffu); }
__device__ __forceinline__ float bflo(unsigned u) { return __uint_as_float(u << 16); }
__device__ __forceinline__ float bfhi(unsigned u) { return __uint_as_float(u & 0xffff0000u); }
__device__ __forceinline__ float bf2f(u16 h) { return __uint_as_float(((unsigned)h) << 16); }
typedef __attribute__((ext_vector_type(4))) float nf4;
typedef __attribute__((ext_vector_type(2))) unsigned nu2;
__device__ __forceinline__ float4 ntload4(const float* ptr) { nf4 v = __builtin_nontemporal_load((const nf4*)ptr); return make_float4(v[0], v[1], v[2], v[3]); }
__device__ __forceinline__ uint2 ntload2(const u16* ptr) { nu2 v = __builtin_nontemporal_load((const nu2*)ptr); return make_uint2(v[0], v[1]); }
__device__ __forceinline__ void ntstore4(float* ptr, float4 x) { nf4 v = {x.x, x.y, x.z, x.w}; __builtin_nontemporal_store(v, (nf4*)ptr); }
__device__ __forceinline__ float wave_sum(float v) {
#pragma unroll
  for (int o = 32; o > 0; o >>= 1) v += __shfl_xor(v, o);
  return v;
}
#define DPP_ROR_ADD(x, n) x += __builtin_bit_cast(float, __builtin_amdgcn_update_dpp(0, __builtin_bit_cast(int, x), 0x120 + (n), 0xf, 0xf, true))
__device__ __forceinline__ float sigmoidf_(float x) { return __builtin_amdgcn_rcpf(1.f + __expf(-x)); }
__device__ __forceinline__ float xrow_sum(float x) {
  unsigned u = __float_as_uint(x);
  auto r = __builtin_amdgcn_permlane32_swap(u, u, false, false);
  float s = __uint_as_float(r[0]) + __uint_as_float(r[1]);
  u = __float_as_uint(s);
  auto r2 = __builtin_amdgcn_permlane16_swap(u, u, false, false);
  return __uint_as_float(r2[0]) + __uint_as_float(r2[1]);
}

__device__ __forceinline__ float wave_sum_fast(float x) {
  DPP_ROR_ADD(x, 8); DPP_ROR_ADD(x, 4); DPP_ROR_ADD(x, 2); DPP_ROR_ADD(x, 1);
  return xrow_sum(x);
}

__device__ __forceinline__ void phase_mod(const Ctx& p, char* smem, const int tid) {
  float* sv = (float*)smem;
  float* red = sv + 9 * 1024;
  const float* c = p.in[1];
  const float* cc = p.in[3];
  const float* mod_w = p.in[6];
  const float* mod_b = p.in[7];
  float* mod = (float*)(p.ws + OFF_MOD);
  for (int e = tid; e < 9 * 1024; e += 512) {
    int j = e >> 10, k = e & 1023;
    float v = (j < 8) ? c[j * 1024 + k] : cc[k];
    sv[e] = v / (1.f + expf(-v));
  }
  __syncthreads();
  for (int item = blockIdx.x; item < 384; item += gridDim.x) {
    int layer = item / 96, c0 = (item % 96) * 64;
    int kq = tid >> 6, col = tid & 63;
    const float* w = mod_w + (size_t)layer * 1024 * 6144 + c0 + col;
    float acc[9];
#pragma unroll
    for (int j = 0; j < 9; ++j) acc[j] = 0.f;
#pragma unroll 8
    for (int k = kq * 128; k < kq * 128 + 128; ++k) {
      float wv = w[(size_t)k * 6144];
#pragma unroll
      for (int j = 0; j < 9; ++j) acc[j] += sv[j * 1024 + k] * wv;
    }
#pragma unroll
    for (int j = 0; j < 9; ++j) red[(kq * 9 + j) * 64 + col] = acc[j];
    __syncthreads();
    for (int e = tid; e < 9 * 64; e += 512) {
      int j = e >> 6, cx = e & 63;
      float s = 0.f;
#pragma unroll
      for (int q = 0; q < 8; ++q) s += red[(q * 9 + j) * 64 + cx];
      s += mod_b[layer * 6144 + c0 + cx];
      mod[(layer * 9 + j) * 6144 + c0 + cx] = s;
    }
    __syncthreads();
  }
}

__device__ __forceinline__ void prep_rows(const Ctx& p, int layer, int which, int nrows, bool from_input, const u16* delta, int drows, const int tid) {
  const float* gam = (which == 0 ? p.in[4] : p.in[5]) + layer * 1024;
  const float* mod = (const float*)(p.ws + OFF_MOD);
  float* ctxres = (float*)(p.ws + OFF_CTXRES);
  u16* H = (u16*)(p.ws);
  int lane = tid & 63, wv = tid >> 6;
  const int stride = gridDim.x * 8;
  for (int row0 = blockIdx.x * 8 + wv; row0 < nrows; row0 += 2 * stride) {
    float4 x[2][4];
    uint2 dv[2][4];
    const bool v1 = (row0 + stride) < nrows;
#pragma unroll
    for (int u = 0; u < 2; ++u) {
      const int row = row0 + u * stride;
      if (u == 0 || v1) {
        const float* src = (row < TL) ? ((from_input ? p.in[0] : p.out) + (size_t)row * 1024) : ((from_input ? p.in[2] : ctxres) + (size_t)(row - TL) * 1024);
        const bool upd = (delta != nullptr) && (row < drows);
#pragma unroll
        for (int q = 0; q < 4; ++q) {
          x[u][q] = ntload4(src + q * 256 + lane * 4);
          dv[u][q] = make_uint2(0, 0);
          if (upd) dv[u][q] = ntload2(delta + (size_t)row * 1024 + q * 256 + lane * 4);
        }
      }
    }
#pragma unroll
    for (int u = 0; u < 2; ++u) {
      const int row = row0 + u * stride;
      if (u == 0 || v1) {
        float* dst = (row < TL) ? (p.out + (size_t)row * 1024) : (ctxres + (size_t)(row - TL) * 1024);
        const bool upd = (delta != nullptr) && (row < drows);
        float ss = 0.f;
#pragma unroll
        for (int q = 0; q < 4; ++q) {
          x[u][q].x += bflo(dv[u][q].x); x[u][q].y += bfhi(dv[u][q].x); x[u][q].z += bflo(dv[u][q].y); x[u][q].w += bfhi(dv[u][q].y);
          ss += x[u][q].x * x[u][q].x + x[u][q].y * x[u][q].y + x[u][q].z * x[u][q].z + x[u][q].w * x[u][q].w;
        }
        ss = wave_sum(ss);
        float rstd = rsqrtf(ss * (1.f / 1024.f) + 1e-6f);
        int j = (row < TL) ? (row >> 12) : 8;
        const float* mp = mod + (size_t)(layer * 9 + j) * 6144 + which * 3072;
#pragma unroll
        for (int q = 0; q < 4; ++q) {
          int col = q * 256 + lane * 4;
          if (from_input || upd) ntstore4(dst + col, x[u][q]);
          float4 g = *(const float4*)(gam + col);
          float4 sh = *(const float4*)(mp + col);
          float4 sc = *(const float4*)(mp + 1024 + col);
          float h0 = x[u][q].x * rstd * g.x * (1.f + sc.x) + sh.x;
          float h1 = x[u][q].y * rstd * g.y * (1.f + sc.y) + sh.y;
          float h2 = x[u][q].z * rstd * g.z * (1.f + sc.z) + sh.z;
          float h3 = x[u][q].w * rstd * g.w * (1.f + sc.w) + sh.w;
          uint2 o; o.x = pack2(h0, h1); o.y = pack2(h2, h3);
          *(uint2*)(H + (size_t)row * 1024 + col) = o;
        }
      }
    }
  }
}

struct CJ { const float* src; int K, N, ld; u16* dst; int ldd, Kp, Np; };
__device__ __forceinline__ void get_cj(const Ctx& p, int layer, int j, CJ& c) {
  const int idx = layer >> 1;
  u16* wm = (u16*)(p.ws + OFF_WMIX);
  u16* wl = (u16*)(p.ws + OFF_WMLP);
  c.K = 1024; c.N = 1024; c.ld = 1024; c.ldd = 1024; c.Kp = 1024; c.Np = 1024; c.src = nullptr; c.dst = nullptr;
  if (j == 0) { c.src = p.in[8] + (size_t)layer * 4 * M1; c.N = 4096; c.ld = 4096; c.dst = wl; c.Np = 4096; }
  else if (j == 1) { c.src = p.in[9] + (size_t)layer * 4 * M1; c.K = 4096; c.dst = wl + 4 * M1; c.ldd = 4096; c.Kp = 4096; }
  else if (layer & 1) { c.src = p.in[31] + (size_t)idx * M1; c.dst = wm; }
  else if (j < 6) { c.src = p.in[11 + (j - 2)] + (size_t)idx * M1; c.dst = wm + (size_t)(j - 2) * M1; }
  else if (j < 10) {
    int d = j & 1; bool isa = j >= 8;
    c.src = p.in[isa ? 19 : 16] + (size_t)(idx * 2 + d) * 65536; c.N = 64; c.ld = 64; c.Np = 64;
    c.dst = wm + 4 * M1 + (isa ? 131072 : 0) + d * 65536;
  }
  else if (j == 10) { c.src = p.in[24] + (size_t)idx * 131072; c.N = 128; c.ld = 128; c.Np = 128; c.dst = wm + 4 * M1 + 2 * 131072; }
  else if (j == 11) { c.src = p.in[25] + (size_t)idx * 131072; c.K = 128; c.Kp = 128; c.ldd = 128; c.dst = wm + 4 * M1 + 4 * 131072; }
  else if (j == 12) { c.src = p.in[22]; c.N = 32; c.ld = 32; c.Np = 128; c.dst = wm + 4 * M1 + 3 * 131072; }
  else { c.src = p.in[23]; c.K = 32; c.Kp = 128; c.ldd = 128; c.dst = wm + 4 * M1 + 5 * 131072; }
}

__device__ __forceinline__ void convert_weights(const Ctx& p, char* smem, int layer, const int tid) {
  float* tile = (float*)smem;
  const int nj = (layer & 1) ? 3 : ((layer >> 1) == 1 ? 14 : 12);
  int rot = 0;
  for (int j = 0; j < nj; ++j) {
    CJ c; get_cj(p, layer, j, c);
    const int nnt = c.Np >> 6, ntiles = (c.Kp >> 6) * nnt;
    int start = (int)blockIdx.x - rot; if (start < 0) start += gridDim.x;
    for (int t = start; t < ntiles; t += gridDim.x) {
      int k0 = (t / nnt) << 6, n0 = (t % nnt) << 6;
      int r = tid >> 4, c4 = (tid & 15) * 4;
#pragma unroll
      for (int hh = 0; hh < 2; ++hh) {
        int rr = r + hh * 32;
        float4 v = make_float4(0.f, 0.f, 0.f, 0.f);
        if (k0 + rr < c.K && n0 + c4 < c.N) v = *(const float4*)(c.src + (size_t)(k0 + rr) * c.ld + n0 + c4);
        tile[(c4 + 0) * 65 + rr] = v.x; tile[(c4 + 1) * 65 + rr] = v.y; tile[(c4 + 2) * 65 + rr] = v.z; tile[(c4 + 3) * 65 + rr] = v.w;
      }
      __syncthreads();
      int n = tid >> 3, kc = (tid & 7) * 8;
      const float* tp = tile + n * 65 + kc;
      uint4 o;
      o.x = pack2(tp[0], tp[1]); o.y = pack2(tp[2], tp[3]); o.z = pack2(tp[4], tp[5]); o.w = pack2(tp[6], tp[7]);
      *(uint4*)(c.dst + (size_t)(n0 + n) * c.ldd + k0 + kc) = o;
      __syncthreads();
    }
    rot = (rot + ntiles) % (int)gridDim.x;
  }
}

__device__ __forceinline__ void fourier_tables(const Ctx& p, bool with_ctx, const int tid) {
  u16* wm = (u16*)(p.ws + OFF_WMIX);
  u16* dftT = wm + M1;
  u16* m1t = dftT + 131072;
  u16* m2t = m1t + 16384;
  u16* dftC = m2t + 8192;
  float2* tw = (float2*)(dftC + 131072);
  size_t gtid = (size_t)blockIdx.x * 512 + tid, gsz = (size_t)gridDim.x * 512;
  for (size_t e = gtid; e < 512 * 256 / 8; e += gsz) {
    int r = (int)(e >> 5), c0 = (int)(e & 31) * 8;
    int ri = r >> 8, m = r & 255;
    float v[8];
#pragma unroll
    for (int q = 0; q < 8; ++q) {
      int ph = (m * (c0 + q)) & 255;
      float s, c; sincospif((float)ph * (1.f / 128.f), &s, &c);
      v[q] = (ri ? s : c) * (1.f / 16.f);
    }
    uint4 o; o.x = pack2(v[0], v[1]); o.y = pack2(v[2], v[3]); o.z = pack2(v[4], v[5]); o.w = pack2(v[6], v[7]);
    *(uint4*)(dftT + (size_t)r * 256 + c0) = o;
  }
  for (size_t e = gtid; e < 128 * 128; e += gsz) {
    int rho = (int)(e >> 7), kap = (int)(e & 127);
    int qq = rho >> 5, part = qq & 1, k1 = (qq >> 1) * 32 + (rho & 31);
    int ri = kap >> 6, l1 = kap & 63;
    int ph = (k1 * l1) & 63;
    float s, c; sincospif((float)ph * (1.f / 32.f), &s, &c);
    float v = (part == 0) ? (ri == 0 ? c : -s) : (ri == 0 ? -s : -c);
    m1t[e] = f2bf(v);
  }
  for (size_t e = gtid; e < 64 * 128; e += gsz) {
    int k2 = (int)(e >> 7), kap = (int)(e & 127);
    int ri = kap >> 6, l2 = kap & 63;
    int ph = (k2 * l2) & 63;
    float s, c; sincospif((float)ph * (1.f / 32.f), &s, &c);
    m2t[e] = f2bf((ri == 0 ? c : s) * (1.f / 64.f));
  }
  for (size_t e = gtid; e < 64 * 64; e += gsz) {
    int k1 = (int)(e >> 6), l2 = (int)(e & 63);
    float s, c; sincospif((float)(k1 * l2) * (1.f / 2048.f), &s, &c);
    tw[e] = make_float2(c, s);
  }
  if (with_ctx) {
    for (size_t e = gtid; e < 256 * 512 / 8; e += gsz) {
      int k = (int)(e >> 6), kap = (int)(e & 63) * 8;
      int ri = kap >> 8, l0 = kap & 255;
      float v[8];
#pragma unroll
      for (int q = 0; q < 8; ++q) {
        int ph = (k * (l0 + q)) & 255;
        float s, c; sincospif((float)ph * (1.f / 128.f), &s, &c);
        v[q] = (ri ? -s : c) * (1.f / 16.f);
      }
      uint4 o; o.x = pack2(v[0], v[1]); o.y = pack2(v[2], v[3]); o.z = pack2(v[4], v[5]); o.w = pack2(v[6], v[7]);
      *(uint4*)(dftC + (size_t)k * 512 + kap) = o;
    }
  }
}

struct GD {
  const u16* A; long lda; int a_rowmask; int a_mode; const float* mu;
  const u16* B; long b_rs_hi, b_rs_lo; int b_kshift; long b_kstride; int b_perm; int a_kshift; long a_kstride;
  int K, m0, n0;
  int ep; u16* out; long ldo; u16* out2; const float* e0; const u16* gsrc;
};
__device__ __forceinline__ void gd_plainA(GD& g, const u16* A, long lda) { g.A = A; g.lda = lda; g.a_rowmask = 0x7fffffff; g.a_mode = 0; g.mu = nullptr; g.a_kshift = 30; g.a_kstride = 0; }
__device__ __forceinline__ void gd_mixA(GD& g, const u16* H, const float* mu) { g.A = H; g.lda = 1024; g.a_rowmask = 0x7fffffff; g.a_mode = 1; g.mu = mu; g.a_kshift = 30; g.a_kstride = 0; }
__device__ __forceinline__ void gd_plainB(GD& g, const u16* B, long ldb) { g.B = B; g.b_rs_hi = 256 * ldb; g.b_rs_lo = ldb; g.b_kshift = 30; g.b_kstride = 0; g.b_perm = 0; }

__device__ __forceinline__ unsigned mix2(unsigned h, unsigned s, float m0, float m1) {
  float h0 = bflo(h), h1 = bfhi(h), s0 = bflo(s), s1 = bfhi(s);
  return pack2(h0 + (s0 - h0) * m0, h1 + (s1 - h1) * m1);
}

#define EPI_LOOP(LD, BODY) \
  _Pragma("unroll") for (int i = 0; i < 2; ++i) { _Pragma("unroll") for (int j = 0; j < 2; ++j) { \
    _Pragma("unroll") for (int r = 0; r < 16; ++r) { \
      const int off = (32 * i + (r & 3) + 8 * (r >> 2)) * (LD) + 32 * j; \
      const float v = acc[i][j][r]; BODY } \
    asm volatile("" ::: "memory"); } }

struct Stg { uint4 a0, a1, a2, a3, b0, b1; };

__device__ __forceinline__ int mix_nb(int t, int k) {
  int nb = -1;
  if (t < TL) {
    int l = t & 4095, c = l & 63, r = l >> 6, qq = k >> 8;
    if (qq == 0) nb = (c > 0) ? t - 1 : -1;
    else if (qq == 1) nb = (c < 63) ? t + 1 : -1;
    else if (qq == 2) nb = (r > 0) ? t - 64 : -1;
    else nb = (r < 63) ? t + 64 : -1;
  } else {
    int pp = (t - TL) & 255;
    if (k < 512) nb = (pp > 0) ? t - 1 : -1; else nb = (pp < 255) ? t + 1 : -1;
  }
  return nb;
}
__device__ __forceinline__ uint4 ld16(const u16* ptr) { return *(const uint4*)ptr; }
__device__ __forceinline__ uint4 mix4(uint4 h, uint4 s, float4 m0, float4 m1) {
  uint4 o;
  o.x = mix2(h.x, s.x, m0.x, m0.y); o.y = mix2(h.y, s.y, m0.z, m0.w);
  o.z = mix2(h.z, s.z, m1.x, m1.y); o.w = mix2(h.w, s.w, m1.z, m1.w);
  return o;
}

#define GEMM_HALF(KH) { \
    bf16x8 fa0[2], fa1[2], fb0[2], fb1[2]; \
    _Pragma("unroll") for (int kk = 0; kk < 2; ++kk) { \
      fa0[kk] = *(const bf16x8*)(ab + ((KH) * 2 + kk) * 16); \
      fb0[kk] = *(const bf16x8*)(bb + ((KH) * 2 + kk) * 16); \
      fa1[kk] = *(const bf16x8*)(ab + 32 * 72 + ((KH) * 2 + kk) * 16); \
      fb1[kk] = *(const bf16x8*)(bb + 32 * 72 + ((KH) * 2 + kk) * 16); } \
    __builtin_amdgcn_sched_barrier(0); \
    _Pragma("unroll") for (int kk = 0; kk < 2; ++kk) { \
      acc[0][0] = __builtin_amdgcn_mfma_f32_32x32x16_bf16(fa0[kk], fb0[kk], acc[0][0], 0, 0, 0); \
      acc[0][1] = __builtin_amdgcn_mfma_f32_32x32x16_bf16(fa0[kk], fb1[kk], acc[0][1], 0, 0, 0); \
      acc[1][0] = __builtin_amdgcn_mfma_f32_32x32x16_bf16(fa1[kk], fb0[kk], acc[1][0], 0, 0, 0); \
      acc[1][1] = __builtin_amdgcn_mfma_f32_32x32x16_bf16(fa1[kk], fb1[kk], acc[1][1], 0, 0, 0); \
    } \
    __builtin_amdgcn_sched_barrier(0); }
#define GEMM_COMPUTE(BUF) { \
    const u16* ab = As + (BUF) * 256 * 72 + (64 * wm + (lane & 31)) * 72 + 8 * (lane >> 5); \
    const u16* bb = Bs + (BUF) * 128 * 72 + (64 * wn + (lane & 31)) * 72 + 8 * (lane >> 5); \
    __builtin_amdgcn_sched_barrier(0); \
    GEMM_HALF(0) GEMM_HALF(1) }
struct Frg { bf16x8 a00, a01, a10, a11, b00, b01, b10, b11; };
#define GEMM_READF(F, BUF, KH) { \
    const u16* ab_ = As + (BUF) * 256 * 72 + (64 * wm + (lane & 31)) * 72 + 8 * (lane >> 5) + (KH) * 32; \
    const u16* bb_ = Bs + (BUF) * 128 * 72 + (64 * wn + (lane & 31)) * 72 + 8 * (lane >> 5) + (KH) * 32; \
    F.a00 = *(const bf16x8*)(ab_);           F.a01 = *(const bf16x8*)(ab_ + 16); \
    F.b00 = *(const bf16x8*)(bb_);           F.b01 = *(const bf16x8*)(bb_ + 16); \
    F.a10 = *(const bf16x8*)(ab_ + 32 * 72); F.a11 = *(const bf16x8*)(ab_ + 32 * 72 + 16); \
    F.b10 = *(const bf16x8*)(bb_ + 32 * 72); F.b11 = *(const bf16x8*)(bb_ + 32 * 72 + 16); }
#define GEMM_MFMA8(F) { \
    acc[0][0] = __builtin_amdgcn_mfma_f32_32x32x16_bf16(F.a00, F.b00, acc[0][0], 0, 0, 0); \
    acc[0][1] = __builtin_amdgcn_mfma_f32_32x32x16_bf16(F.a00, F.b10, acc[0][1], 0, 0, 0); \
    acc[1][0] = __builtin_amdgcn_mfma_f32_32x32x16_bf16(F.a10, F.b00, acc[1][0], 0, 0, 0); \
    acc[1][1] = __builtin_amdgcn_mfma_f32_32x32x16_bf16(F.a10, F.b10, acc[1][1], 0, 0, 0); \
    acc[0][0] = __builtin_amdgcn_mfma_f32_32x32x16_bf16(F.a01, F.b01, acc[0][0], 0, 0, 0); \
    acc[0][1] = __builtin_amdgcn_mfma_f32_32x32x16_bf16(F.a01, F.b11, acc[0][1], 0, 0, 0); \
    acc[1][0] = __builtin_amdgcn_mfma_f32_32x32x16_bf16(F.a11, F.b01, acc[1][0], 0, 0, 0); \
    acc[1][1] = __builtin_amdgcn_mfma_f32_32x32x16_bf16(F.a11, F.b11, acc[1][1], 0, 0, 0); }
#define GEMM_KSTEP_LAST(BUF, RLOAD, LSRC, KT, RSTORE) { \
    GEMM_READF(F1, BUF, 1) \
    GEMM_LOADX(RLOAD, LSRC, KT) \
    GEMM_STORE(RSTORE, (BUF) ^ 1) \
    __builtin_amdgcn_sched_barrier(0); \
    GEMM_MFMA8(F0) \
    __builtin_amdgcn_sched_barrier(0); \
    __syncthreads(); \
    GEMM_MFMA8(F1) \
    __builtin_amdgcn_sched_barrier(0); }
#define GEMM_KSTEP(BUF, RLOAD, LSRC, KT, RSTORE) { \
    GEMM_READF(F1, BUF, 1) \
    GEMM_LOADX(RLOAD, LSRC, KT) \
    GEMM_STORE(RSTORE, (BUF) ^ 1) \
    __builtin_amdgcn_sched_barrier(0); \
    GEMM_MFMA8(F0) \
    __builtin_amdgcn_sched_barrier(0); \
    __syncthreads(); \
    GEMM_READF(F0, (BUF) ^ 1, 0) \
    __builtin_amdgcn_sched_barrier(0); \
    GEMM_MFMA8(F1) \
    __builtin_amdgcn_sched_barrier(0); }
#define GEMM_LOADX(R, L, KT) { const int k0_ = min((KT), L.nk - 1) * 64; \
    const int soa_ = __builtin_amdgcn_readfirstlane((int)(((long)(k0_ >> L.akshift) * L.akstride + (k0_ & L.akmask)) * 2)); \
    const int sob_ = __builtin_amdgcn_readfirstlane((int)(((long)(k0_ >> L.kshift) * L.kstride + (k0_ & L.kmask)) * 2)); \
    const __amdgpu_buffer_rsrc_t rsA_ = make_rsrc(L.baseA); const __amdgpu_buffer_rsrc_t rsB_ = make_rsrc(L.baseB); \
    R.a0 = bufld(rsA_, L.va0, soa_); R.a1 = bufld(rsA_, L.va1, soa_); R.a2 = bufld(rsA_, L.va2, soa_); R.a3 = bufld(rsA_, L.va3, soa_); \
    R.b0 = bufld(rsB_, L.vb0, sob_); R.b1 = bufld(rsB_, L.vb1, sob_); }
#define GEMM_STORE(R, BUF) { u16* ad_ = As + (BUF) * 256 * 72 + sto; u16* bd_ = Bs + (BUF) * 128 * 72 + sto; \
    *(uint4*)(ad_) = R.a0; *(uint4*)(ad_ + 64 * 72) = R.a1; *(uint4*)(ad_ + 128 * 72) = R.a2; *(uint4*)(ad_ + 192 * 72) = R.a3; \
    *(uint4*)(bd_) = R.b0; *(uint4*)(bd_ + 64 * 72) = R.b1; }

typedef __attribute__((ext_vector_type(4))) unsigned u32x4;
__device__ __forceinline__ __amdgpu_buffer_rsrc_t make_rsrc(const u16* q) {
  unsigned long long v = (unsigned long long)q;
  unsigned lo = __builtin_amdgcn_readfirstlane((unsigned)v), hi = __builtin_amdgcn_readfirstlane((unsigned)(v >> 32));
  void* up = (void*)(((unsigned long long)hi << 32) | lo);
  return __builtin_amdgcn_make_buffer_rsrc(up, (short)0, 0x7ffffff0, 0x00020000);
}
__device__ __forceinline__ uint4 bufld(__amdgpu_buffer_rsrc_t rs, unsigned voff, int soff) {
  u32x4 v = __builtin_amdgcn_raw_buffer_load_b128(rs, (int)voff, soff, 0);
  return make_uint4(v[0], v[1], v[2], v[3]);
}

struct LdSt { const u16* baseA; const u16* baseB; unsigned va0, va1, va2, va3, vb0, vb1; int nk, kshift, kmask; long kstride; int akshift, akmask; long akstride; };
__device__ __forceinline__ void ld_setup(LdSt& L, const GD& g, const int lr, const int lc) {
  L.baseA = g.A; L.baseB = g.B + (long)(g.n0 >> 8) * g.b_rs_hi;
  const unsigned nl = (unsigned)(g.n0 & 255) + (unsigned)lr;
  L.vb0 = (nl * (unsigned)g.b_rs_lo + (unsigned)lc) * 2u;
  L.vb1 = ((nl + 64u) * (unsigned)g.b_rs_lo + (unsigned)lc) * 2u;
  const int t0 = g.m0 + lr;
  const unsigned ulda = (unsigned)g.lda;
  L.va0 = ((unsigned)((t0) & g.a_rowmask) * ulda + (unsigned)lc) * 2u;
  L.va1 = ((unsigned)((t0 + 64) & g.a_rowmask) * ulda + (unsigned)lc) * 2u;
  L.va2 = ((unsigned)((t0 + 128) & g.a_rowmask) * ulda + (unsigned)lc) * 2u;
  L.va3 = ((unsigned)((t0 + 192) & g.a_rowmask) * ulda + (unsigned)lc) * 2u;
  L.nk = g.K >> 6; L.kshift = g.b_kshift; L.kmask = (1 << g.b_kshift) - 1; L.kstride = g.b_kstride;
  L.akshift = g.a_kshift; L.akmask = (1 << g.a_kshift) - 1; L.akstride = g.a_kstride;
  if (g.b_perm == 1) {
    const unsigned n_0 = (unsigned)g.n0 + (unsigned)lr, n_1 = n_0 + 64u;
    const unsigned tk0 = (n_0 & ~4095u) | ((n_0 & 63u) << 6) | ((n_0 >> 6) & 63u);
    const unsigned tk1 = (n_1 & ~4095u) | ((n_1 & 63u) << 6) | ((n_1 >> 6) & 63u);
    L.baseB = g.B;
    L.vb0 = (tk0 * 1024u + (unsigned)lc) * 2u; L.vb1 = (tk1 * 1024u + (unsigned)lc) * 2u;
  } else if (g.b_perm == 2) {
    const unsigned n_0 = (unsigned)g.n0 + (unsigned)lr, n_1 = n_0 + 64u;
    const unsigned r0 = (((n_0 & 1023u) * 8u + (n_0 >> 16)) * 64u + ((n_0 >> 10) & 63u));
    const unsigned r1 = (((n_1 & 1023u) * 8u + (n_1 >> 16)) * 64u + ((n_1 >> 10) & 63u));
    L.baseB = g.B;
    L.vb0 = (r0 * 128u + (unsigned)lc) * 2u; L.vb1 = (r1 * 128u + (unsigned)lc) * 2u;
  }
}
__device__ __forceinline__ void ld_select(LdSt& o, const bool c, const LdSt& a, const LdSt& b) {
  o.baseA = c ? a.baseA : b.baseA; o.baseB = c ? a.baseB : b.baseB;
  o.va0 = c ? a.va0 : b.va0; o.va1 = c ? a.va1 : b.va1; o.va2 = c ? a.va2 : b.va2; o.va3 = c ? a.va3 : b.va3;
  o.vb0 = c ? a.vb0 : b.vb0; o.vb1 = c ? a.vb1 : b.vb1;
  o.nk = c ? a.nk : b.nk; o.kshift = c ? a.kshift : b.kshift; o.kmask = c ? a.kmask : b.kmask; o.kstride = c ? a.kstride : b.kstride;
  o.akshift = c ? a.akshift : b.akshift; o.akmask = c ? a.akmask : b.akmask; o.akstride = c ? a.akstride : b.akstride;
}

__device__ __forceinline__ void gemm_epilogue(const Ctx& p, const GD& g, f32x16 (&acc)[2][2], const int tid);

__device__ __forceinline__ void gemm_tile_mix(const Ctx& p, char* smem, const GD& g, const int tid) {
  u16* As = (u16*)smem;
  u16* Bs = As + 2 * 256 * 72;
  const int lane = tid & 63, w = tid >> 6, wm = w >> 1, wn = w & 1;
  const int lr = tid >> 3, lc = (tid & 7) * 8;
  f32x16 acc[2][2];
#pragma unroll
  for (int i = 0; i < 2; ++i)
#pragma unroll
    for (int j = 0; j < 2; ++j)
#pragma unroll
      for (int r = 0; r < 16; ++r) acc[i][j][r] = 0.f;
  Stg R0, R1;
  LdSt L; ld_setup(L, g, lr, lc);
  const int nk = L.nk;
  const int t0 = g.m0 + lr;
  const int sto = lr * 72 + lc;
  {
    float4 mu0, mu1;
    int nbm = 0;
    const uint4 z4 = make_uint4(0, 0, 0, 0);
    int nq0[4], nq1[4], nq2[4], nq3[4];
#pragma unroll
    for (int q4 = 0; q4 < 4; ++q4) {
      nq0[q4] = mix_nb(t0, q4 * 256); nq1[q4] = mix_nb(t0 + 64, q4 * 256); nq2[q4] = mix_nb(t0 + 128, q4 * 256); nq3[q4] = mix_nb(t0 + 192, q4 * 256);
    }
    for (int kt = -1; kt < nk; ++kt) {
      const int cur = kt & 1;
      if (kt + 1 < nk) {
        const int k0 = (kt + 1) * 64;
        const int k = k0 + lc;
        GEMM_LOADX(R0, L, kt + 1)
        const __amdgpu_buffer_rsrc_t rsA = make_rsrc(L.baseA);
        mu0 = *(const float4*)(g.mu + k); mu1 = *(const float4*)(g.mu + k + 4);
        const int soa = __builtin_amdgcn_readfirstlane(k0 * 2);
        const int qq = __builtin_amdgcn_readfirstlane(k0 >> 8);
        const int nb0 = (qq == 0) ? nq0[0] : (qq == 1) ? nq0[1] : (qq == 2) ? nq0[2] : nq0[3];
        const int nb1 = (qq == 0) ? nq1[0] : (qq == 1) ? nq1[1] : (qq == 2) ? nq1[2] : nq1[3];
        const int nb2 = (qq == 0) ? nq2[0] : (qq == 1) ? nq2[1] : (qq == 2) ? nq2[2] : nq2[3];
        const int nb3 = (qq == 0) ? nq3[0] : (qq == 1) ? nq3[1] : (qq == 2) ? nq3[2] : nq3[3];
        nbm = (nb0 >= 0 ? 1 : 0) | (nb1 >= 0 ? 2 : 0) | (nb2 >= 0 ? 4 : 0) | (nb3 >= 0 ? 8 : 0);
        R1.a0 = bufld(rsA, nb0 >= 0 ? ((unsigned)nb0 * 1024u + (unsigned)lc) * 2u : 0x80000000u, soa);
        R1.a1 = bufld(rsA, nb1 >= 0 ? ((unsigned)nb1 * 1024u + (unsigned)lc) * 2u : 0x80000000u, soa);
        R1.a2 = bufld(rsA, nb2 >= 0 ? ((unsigned)nb2 * 1024u + (unsigned)lc) * 2u : 0x80000000u, soa);
        R1.a3 = bufld(rsA, nb3 >= 0 ? ((unsigned)nb3 * 1024u + (unsigned)lc) * 2u : 0x80000000u, soa);
      }
      if (kt >= 0) GEMM_COMPUTE(cur)
      if (kt + 1 < nk) {
        R0.a0 = mix4(R0.a0, R1.a0, mu0, mu1); R0.a1 = mix4(R0.a1, R1.a1, mu0, mu1);
        R0.a2 = mix4(R0.a2, R1.a2, mu0, mu1); R0.a3 = mix4(R0.a3, R1.a3, mu0, mu1);
        GEMM_STORE(R0, cur ^ 1)
      }
      __syncthreads();
    }
  }
  gemm_epilogue(p, g, acc, tid);
}

__device__ __forceinline__ void gemm_epilogue(const Ctx& p, const GD& g, f32x16 (&acc)[2][2], const int tid) {
  int te = tid;
  asm volatile("" : "+v"(te));
  const int le = te & 63, we = te >> 6;
  const int lrow0 = 64 * (we >> 1) + 4 * (le >> 5), lcol0 = 64 * (we & 1) + (le & 31);
  const int ldo = (int)g.ldo;
  switch (g.ep) {
    case 0: { u16* ob = g.out + (size_t)(g.m0 + lrow0) * g.ldo + g.n0 + lcol0; EPI_LOOP(ldo, { ob[off] = f2bf(v); }) } break;
    case 1: { u16* ob = g.out + (size_t)(g.m0 + lrow0) * g.ldo + g.n0 + lcol0; EPI_LOOP(ldo, { ob[off] = f2bf(tanhf(v)); }) } break;
    case 2: { u16* ob = g.out + (size_t)(g.m0 + lrow0) * g.ldo + g.n0 + lcol0; EPI_LOOP(ldo, { ob[off] = f2bf(sigmoidf_(v)); }) } break;
    case 3: { u16* ob = g.out + (size_t)(g.m0 + lrow0) * g.ldo + g.n0 + lcol0; EPI_LOOP(ldo, { float rr = fmaxf(v, 0.f); ob[off] = f2bf(rr * rr); }) } break;
    case 4: { u16* ob = g.out + (size_t)(g.m0 + lrow0) * 64 + g.n0 + lcol0; if (g.n0 + lcol0 < 32) { EPI_LOOP(64, { ob[off] = f2bf(v); }) } } break;
    case 5: {
      const int jb = (g.m0 < TL) ? (g.m0 >> 12) : 8;
      const float* gp = g.e0 + jb * 6144 + g.n0 + lcol0;
      const float g0 = gp[0], g1 = gp[32];
      u16* ob = g.out + (size_t)(g.m0 + lrow0) * 1024 + g.n0 + lcol0;
      EPI_LOOP(1024, { ob[off] = f2bf((j ? g1 : g0) * v); })
    } break;
    case 6: { u16* ob = g.out + (size_t)(g.m0 + lrow0) * g.ldo + g.n0 + lcol0; const float* bp = g.e0 + g.n0 + lcol0; const float c0 = bp[0], c1 = bp[32];
      EPI_LOOP(ldo, { ob[off] = f2bf(sigmoidf_((j ? c1 : c0) + v)); }) } break;
    case 7: {
      u16* ob = g.out + (size_t)(g.m0 + lrow0) * 1024 + g.n0 + lcol0; const u16* gs = g.gsrc + (size_t)(g.m0 + lrow0) * 1024 + g.n0 + lcol0;
      EPI_LOOP(1024, { float vf = bf2f(ob[off]); float gt = bf2f(gs[off]); ob[off] = f2bf(v + (vf - v) * gt); })
    } break;
    case 8: {
      u16* ob; int ld;
      if (g.n0 < TL) { ld = TL; ob = g.out + (size_t)(g.m0 + lrow0) * TL + g.n0 + lcol0; } else { ld = TC; ob = g.out2 + (size_t)(g.m0 + lrow0) * TC + (g.n0 - TL) + lcol0; }
      EPI_LOOP(ld, { ob[off] = f2bf(v); })
    } break;
    case 9: {
      const int gq = g.m0 >> 17, rloc = g.m0 & 131071;
      const int mmq = rloc >> 9, b = ((rloc & 511) >> 6) + (we >> 1);
      const int k1 = 32 * (we & 1) + (le & 31);
      const float2* tw = (const float2*)g.e0 + k1 * 64;
      u16* zb = g.out + ((size_t)(((gq * 256 + mmq) * 8 + b) * 64 + k1) * 2) * 64;
#pragma unroll
      for (int i = 0; i < 2; ++i) {
#pragma unroll
        for (int rq = 0; rq < 4; ++rq) {
          const int l20 = 32 * i + 8 * rq + 4 * (le >> 5);
          float zr[4], zi[4];
#pragma unroll
          for (int e = 0; e < 4; ++e) {
            const float2 t = tw[l20 + e];
            const float re = acc[i][0][rq * 4 + e], im = acc[i][1][rq * 4 + e];
            zr[e] = re * t.x + im * t.y; zi[e] = im * t.x - re * t.y;
          }
          *(uint2*)(zb + l20) = make_uint2(pack2(zr[0], zr[1]), pack2(zr[2], zr[3]));
          *(uint2*)(zb + 64 + l20) = make_uint2(pack2(zi[0], zi[1]), pack2(zi[2], zi[3]));
        }
        asm volatile("" ::: "memory");
      }
    } break;
    case 10: {
      if ((we >> 1) == 0) {
        const int b = g.n0 >> 16, k1 = (g.n0 >> 10) & 63, gm0 = (g.n0 & 1023) + lcol0;
        u16* ob = g.out + ((size_t)(b * 4096 + k1 + 64 * (4 * (le >> 5)))) * 1024 + gm0;
        EPI_LOOP(65536, { ob[off] = f2bf(v); })
      }
    } break;
    default: break;
  }
}

enum { G_RB = 0, G_RC, G_RC2, G_WO_R, G_FB, G_F1, G_F2, G_WO_F, G_MLP1, G_MLP2 };

__device__ __forceinline__ int gemm_total(int kind, int layer) {
  const int idx = layer >> 1;
  const bool ctx_in = layer <= 2, ctx_out = layer < 2;
  const int mt_out = (ctx_out ? T : TL) >> 8;
  switch (kind) {
    case G_RB: return 136 * ((idx == 0) ? 27 : 20);
    case G_RC: return 136 * ((idx == 0) ? 8 : 16);
    case G_RC2: return 136 * 8;
    case G_WO_R: return mt_out * 8;
    case G_FB: return 8 * (ctx_in ? 272 : 256);
    case G_F1: return 2048;
    case G_F2: return 4096 + (ctx_in ? 64 : 0);
    case G_WO_F: return mt_out * 8;
    case G_MLP1: return mt_out * 32;
    default: return mt_out * 8;
  }
}

__device__ __forceinline__ void make_gd(const Ctx& p, int kind, int layer, int tile, GD& g) {
  const int idx = layer >> 1;
  const u16* H = (const u16*)p.ws;
  const u16* wm = (const u16*)(p.ws + OFF_WMIX);
  const float* mu = p.in[10] + (size_t)idx * 6 * 1024;
  const float* mod = (const float*)(p.ws + OFF_MOD) + (size_t)layer * 9 * 6144;
  g.out = nullptr; g.out2 = nullptr; g.e0 = nullptr; g.gsrc = nullptr; g.ldo = 1024; g.ep = 0; g.K = 1024;
  switch (kind) {
    case G_RB: {
      const int CT = (idx == 0) ? 27 : 20;
      int tm = tile / CT, ct = tile % CT;
      g.m0 = tm * 256;
      int nv = (idx == 0) ? 8 : 0;
      if (ct < 8) { gd_mixA(g, H, mu + 0 * 1024); gd_plainB(g, wm + 0 * M1, 1024); g.n0 = ct * 128; g.out = (u16*)(p.ws + 1 * SLOT); }
      else if (ct < 16) { gd_mixA(g, H, mu + 2 * 1024); gd_plainB(g, wm + 1 * M1, 1024); g.n0 = (ct - 8) * 128; g.out = (u16*)(p.ws + 2 * SLOT); }
      else if (ct < 16 + nv) { gd_mixA(g, H, mu + 3 * 1024); gd_plainB(g, wm + 2 * M1, 1024); g.n0 = (ct - 16) * 128; g.out = (u16*)(p.ws + 5 * SLOT); }
      else {
        int q = ct - 16 - nv; g.n0 = 0;
        if (q == 0) { gd_mixA(g, H, mu + 1 * 1024); gd_plainB(g, wm + 4 * M1, 1024); g.ep = 1; g.out = (u16*)(p.ws + OFF_HW); g.ldo = 128; }
        else if (q == 1) { gd_mixA(g, H, mu + 4 * 1024); gd_plainB(g, wm + 4 * M1 + 131072, 1024); g.ep = 0; g.out = (u16*)(p.ws + OFF_HA); g.ldo = 128; }
        else if (q == 2) { gd_mixA(g, H, mu + 5 * 1024); gd_plainB(g, wm + 4 * M1 + 2 * 131072, 1024); g.ep = 2; g.out = (u16*)(p.ws + OFF_HG); g.ldo = 128; }
        else { gd_mixA(g, H, mu + 3 * 1024); gd_plainB(g, wm + 4 * M1 + 3 * 131072, 1024); g.ep = 0; g.out = (u16*)(p.ws + OFF_HV); g.ldo = 128; }
      }
    } break;
    case G_RC: {
      const int CT = (idx == 0) ? 8 : 16;
      int tm = tile / CT, ct = tile % CT;
      g.m0 = tm * 256;
      if (ct < 8) { gd_plainA(g, (const u16*)(p.ws + OFF_HG), 128); gd_plainB(g, wm + 4 * M1 + 4 * 131072, 128); g.K = 128; g.n0 = ct * 128; g.out = (u16*)(p.ws + 4 * SLOT); }
      else { gd_plainA(g, (const u16*)(p.ws + OFF_HV), 128); gd_plainB(g, wm + 4 * M1 + 5 * 131072, 128); g.K = 128; g.n0 = (ct - 8) * 128; g.ep = 6; g.e0 = p.in[21]; g.out = (u16*)(p.ws + 3 * SLOT); }
    } break;
    case G_RC2: {
      int tm = tile >> 3, ct = tile & 7;
      g.m0 = tm * 256; g.n0 = ct * 128;
      gd_mixA(g, H, mu + 3 * 1024); gd_plainB(g, wm + 2 * M1, 1024);
      g.ep = 7; g.out = (u16*)(p.ws + 5 * SLOT); g.gsrc = (const u16*)(p.ws + 3 * SLOT);
    } break;
    case G_WO_R: {
      int tm = tile >> 3, ct = tile & 7;
      g.m0 = tm * 256; g.n0 = ct * 128;
      gd_plainA(g, H, 1024); gd_plainB(g, wm + 3 * M1, 1024);
      g.ep = 5; g.e0 = mod + 2048; g.out = (u16*)(p.ws + 1 * SLOT);
    } break;
    case G_FB: {
      int tn = tile >> 3, tm = tile & 7;
      g.K = 256; g.m0 = tm * 256; g.n0 = tn * 128;
      gd_plainA(g, wm + M1, 256); g.a_rowmask = 511;
      gd_plainB(g, H + 256 * (tm >> 1), 1024);
      if (g.n0 < TL) g.b_perm = 1;
      g.ep = 8; g.out = (u16*)(p.ws + 1 * SLOT); g.out2 = g.out + (size_t)2048 * TL;
    } break;
    case G_F1: {
      const u16* YT = (const u16*)(p.ws + 1 * SLOT);
      const int gq = tile >> 9;
      g.K = 128; g.m0 = tile * 256; g.n0 = 0;
      gd_plainA(g, YT + (size_t)gq * 512 * TL - (size_t)gq * 131072 * 64, 64);
      g.a_kshift = 6; g.a_kstride = (long)256 * TL;
      gd_plainB(g, wm + M1 + 131072, 128);
      g.ep = 9; g.out = (u16*)(p.ws + 3 * SLOT); g.e0 = (const float*)(wm + M1 + 131072 + 16384 + 8192 + 131072);
    } break;
    case G_F2: {
      u16* fo = (u16*)(p.ws + 1 * SLOT);
      if (tile < 4096) {
        g.K = 128; g.m0 = 0; g.n0 = tile * 128;
        gd_plainA(g, wm + M1 + 131072 + 16384, 128); g.a_rowmask = 63;
        gd_plainB(g, (const u16*)(p.ws + 3 * SLOT), 128); g.b_perm = 2;
        g.ep = 10; g.out = fo;
      } else {
        const u16* dftC = wm + M1 + 131072 + 16384 + 8192;
        const u16* YTc = (const u16*)(p.ws + 1 * SLOT) + (size_t)2048 * TL;
        int t2 = tile - 4096; int b = t2 >> 3, ct = t2 & 7;
        g.K = 512; g.m0 = 0; g.n0 = ct * 128;
        gd_plainA(g, dftC, 512);
        g.B = YTc + (size_t)b * 256; g.b_rs_hi = (long)512 * TC; g.b_rs_lo = TC; g.b_kshift = 8; g.b_kstride = (long)256 * TC; g.b_perm = 0;
        g.out = fo + (size_t)(TL + b * 256) * 1024;
      }
    } break;
    case G_WO_F: {
      int tm = tile >> 3, ct = tile & 7;
      g.m0 = tm * 256; g.n0 = ct * 128;
      gd_plainA(g, (const u16*)(p.ws + 1 * SLOT), 1024); gd_plainB(g, wm, 1024);
      g.ep = 5; g.e0 = mod + 2048; g.out = (u16*)(p.ws + 2 * SLOT);
    } break;
    case G_MLP1: {
      const int grp = tile >> 7, ii = tile & 127;
      int tm = grp * 4 + ((ii & 31) >> 3), ct = (ii >> 5) * 8 + (ii & 7);
      g.m0 = tm * 256; g.n0 = ct * 128;
      gd_plainA(g, H, 1024); gd_plainB(g, (const u16*)(p.ws + OFF_WMLP), 1024);
      g.ep = 3; g.out = (u16*)(p.ws + 1 * SLOT); g.ldo = 4096;
    } break;
    default: {
      int tm = tile >> 3, ct = tile & 7;
      g.K = 4096; g.m0 = tm * 256; g.n0 = ct * 128;
      gd_plainA(g, (const u16*)(p.ws + 1 * SLOT), 4096); gd_plainB(g, (const u16*)(p.ws + OFF_WMLP) + 4 * M1, 4096);
      g.ep = 5; g.e0 = mod + 5 * 1024; g.out = (u16*)(p.ws);
    } break;
  }
}

#define SCAN_SA_TEXT \
      "v_mul_f32_dpp %0, %2, %3 row_newbcast:0 row_mask:0xf bank_mask:0xf\n\t" \
      "v_mul_f32_dpp %1, %2, %4 row_newbcast:1 row_mask:0xf bank_mask:0xf\n\t" \
      "v_fmac_f32_dpp %0, %2, %5 row_newbcast:2 row_mask:0xf bank_mask:0xf\n\t" \
      "v_fmac_f32_dpp %1, %2, %6 row_newbcast:3 row_mask:0xf bank_mask:0xf\n\t" \
      "v_fmac_f32_dpp %0, %2, %7 row_newbcast:4 row_mask:0xf bank_mask:0xf\n\t" \
      "v_fmac_f32_dpp %1, %2, %8 row_newbcast:5 row_mask:0xf bank_mask:0xf\n\t" \
      "v_fmac_f32_dpp %0, %2, %9 row_newbcast:6 row_mask:0xf bank_mask:0xf\n\t" \
      "v_fmac_f32_dpp %1, %2, %10 row_newbcast:7 row_mask:0xf bank_mask:0xf\n\t" \
      "v_fmac_f32_dpp %0, %2, %11 row_newbcast:8 row_mask:0xf bank_mask:0xf\n\t" \
      "v_fmac_f32_dpp %1, %2, %12 row_newbcast:9 row_mask:0xf bank_mask:0xf\n\t" \
      "v_fmac_f32_dpp %0, %2, %13 row_newbcast:10 row_mask:0xf bank_mask:0xf\n\t" \
      "v_fmac_f32_dpp %1, %2, %14 row_newbcast:11 row_mask:0xf bank_mask:0xf\n\t" \
      "v_fmac_f32_dpp %0, %2, %15 row_newbcast:12 row_mask:0xf bank_mask:0xf\n\t" \
      "v_fmac_f32_dpp %1, %2, %16 row_newbcast:13 row_mask:0xf bank_mask:0xf\n\t" \
      "v_fmac_f32_dpp %0, %2, %17 row_newbcast:14 row_mask:0xf bank_mask:0xf\n\t" \
      "v_fmac_f32_dpp %1, %2, %18 row_newbcast:15 row_mask:0xf bank_mask:0xf\n\t"
#define SCAN_SA(sa0, sa1, A) asm( \
      SCAN_SA_TEXT \
      : "=&v"(sa0), "=&v"(sa1) : "v"(A), "v"(S[0]), "v"(S[1]), "v"(S[2]), "v"(S[3]), "v"(S[4]), "v"(S[5]), "v"(S[6]), "v"(S[7]), \
        "v"(S[8]), "v"(S[9]), "v"(S[10]), "v"(S[11]), "v"(S[12]), "v"(S[13]), "v"(S[14]), "v"(S[15]))
#define SCAN_UP(B0, W, Bv, KD, sa, VV) asm( \
      "v_mul_f32_dpp %0, %16, %8 row_newbcast:0 row_mask:0xf bank_mask:0xf\n\t" \
      "v_mul_f32_dpp %1, %16, %9 row_newbcast:1 row_mask:0xf bank_mask:0xf\n\t" \
      "v_mul_f32_dpp %2, %16, %10 row_newbcast:2 row_mask:0xf bank_mask:0xf\n\t" \
      "v_mul_f32_dpp %3, %16, %11 row_newbcast:3 row_mask:0xf bank_mask:0xf\n\t" \
      "v_mul_f32_dpp %4, %16, %12 row_newbcast:4 row_mask:0xf bank_mask:0xf\n\t" \
      "v_mul_f32_dpp %5, %16, %13 row_newbcast:5 row_mask:0xf bank_mask:0xf\n\t" \
      "v_mul_f32_dpp %6, %16, %14 row_newbcast:6 row_mask:0xf bank_mask:0xf\n\t" \
      "v_mul_f32_dpp %7, %16, %15 row_newbcast:7 row_mask:0xf bank_mask:0xf\n\t" \
      "v_fmac_f32_dpp %0, %17, %19 row_newbcast:0 row_mask:0xf bank_mask:0xf\n\t" \
      "v_fmac_f32_dpp %1, %17, %19 row_newbcast:1 row_mask:0xf bank_mask:0xf\n\t" \
      "v_fmac_f32_dpp %2, %17, %19 row_newbcast:2 row_mask:0xf bank_mask:0xf\n\t" \
      "v_fmac_f32_dpp %3, %17, %19 row_newbcast:3 row_mask:0xf bank_mask:0xf\n\t" \
      "v_fmac_f32_dpp %4, %17, %19 row_newbcast:4 row_mask:0xf bank_mask:0xf\n\t" \
      "v_fmac_f32_dpp %5, %17, %19 row_newbcast:5 row_mask:0xf bank_mask:0xf\n\t" \
      "v_fmac_f32_dpp %6, %17, %19 row_newbcast:6 row_mask:0xf bank_mask:0xf\n\t" \
      "v_fmac_f32_dpp %7, %17, %19 row_newbcast:7 row_mask:0xf bank_mask:0xf\n\t" \
      "v_fmac_f32_dpp %0, %18, %20 row_newbcast:0 row_mask:0xf bank_mask:0xf\n\t" \
      "v_fmac_f32_dpp %1, %18, %20 row_newbcast:1 row_mask:0xf bank_mask:0xf\n\t" \
      "v_fmac_f32_dpp %2, %18, %20 row_newbcast:2 row_mask:0xf bank_mask:0xf\n\t" \
      "v_fmac_f32_dpp %3, %18, %20 row_newbcast:3 row_mask:0xf bank_mask:0xf\n\t" \
      "v_fmac_f32_dpp %4, %18, %20 row_newbcast:4 row_mask:0xf bank_mask:0xf\n\t" \
      "v_fmac_f32_dpp %5, %18, %20 row_newbcast:5 row_mask:0xf bank_mask:0xf\n\t" \
      "v_fmac_f32_dpp %6, %18, %20 row_newbcast:6 row_mask:0xf bank_mask:0xf\n\t" \
      "v_fmac_f32_dpp %7, %18, %20 row_newbcast:7 row_mask:0xf bank_mask:0xf\n\t" \
      : "=&v"(N[B0 + 0]), "=&v"(N[B0 + 1]), "=&v"(N[B0 + 2]), "=&v"(N[B0 + 3]), "=&v"(N[B0 + 4]), "=&v"(N[B0 + 5]), "=&v"(N[B0 + 6]), "=&v"(N[B0 + 7]) \
      : "v"(S[B0 + 0]), "v"(S[B0 + 1]), "v"(S[B0 + 2]), "v"(S[B0 + 3]), "v"(S[B0 + 4]), "v"(S[B0 + 5]), "v"(S[B0 + 6]), "v"(S[B0 + 7]), \
        "v"(W), "v"(Bv), "v"(KD), "v"(sa), "v"(VV))
#define SCAN_UP8(B0, W, Bv, KD, sa, VV) asm( \
      "v_mul_f32_dpp %0, %16, %8 row_newbcast:8 row_mask:0xf bank_mask:0xf\n\t" \
      "v_mul_f32_dpp %1, %16, %9 row_newbcast:9 row_mask:0xf bank_mask:0xf\n\t" \
      "v_mul_f32_dpp %2, %16, %10 row_newbcast:10 row_mask:0xf bank_mask:0xf\n\t" \
      "v_mul_f32_dpp %3, %16, %11 row_newbcast:11 row_mask:0xf bank_mask:0xf\n\t" \
      "v_mul_f32_dpp %4, %16, %12 row_newbcast:12 row_mask:0xf bank_mask:0xf\n\t" \
      "v_mul_f32_dpp %5, %16, %13 row_newbcast:13 row_mask:0xf bank_mask:0xf\n\t" \
      "v_mul_f32_dpp %6, %16, %14 row_newbcast:14 row_mask:0xf bank_mask:0xf\n\t" \
      "v_mul_f32_dpp %7, %16, %15 row_newbcast:15 row_mask:0xf bank_mask:0xf\n\t" \
      "v_fmac_f32_dpp %0, %17, %19 row_newbcast:8 row_mask:0xf bank_mask:0xf\n\t" \
      "v_fmac_f32_dpp %1, %17, %19 row_newbcast:9 row_mask:0xf bank_mask:0xf\n\t" \
      "v_fmac_f32_dpp %2, %17, %19 row_newbcast:10 row_mask:0xf bank_mask:0xf\n\t" \
      "v_fmac_f32_dpp %3, %17, %19 row_newbcast:11 row_mask:0xf bank_mask:0xf\n\t" \
      "v_fmac_f32_dpp %4, %17, %19 row_newbcast:12 row_mask:0xf bank_mask:0xf\n\t" \
      "v_fmac_f32_dpp %5, %17, %19 row_newbcast:13 row_mask:0xf bank_mask:0xf\n\t" \
      "v_fmac_f32_dpp %6, %17, %19 row_newbcast:14 row_mask:0xf bank_mask:0xf\n\t" \
      "v_fmac_f32_dpp %7, %17, %19 row_newbcast:15 row_mask:0xf bank_mask:0xf\n\t" \
      "v_fmac_f32_dpp %0, %18, %20 row_newbcast:8 row_mask:0xf bank_mask:0xf\n\t" \
      "v_fmac_f32_dpp %1, %18, %20 row_newbcast:9 row_mask:0xf bank_mask:0xf\n\t" \
      "v_fmac_f32_dpp %2, %18, %20 row_newbcast:10 row_mask:0xf bank_mask:0xf\n\t" \
      "v_fmac_f32_dpp %3, %18, %20 row_newbcast:11 row_mask:0xf bank_mask:0xf\n\t" \
      "v_fmac_f32_dpp %4, %18, %20 row_newbcast:12 row_mask:0xf bank_mask:0xf\n\t" \
      "v_fmac_f32_dpp %5, %18, %20 row_newbcast:13 row_mask:0xf bank_mask:0xf\n\t" \
      "v_fmac_f32_dpp %6, %18, %20 row_newbcast:14 row_mask:0xf bank_mask:0xf\n\t" \
      "v_fmac_f32_dpp %7, %18, %20 row_newbcast:15 row_mask:0xf bank_mask:0xf\n\t" \
      : "=&v"(N[B0 + 0]), "=&v"(N[B0 + 1]), "=&v"(N[B0 + 2]), "=&v"(N[B0 + 3]), "=&v"(N[B0 + 4]), "=&v"(N[B0 + 5]), "=&v"(N[B0 + 6]), "=&v"(N[B0 + 7]) \
      : "v"(S[B0 + 0]), "v"(S[B0 + 1]), "v"(S[B0 + 2]), "v"(S[B0 + 3]), "v"(S[B0 + 4]), "v"(S[B0 + 5]), "v"(S[B0 + 6]), "v"(S[B0 + 7]), \
        "v"(W), "v"(Bv), "v"(KD), "v"(sa), "v"(VV))
#define SCAN_Y(sa0, sa1, A) asm( \
      SCAN_SA_TEXT \
      : "=&v"(sa0), "=&v"(sa1) : "v"(A), "v"(N[0]), "v"(N[1]), "v"(N[2]), "v"(N[3]), "v"(N[4]), "v"(N[5]), "v"(N[6]), "v"(N[7]), \
        "v"(N[8]), "v"(N[9]), "v"(N[10]), "v"(N[11]), "v"(N[12]), "v"(N[13]), "v"(N[14]), "v"(N[15]))
#define SCAN_STEP(W, A, Bv, KD, R, VV, YP, PREFETCH) { \
      float sa0, sa1, y0, y1; float N[16]; \
      asm volatile("s_nop 1" : "+v"(A), "+v"(W), "+v"(Bv), "+v"(KD), "+v"(R)); \
      SCAN_SA(sa0, sa1, A); \
      PREFETCH \
      const float sa = xrow_sum(sa0 + sa1); \
      SCAN_UP(0, W, Bv, KD, sa, VV); \
      SCAN_UP8(8, W, Bv, KD, sa, VV); \
      SCAN_Y(y0, y1, R); \
      YP = y0 + y1; \
      _Pragma("unroll") for (int j_ = 0; j_ < 16; ++j_) S[j_] = N[j_]; }
#define SCAN_LOAD(W, A, Bv, KD, R, VV, SIDX) { const float* np_ = bp + (SIDX) * 384; \
      W = np_[lane]; A = np_[64 + lane]; Bv = np_[128 + lane]; KD = np_[192 + lane]; R = np_[256 + lane]; VV = np_[vo]; }

__device__ __forceinline__ int scan_row(int gstep, int b, int d) {
  if (gstep < 256) { int pp = d ? 255 - gstep : gstep; return TL + b * 256 + pp; }
  int l = gstep - 256; if (d) l = 4095 - l;
  return b * 4096 + l;
}

__device__ __forceinline__ void phase_scan(const Ctx& p, char* smem, int idx, bool ctx_y, const int tid) {
  if (blockIdx.x >= 256) return;
  const int item = blockIdx.x;
  const int d = item & 1, h = (item >> 1) & 15, b = item >> 5;
  float* buf = (float*)smem;
  float* ybuf = buf + 2 * 32 * 384;
  const int lane = tid & 63, w = tid >> 6;
  const u16* rbuf = (const u16*)(p.ws + 1 * SLOT);
  const u16* kbuf = (const u16*)(p.ws + 2 * SLOT);
  const u16* vbuf = (const u16*)(p.ws + 5 * SLOT);
  u16* ybase = (u16*)(p.ws + (d == 0 ? 0 : 3 * SLOT));
  const u16* hw = (const u16*)(p.ws + OFF_HW);
  const u16* ha = (const u16*)(p.ws + OFF_HA);
  float* bsum = (float*)(p.ws + OFF_BSUM);
  const int ch = h * 64;

  uint4* Bl = (uint4*)(ybuf + 2 * 2048);
  float w0v[4], a0v[4];
  float kkw = 0.f, kaw = 0.f, rkw = 0.f;
#pragma unroll
  for (int cb = 0; cb < 4; ++cb) { w0v[cb] = 0.f; a0v[cb] = 0.f; }
  if (w >= 4) {
    const float* w2 = p.in[17] + (size_t)(idx * 2 + d) * 64 * 1024;
    const float* a2 = p.in[20] + (size_t)(idx * 2 + d) * 64 * 1024;
#pragma unroll
    for (int cb = 0; cb < 4; ++cb) {
      int col = ch + 16 * cb + (lane & 15);
      w0v[cb] = p.in[15][(idx * 2 + d) * 1024 + col];
      a0v[cb] = p.in[18][(idx * 2 + d) * 1024 + col];
    }
    {
      const int cb = w - 4;
      const int col = ch + 16 * cb + (lane & 15);
#pragma unroll
      for (int i = 0; i < 2; ++i) {
        const int k0 = 32 * i + 8 * (lane >> 4);
        float fw[8], fa[8];
#pragma unroll
        for (int q = 0; q < 8; ++q) { fw[q] = w2[(size_t)(k0 + q) * 1024 + col]; fa[q] = a2[(size_t)(k0 + q) * 1024 + col]; }
        Bl[((0 * 4 + cb) * 2 + i) * 64 + lane] = make_uint4(pack2(fw[0], fw[1]), pack2(fw[2], fw[3]), pack2(fw[4], fw[5]), pack2(fw[6], fw[7]));
        Bl[((1 * 4 + cb) * 2 + i) * 64 + lane] = make_uint4(pack2(fa[0], fa[1]), pack2(fa[2], fa[3]), pack2(fa[4], fa[5]), pack2(fa[6], fa[7]));
      }
    }
    kkw = p.in[26][idx * 1024 + ch + lane];
    kaw = p.in[27][idx * 1024 + ch + lane];
    rkw = p.in[28][idx * 1024 + ch + lane];
  }
  __syncthreads();
  float S[16];
#pragma unroll
  for (int j = 0; j < 16; ++j) S[j] = 0.f;

  for (int it = 0; it <= 137; ++it) {
    if (w >= 4) {
      const int jw = w - 4;
      if (it >= 2) {
        int cy = it - 2;
        const float* yb = ybuf + (cy & 1) * 2048;
        if (cy >= 8 || ctx_y) {
          const int yrow0 = scan_row(cy * 32 + jw * 8, b, d);
#pragma unroll
          for (int s8 = 0; s8 < 8; ++s8) {
            int s = jw * 8 + s8;
            int row = yrow0 + (d ? -s8 : s8);
            ybase[(unsigned)row * 1024u + (unsigned)(ch + lane)] = f2bf(yb[s * 64 + lane]);
          }
        }
      }
      if (it < 136) {
        float* bp = buf + (it & 1) * 12288;
        const int s0 = jw * 8;
        const int prow0 = scan_row(it * 32 + s0, b, d);
        int rowm = prow0 + (d ? -(lane & 7) : (lane & 7));
        bf16x8 Aw0 = *(const bf16x8*)(hw + ((unsigned)rowm * 128u + (unsigned)(d * 64 + 8 * (lane >> 4))));
        bf16x8 Aw1 = *(const bf16x8*)(hw + ((unsigned)rowm * 128u + (unsigned)(d * 64 + 32 + 8 * (lane >> 4))));
        bf16x8 Aa0 = *(const bf16x8*)(ha + ((unsigned)rowm * 128u + (unsigned)(d * 64 + 8 * (lane >> 4))));
        bf16x8 Aa1 = *(const bf16x8*)(ha + ((unsigned)rowm * 128u + (unsigned)(d * 64 + 32 + 8 * (lane >> 4))));
        float kx[8], rx[8], vx[8];
#pragma unroll
        for (int s8 = 0; s8 < 8; ++s8) {
          int row = prow0 + (d ? -s8 : s8);
          const unsigned o = (unsigned)row * 1024u + (unsigned)(ch + lane);
          kx[s8] = bf2f(kbuf[o]); rx[s8] = bf2f(rbuf[o]); vx[s8] = bf2f(vbuf[o]);
        }
        const bool hiL = lane >= 32;
#pragma unroll
        for (int cbp = 0; cbp < 2; ++cbp) {
          f32x4 cwl = {0.f, 0.f, 0.f, 0.f}, cal = {0.f, 0.f, 0.f, 0.f}, cwh = {0.f, 0.f, 0.f, 0.f}, cah = {0.f, 0.f, 0.f, 0.f};
          {
            const int cb = cbp;
            const bf16x8 bw0 = __builtin_bit_cast(bf16x8, Bl[((0 * 4 + cb) * 2 + 0) * 64 + lane]);
            const bf16x8 bw1 = __builtin_bit_cast(bf16x8, Bl[((0 * 4 + cb) * 2 + 1) * 64 + lane]);
            const bf16x8 ba0 = __builtin_bit_cast(bf16x8, Bl[((1 * 4 + cb) * 2 + 0) * 64 + lane]);
            const bf16x8 ba1 = __builtin_bit_cast(bf16x8, Bl[((1 * 4 + cb) * 2 + 1) * 64 + lane]);
            cwl = __builtin_amdgcn_mfma_f32_16x16x32_bf16(Aw0, bw0, cwl, 0, 0, 0);
            cwl = __builtin_amdgcn_mfma_f32_16x16x32_bf16(Aw1, bw1, cwl, 0, 0, 0);
            cal = __builtin_amdgcn_mfma_f32_16x16x32_bf16(Aa0, ba0, cal, 0, 0, 0);
            cal = __builtin_amdgcn_mfma_f32_16x16x32_bf16(Aa1, ba1, cal, 0, 0, 0);
          }
          {
            const int cb = cbp + 2;
            const bf16x8 bw0 = __builtin_bit_cast(bf16x8, Bl[((0 * 4 + cb) * 2 + 0) * 64 + lane]);
            const bf16x8 bw1 = __builtin_bit_cast(bf16x8, Bl[((0 * 4 + cb) * 2 + 1) * 64 + lane]);
            const bf16x8 ba0 = __builtin_bit_cast(bf16x8, Bl[((1 * 4 + cb) * 2 + 0) * 64 + lane]);
            const bf16x8 ba1 = __builtin_bit_cast(bf16x8, Bl[((1 * 4 + cb) * 2 + 1) * 64 + lane]);
            cwh = __builtin_amdgcn_mfma_f32_16x16x32_bf16(Aw0, bw0, cwh, 0, 0, 0);
            cwh = __builtin_amdgcn_mfma_f32_16x16x32_bf16(Aw1, bw1, cwh, 0, 0, 0);
            cah = __builtin_amdgcn_mfma_f32_16x16x32_bf16(Aa0, ba0, cah, 0, 0, 0);
            cah = __builtin_amdgcn_mfma_f32_16x16x32_bf16(Aa1, ba1, cah, 0, 0, 0);
          }
          const float w0s = hiL ? w0v[cbp + 2] : w0v[cbp];
          const float a0s = hiL ? a0v[cbp + 2] : a0v[cbp];
          const int colb = 16 * (cbp + (hiL ? 2 : 0)) + (lane & 15);
#pragma unroll
          for (int r = 0; r < 4; ++r) {
            const int m = 4 * ((lane >> 4) & 1) + r;
            const float xw = (hiL ? cwh[r] : cwl[r]) + w0s;
            const float xa = (hiL ? cah[r] : cal[r]) + a0s;
            const float dec = __expf(-0.60653066f * sigmoidf_(xw));
            const float ic = sigmoidf_(xa);
            bp[(s0 + m) * 384 + 0 * 64 + colb] = dec;
            bp[(s0 + m) * 384 + 1 * 64 + colb] = ic;
          }
        }
        float icv[8], kkr[8], kdv[8], X[16];
#pragma unroll
        for (int s8 = 0; s8 < 8; ++s8) {
          icv[s8] = bp[(s0 + s8) * 384 + 64 + lane];
          kkr[s8] = kx[s8] * kkw;
          kdv[s8] = kx[s8] * (1.f + (icv[s8] - 1.f) * kaw);
          X[2 * s8] = kkr[s8] * kkr[s8];
          X[2 * s8 + 1] = rx[s8] * kdv[s8] * rkw;
        }
        float Yv[8], Zv[4];
#pragma unroll
        for (int m = 0; m < 8; ++m) {
          auto pp = __builtin_amdgcn_permlane32_swap(__float_as_uint(X[2 * m]), __float_as_uint(X[2 * m + 1]), false, false);
          Yv[m] = __uint_as_float(pp[0]) + __uint_as_float(pp[1]);
        }
#pragma unroll
        for (int n = 0; n < 4; ++n) {
          auto pq = __builtin_amdgcn_permlane16_swap(__float_as_uint(Yv[2 * n]), __float_as_uint(Yv[2 * n + 1]), false, false);
          float z = __uint_as_float(pq[0]) + __uint_as_float(pq[1]);
          DPP_ROR_ADD(z, 8); DPP_ROR_ADD(z, 4); DPP_ROR_ADD(z, 2); DPP_ROR_ADD(z, 1);
          Zv[n] = z;
        }
        float bsv = 0.f;
#pragma unroll
        for (int s8 = 0; s8 < 8; ++s8) {
          const int s = s0 + s8;
          const int zi = __float_as_int(Zv[s8 >> 1]);
          const float ss = __int_as_float(__builtin_amdgcn_readlane(zi, (s8 & 1) * 16));
          const float bs = __int_as_float(__builtin_amdgcn_readlane(zi, 32 + (s8 & 1) * 16));
          const float ic = icv[s8];
          const float kk = kkr[s8] * rsqrtf(fmaxf(ss, 1e-24f));
          bsv = (lane == s8) ? bs : bsv;
          bp[s * 384 + 64 + lane] = -kk;
          bp[s * 384 + 128 + lane] = kk * ic;
          bp[s * 384 + 192 + lane] = kdv[s8];
          bp[s * 384 + 256 + lane] = rx[s8];
          bp[s * 384 + 320 + lane] = vx[s8];
        }
        if (lane < 8) bsum[(unsigned)(prow0 + (d ? -lane : lane)) * 32u + (unsigned)(h * 2 + d)] = bsv;
      }
    } else {
      if (it >= 1 && it <= 136) {
        const float* bp = buf + ((it - 1) & 1) * 12288;
        float* yb = ybuf + ((it - 1) & 1) * 2048;
        const int vo = 320 + 16 * w + (lane & 15);
        float W0, A0, B0, K0, R0, V0, W1, A1, B1, K1, R1, V1;
        SCAN_LOAD(W0, A0, B0, K0, R0, V0, 0)
#pragma unroll 1
        for (int s = 0; s < 32; s += 4) {
          float yp0, yp1, yp2, yp3;
          SCAN_STEP(W0, A0, B0, K0, R0, V0, yp0, SCAN_LOAD(W1, A1, B1, K1, R1, V1, s + 1))
          SCAN_STEP(W1, A1, B1, K1, R1, V1, yp1, SCAN_LOAD(W0, A0, B0, K0, R0, V0, s + 2))
          SCAN_STEP(W0, A0, B0, K0, R0, V0, yp2, SCAN_LOAD(W1, A1, B1, K1, R1, V1, s + 3))
          const int s4 = (s + 4 < 32) ? s + 4 : 31;
          SCAN_STEP(W1, A1, B1, K1, R1, V1, yp3, SCAN_LOAD(W0, A0, B0, K0, R0, V0, s4))
          {
            auto p01 = __builtin_amdgcn_permlane32_swap(__float_as_uint(yp0), __float_as_uint(yp1), false, false);
            auto p23 = __builtin_amdgcn_permlane32_swap(__float_as_uint(yp2), __float_as_uint(yp3), false, false);
            const float u01 = __uint_as_float(p01[0]) + __uint_as_float(p01[1]);
            const float u23 = __uint_as_float(p23[0]) + __uint_as_float(p23[1]);
            auto pz = __builtin_amdgcn_permlane16_swap(__float_as_uint(u01), __float_as_uint(u23), false, false);
            const float z = __uint_as_float(pz[0]) + __uint_as_float(pz[1]);
            const int rho = lane >> 4;
            const int smap = ((rho & 1) << 1) | (rho >> 1);
            yb[(s + smap) * 64 + 16 * w + (lane & 15)] = z;
          }
        }
      }
    }
    __syncthreads();
  }
}

__device__ __forceinline__ void phase_readout(const Ctx& p, int idx, int nrows, const int tid) {
  u16* y0 = (u16*)(p.ws);
  const u16* y1 = (const u16*)(p.ws + 3 * SLOT);
  const u16* vb = (const u16*)(p.ws + 5 * SLOT);
  const u16* gb = (const u16*)(p.ws + 4 * SLOT);
  const float* bsum = (const float*)(p.ws + OFF_BSUM);
  const float* lw = p.in[29] + idx * 1024;
  const float* lb = p.in[30] + idx * 1024;
  int lane = tid & 63, wv = tid >> 6;
  const int stride = gridDim.x * 8;
  for (int row0 = blockIdx.x * 8 + wv; row0 < nrows; row0 += 2 * stride) {
    const bool v1 = (row0 + stride) < nrows;
    uint4 ld[2][8];
    float bs0[2], bs1[2];
#pragma unroll
    for (int u = 0; u < 2; ++u) {
      const int row = row0 + u * stride;
      if (u == 0 || v1) {
        const size_t o = (size_t)row * 1024 + lane * 16;
        ld[u][0] = *(const uint4*)(y0 + o); ld[u][1] = *(const uint4*)(y0 + o + 8);
        ld[u][2] = *(const uint4*)(y1 + o); ld[u][3] = *(const uint4*)(y1 + o + 8);
        ld[u][4] = *(const uint4*)(vb + o); ld[u][5] = *(const uint4*)(vb + o + 8);
        ld[u][6] = *(const uint4*)(gb + o); ld[u][7] = *(const uint4*)(gb + o + 8);
        const int hh = lane >> 2;
        bs0[u] = bsum[(size_t)row * 32 + hh * 2]; bs1[u] = bsum[(size_t)row * 32 + hh * 2 + 1];
      }
    }
#pragma unroll
    for (int u = 0; u < 2; ++u) {
      const int row = row0 + u * stride;
      if (u == 0 || v1) {
        const size_t o = (size_t)row * 1024 + lane * 16;
        const uint4 a0 = ld[u][0], a1 = ld[u][1], b0 = ld[u][2], b1 = ld[u][3], v0 = ld[u][4], v1q = ld[u][5], g0 = ld[u][6], g1 = ld[u][7];
        unsigned ya[8] = {a0.x, a0.y, a0.z, a0.w, a1.x, a1.y, a1.z, a1.w};
        unsigned yb[8] = {b0.x, b0.y, b0.z, b0.w, b1.x, b1.y, b1.z, b1.w};
        unsigned vv[8] = {v0.x, v0.y, v0.z, v0.w, v1q.x, v1q.y, v1q.z, v1q.w};
        unsigned gg[8] = {g0.x, g0.y, g0.z, g0.w, g1.x, g1.y, g1.z, g1.w};
        float y[16];
        float sum = 0.f;
#pragma unroll
        for (int q = 0; q < 8; ++q) {
          y[2 * q] = bflo(ya[q]) + bflo(yb[q]);
          y[2 * q + 1] = bfhi(ya[q]) + bfhi(yb[q]);
          sum += y[2 * q] + y[2 * q + 1];
        }
        sum += __shfl_xor(sum, 1); sum += __shfl_xor(sum, 2);
        float mean = sum * (1.f / 64.f);
        float var = 0.f;
#pragma unroll
        for (int q = 0; q < 16; ++q) { float dd = y[q] - mean; var += dd * dd; }
        var += __shfl_xor(var, 1); var += __shfl_xor(var, 2);
        float rstd = rsqrtf(var * (1.f / 64.f) + 64e-5f);
        float bon = bs0[u] + bs1[u];
        unsigned ov[8];
#pragma unroll
        for (int q = 0; q < 8; ++q) {
          int c = lane * 16 + 2 * q;
          float o0 = ((y[2 * q] - mean) * rstd * lw[c] + lb[c] + bon * bflo(vv[q])) * bflo(gg[q]);
          float o1 = ((y[2 * q + 1] - mean) * rstd * lw[c + 1] + lb[c + 1] + bon * bfhi(vv[q])) * bfhi(gg[q]);
          ov[q] = pack2(o0, o1);
        }
        *(uint4*)(y0 + o) = make_uint4(ov[0], ov[1], ov[2], ov[3]);
        *(uint4*)(y0 + o + 8) = make_uint4(ov[4], ov[5], ov[6], ov[7]);
      }
    }
  }
}

__device__ __forceinline__ void phase_final(const Ctx& p, const int tid) {
  const float* gam = p.in[32];
  int lane = tid & 63, wv = tid >> 6;
  for (int row = blockIdx.x * 8 + wv; row < TL; row += gridDim.x * 8) {
    float* src = p.out + (size_t)row * 1024;
    float4 x[4];
    float ss = 0.f;
#pragma unroll
    for (int q = 0; q < 4; ++q) {
      x[q] = *(const float4*)(src + q * 256 + lane * 4);
      {
        uint2 dv = *(const uint2*)((const u16*)p.ws + (size_t)row * 1024 + q * 256 + lane * 4);
        x[q].x += bflo(dv.x); x[q].y += bfhi(dv.x); x[q].z += bflo(dv.y); x[q].w += bfhi(dv.y);
      }
      ss += x[q].x * x[q].x + x[q].y * x[q].y + x[q].z * x[q].z + x[q].w * x[q].w;
    }
    ss = wave_sum(ss);
    float rstd = rsqrtf(ss * (1.f / 1024.f) + 1e-6f);
#pragma unroll
    for (int q = 0; q < 4; ++q) {
      int col = q * 256 + lane * 4;
      float4 g = *(const float4*)(gam + col);
      float4 o = make_float4(x[q].x * rstd * g.x, x[q].y * rstd * g.y, x[q].z * rstd * g.z, x[q].w * rstd * g.w);
#if PROBE_STEPS
      { long long tt = *(const long long*)(p.ws + OFF_PROBE); int n2 = (int)(tt / 100); if (n2 > 30000) n2 = 30000;
        if (q == 0 && lane == 0 && row < n2) o.x += 0.125f; }
#endif
      *(float4*)(src + col) = o;
    }
  }
}

__device__ __forceinline__ void gemm_run_plain(const Ctx& p, char* smem, const int kind, const int layer, const int total, const int vbid, int tid) {
  u16* As = (u16*)smem;
  u16* Bs = As + 2 * 256 * 72;
  int ntile = vbid;
  bool first = true;
  GD g; LdSt Lc;
  Stg R0, R1;
  Frg F0, F1;
  for (;;) {
    const bool has_next = ntile < total;
    asm volatile("" : "+v"(tid));
    const int lane = tid & 63, w = tid >> 6, wm = w >> 1, wn = w & 1;
    const int lr = tid >> 3, lc = (tid & 7) * 8;
    const int sto = lr * 72 + lc;
    GD gn; make_gd(p, kind, layer, has_next ? ntile : total - 1, gn);
    LdSt Ln; ld_setup(Ln, gn, lr, lc);
    __builtin_amdgcn_s_waitcnt(0xC07F);
    if (first) {
      if (!has_next) break;
      g = gn; Lc = Ln;
      GEMM_LOADX(R0, Lc, 0)
      GEMM_LOADX(R1, Lc, 1)
      GEMM_STORE(R0, 0)
      __syncthreads();
      GEMM_READF(F0, 0, 0)
      first = false; ntile += gridDim.x;
      continue;
    }
    f32x16 acc[2][2];
#pragma unroll
    for (int i = 0; i < 2; ++i)
#pragma unroll
      for (int j = 0; j < 2; ++j)
#pragma unroll
        for (int r = 0; r < 16; ++r) acc[i][j][r] = 0.f;
    const int nk = Lc.nk;
    if (nk > 2) {
      GEMM_KSTEP(0, R0, Lc, 2, R1)
      GEMM_KSTEP(1, R1, Lc, 3, R0)
    }
    __builtin_amdgcn_s_waitcnt(0x0070);
    for (int kt = 2; kt + 2 < nk; kt += 2) {
      GEMM_KSTEP(0, R0, Lc, kt + 2, R1)
      GEMM_KSTEP(1, R1, Lc, kt + 3, R0)
    }
    GEMM_KSTEP(0, R0, Ln, 0, R1)
    GEMM_KSTEP_LAST(1, R1, Ln, 1, R0)
    gemm_epilogue(p, g, acc, tid);
    if (!has_next) break;
    GEMM_READF(F0, 0, 0)
    g = gn; Lc = Ln; ntile += gridDim.x;
  }
  __syncthreads();
}

__global__ void __launch_bounds__(512) fwd_megakernel(Params p0) {
  Ctx p; p.in = p0.in; p.out = p0.out; p.ws = p0.ws;
  extern __shared__ __attribute__((aligned(16))) char smem[];
  cg::grid_group grid = cg::this_grid();

  int tid0 = threadIdx.x;
  asm volatile("" : "+v"(tid0));
  phase_mod(p, smem, tid0);
  asm volatile("" : "+v"(tid0));
  convert_weights(p, smem, 0, tid0);
  grid.sync();
  for (int ph = 0; ph < 40; ++ph) {
    const int layer = ph / 10, step = ph % 10;
    const int idx = layer >> 1;
    const bool rw = (layer & 1) == 0;
    const bool ctx_in = layer <= 2, ctx_out = layer < 2;
    const int rows_in = ctx_in ? T : TL, rows_out = ctx_out ? T : TL;
    int gk = -1;
    int tid = threadIdx.x;
    Ctx q; q.in = p0.in;
    {
      unsigned long long w_ = (unsigned long long)p0.ws, o_ = (unsigned long long)p0.out;
      unsigned wl = __builtin_amdgcn_readfirstlane((unsigned)w_), wh = __builtin_amdgcn_readfirstlane((unsigned)(w_ >> 32));
      unsigned ol = __builtin_amdgcn_readfirstlane((unsigned)o_), oh = __builtin_amdgcn_readfirstlane((unsigned)(o_ >> 32));
      asm volatile("" : "+s"(wl), "+s"(wh), "+s"(ol), "+s"(oh));
      q.ws = (char*)(((unsigned long long)wh << 32) | wl);
      q.out = (float*)(((unsigned long long)oh << 32) | ol);
    }
#if PROBE_STEPS
    if (blockIdx.x == 0 && tid == 0) ((long long*)(q.ws + OFF_PROBE))[1] = wall_clock64();
#endif
#define OPAQUE_TID() asm volatile("" : "+v"(tid))
    if (step == 0 || step == 7) {
      OPAQUE_TID();
      {
        const u16* dl = (step == 7) ? (const u16*)(q.ws + (rw ? 1 : 2) * SLOT) : ((ph == 0) ? (const u16*)nullptr : (const u16*)q.ws);
        const int drows = (step == 7) ? rows_out : ((layer - 1) < 2 ? T : TL);
        prep_rows(q, layer, step == 0 ? 0 : 1, step == 0 ? rows_in : rows_out, ph == 0, dl, drows, tid);
      }
      if (step == 0) {
        OPAQUE_TID();
        if (layer > 0) convert_weights(q, smem, layer, tid);
        if (!rw) { OPAQUE_TID(); fourier_tables(q, ctx_in, tid); }
      }
    } else if (step == 1) gk = rw ? G_RB : G_FB;
    else if (step == 2) gk = rw ? G_RC : G_F1;
    else if (step == 3) { if (rw && idx != 1) continue; gk = rw ? G_RC2 : G_F2; }
    else if (step == 4) { if (!rw) continue; OPAQUE_TID(); phase_scan(q, smem, idx, ctx_out, tid); }
    else if (step == 5) { if (!rw) continue; OPAQUE_TID(); phase_readout(q, idx, rows_out, tid); }
    else if (step == 6) gk = rw ? G_WO_R : G_WO_F;
    else if (step == 8) gk = G_MLP1;
    else gk = G_MLP2;
    if (gk >= 0) {
      const int total = gemm_total(gk, layer);
      const int vbid = (int)(blockIdx.x & 7) * (int)(gridDim.x >> 3) + (int)(blockIdx.x >> 3);
      if (gk == G_RB || gk == G_RC2) {
        for (int tile = vbid; tile < total; tile += gridDim.x) {
          GD g;
          make_gd(q, gk, layer, tile, g);
          OPAQUE_TID();
          gemm_tile_mix(q, smem, g, tid);
        }
      } else {
        gemm_run_plain(q, smem, gk, layer, total, vbid, tid);
      }
    }
    grid.sync();
#if PROBE_STEPS
    if (blockIdx.x == 0 && threadIdx.x == 0) {
      long long* pr = (long long*)(p.ws + OFF_PROBE);
      if (ph == 0) pr[0] = 0;
      if (((PROBE_STEPS >> step) & 1) && ((PROBE_LAYERS >> layer) & 1)) pr[0] += wall_clock64() - pr[1];
    }
#endif
  }
#if PROBE_STEPS
  grid.sync();
#endif
  int tid1 = threadIdx.x;
  asm volatile("" : "+v"(tid1));
  phase_final(p, tid1);
}

extern "C" void kernel_launch(void* const* d_in, const int* in_sizes, int n_in,
                              void* d_out, int out_size, void* d_ws, size_t ws_size,
                              hipStream_t stream) {
  static int grid_blocks = 0;
  if (!grid_blocks) {
    int dev = 0, cus = 0, per_cu = 0;
    (void)hipGetDevice(&dev);
    (void)hipDeviceGetAttribute(&cus, hipDeviceAttributeMultiprocessorCount, dev);
    if (hipFuncSetAttribute((const void*)fwd_megakernel, hipFuncAttributeMaxDynamicSharedMemorySize, LDS_BYTES) != hipSuccess)
      fprintf(stderr, "hipFuncSetAttribute failed\n");
    (void)hipOccupancyMaxActiveBlocksPerMultiprocessor(&per_cu, (const void*)fwd_megakernel, 512, LDS_BYTES);
    if (per_cu < 1) { fprintf(stderr, "occupancy query returned %d\n", per_cu); per_cu = 1; }
    (void)hipGetLastError();
    grid_blocks = cus;
    if (ws_size < WS_END) fprintf(stderr, "workspace too small: %zu < %zu\n", ws_size, (size_t)WS_END);
  }
  Params p{};
  for (int i = 0; i < 33; ++i) p.in[i] = (const float*)d_in[i];
  p.out = (float*)d_out;
  p.ws = (char*)d_ws;
  void* args[] = {&p};
  hipError_t e = hipLaunchCooperativeKernel((const void*)fwd_megakernel, dim3(grid_blocks), dim3(512), args, LDS_BYTES, stream);
  if (e != hipSuccess) fprintf(stderr, "cooperative launch failed: %s (grid %d)\n", hipGetErrorString(e), grid_blocks);
}
```
